# Optimizing an MI355X kernel written in HIP

```python
import jax, jax.numpy as jnp
from jax import lax
import numpy as np

D_MODEL = 1024
BATCH = 16
SEQ = 4096
DEPTH = 1

CHUNK = 64
MIX_WIDTH = D_MODEL
M_HEADS = 4
M_HEAD_DIM = 128
M_WIDTH = M_HEADS * M_HEAD_DIM
CONV_WIDTH = 4
A_HEADS = 4
A_HEAD_DIM = 128
A_WIDTH = A_HEADS * A_HEAD_DIM
IDX_HEADS = 4
IDX_DIM = 64
TOPK_KEYS_MAX = 256
Q_BLOCK = 128
ROPE_THETA = 500000.0
ROPE_FRACTION_DIV = 4
N_EXPERTS = 64
N_GROUPS = 8
TOPK_GROUPS = 4
TOPK_EXPERTS = 8
D_EXPERT = 256
D_SHARED = 256
ROUTE_SCALE = 2.5
EXPERT_BLOCK = 512
NORM_EPS = 1e-6
STAB_INIT = -1e30
SPLIT_SIZES = (M_WIDTH, M_WIDTH, M_WIDTH, M_WIDTH, M_HEADS, M_HEADS, A_WIDTH, A_HEAD_DIM, A_HEAD_DIM, IDX_HEADS * IDX_DIM, IDX_DIM, IDX_HEADS)
IN_DIM = 4 * M_WIDTH + 2 * M_HEADS + A_WIDTH + 2 * A_HEAD_DIM + IDX_HEADS * IDX_DIM + IDX_DIM + IDX_HEADS

kernel_name = "hymba_mlstm_dsa_moe_block"


def rms_norm(x, g):
    xf = x.astype(jnp.float32)
    y = xf * lax.rsqrt(jnp.mean(xf * xf, axis=-1, keepdims=True) + NORM_EPS)
    return (y * g.astype(jnp.float32)).astype(x.dtype)


def layer_norm(x, g, b):
    xf = x.astype(jnp.float32)
    mu = jnp.mean(xf, axis=-1, keepdims=True)
    var = jnp.mean(jnp.square(xf - mu), axis=-1, keepdims=True)
    y = (xf - mu) * lax.rsqrt(var + NORM_EPS)
    return (y * g.astype(jnp.float32) + b.astype(jnp.float32)).astype(x.dtype)


def head_rms_norm(h, g):
    y = h * lax.rsqrt(jnp.mean(h * h, axis=-1, keepdims=True) + NORM_EPS)
    return y * g.astype(jnp.float32).reshape(h.shape[-2:])


def partial_rope(x, pos):
    dh = x.shape[-1]
    rot = dh // ROPE_FRACTION_DIV
    half = rot // 2
    inv_freq = jnp.exp(-jnp.log(jnp.float32(ROPE_THETA)) * jnp.arange(half, dtype=jnp.float32) * (2.0 / rot))
    ang = pos.astype(jnp.float32)[:, None] * inv_freq[None, :]
    shape = (1, pos.shape[0]) + (1,) * (x.ndim - 3) + (half,)
    cos = jnp.cos(ang).reshape(shape)
    sin = jnp.sin(ang).reshape(shape)
    xf = x.astype(jnp.float32)
    x1 = xf[..., :half]
    x2 = xf[..., half:rot]
    out = jnp.concatenate([x1 * cos - x2 * sin, x2 * cos + x1 * sin, xf[..., rot:]], axis=-1)
    return out.astype(x.dtype)


def causal_conv(u, w, b):
    ch = u.shape[-1]
    out = lax.conv_general_dilated(u, w.astype(u.dtype)[:, None, :], window_strides=(1,), padding=[(CONV_WIDTH - 1, 0)], dimension_numbers=("NWC", "WIO", "NWC"), feature_group_count=ch)
    return out + b.astype(u.dtype)


def mlstm_chunkwise(q, k, v, i_pre, f_pre):
    B, S, H, Dh = q.shape
    NC = S // CHUNK
    f32 = jnp.float32

    def chunks(a):
        a = a.astype(f32).reshape((B, NC, CHUNK) + a.shape[2:])
        return jnp.moveaxis(jnp.moveaxis(a, 1, 0), 3, 2)

    qc = chunks(q)
    kc = chunks(k) * (Dh ** -0.5)
    vc = chunks(v)
    ic = chunks(i_pre)
    lfc = jax.nn.log_sigmoid(chunks(f_pre))
    tril = jnp.tril(jnp.ones((CHUNK, CHUNK), dtype=bool))

    def step(carry, inp):
        C, n, m = carry
        qb, kb, vb, ib, lfb = inp
        b = jnp.cumsum(lfb, axis=-1)
        logD = b[..., :, None] - b[..., None, :] + ib[..., None, :]
        logD = jnp.where(tril, logD, -jnp.inf)
        m_inter = b + m[..., None]
        m_t = jnp.maximum(m_inter, jnp.max(logD, axis=-1))
        dmat = jnp.exp(logD - m_t[..., None])
        s_qk = jnp.einsum("bhtd,bhsd->bhts", qb, kb) * dmat
        inter = jnp.exp(m_inter - m_t)
        num = jnp.einsum("bhts,bhsd->bhtd", s_qk, vb) + inter[..., None] * jnp.einsum("bhvk,bhtk->bhtv", C, qb)
        den = jnp.sum(s_qk, axis=-1) + inter * jnp.einsum("bhk,bhtk->bht", n, qb)
        h = num / jnp.maximum(jnp.abs(den), jnp.exp(-m_t))[..., None]
        bL = b[..., -1]
        log_w = bL[..., None] - b + ib
        m_new = jnp.maximum(bL + m, jnp.max(log_w, axis=-1))
        w = jnp.exp(log_w - m_new[..., None])
        decay = jnp.exp(bL + m - m_new)
        C_new = decay[..., None, None] * C + jnp.einsum("bhsv,bhsk->bhvk", vb * w[..., None], kb)
        n_new = decay[..., None] * n + jnp.einsum("bhs,bhsk->bhk", w, kb)
        return (C_new, n_new, m_new), h

    init = (jnp.zeros((B, H, Dh, Dh), f32), jnp.zeros((B, H, Dh), f32), jnp.full((B, H), STAB_INIT, f32))
    _, hs = lax.scan(step, init, (qc, kc, vc, ic, lfc))
    return hs.transpose(1, 0, 3, 2, 4).reshape(B, S, H, Dh)


def dsa_attention(aq, ak, av, iq, ik, iw):
    B, S, H, Dh = aq.shape
    k_top = min(TOPK_KEYS_MAX, S // 4)
    nqb = S // Q_BLOCK
    key_chunk = jnp.arange(S) // CHUNK
    scale = Dh ** -0.5

    def block(args):
        qb, iqb, iwb, qpos = args
        q_chunk = qpos // CHUNK
        rel = jax.nn.relu(jnp.einsum("bqhd,bsd->bqhs", iqb, ik))
        score = jnp.einsum("bqh,bqhs->bqs", iwb, rel).astype(jnp.float32)
        admissible = key_chunk[None, :] <= q_chunk[:, None]
        score = jnp.where(admissible[None], score, -jnp.inf)
        _, idx = lax.top_k(score, k_top)
        valid = (idx // CHUNK) <= q_chunk[None, :, None]
        kg = jax.vmap(lambda kk, ii: kk[ii])(ak, idx)
        vg = jax.vmap(lambda vv, ii: vv[ii])(av, idx)
        logits = jnp.einsum("bqhd,bqkd->bhqk", qb, kg).astype(jnp.float32) * scale
        logits = jnp.where(valid[:, None], logits, -jnp.inf)
        p = jax.nn.softmax(logits, axis=-1).astype(vg.dtype)
        return jnp.einsum("bhqk,bqkd->bqhd", p, vg)

    def qblocks(a):
        return jnp.moveaxis(a.reshape((B, nqb, Q_BLOCK) + a.shape[2:]), 1, 0)

    out = lax.map(block, (qblocks(aq), qblocks(iq), qblocks(iw), jnp.arange(S).reshape(nqb, Q_BLOCK)))
    return jnp.moveaxis(out, 0, 1).reshape(B, S, H, Dh)


def moe_ffn(h, w_router, b_router, w_gate, w_up, w_down, ws_gate, ws_up, ws_down):
    B, S, D = h.shape
    T = B * S
    hf = h.reshape(T, D)
    scores = jax.nn.sigmoid(hf.astype(jnp.float32) @ w_router.astype(jnp.float32))
    sel = scores + b_router.astype(jnp.float32)
    grp = sel.reshape(T, N_GROUPS, N_EXPERTS // N_GROUPS)
    grp_score = jnp.sum(lax.top_k(grp, 2)[0], axis=-1)
    _, top_g = lax.top_k(grp_score, TOPK_GROUPS)
    gmask = jnp.any(top_g[..., None] == jnp.arange(N_GROUPS), axis=-2)
    emask = jnp.repeat(gmask, N_EXPERTS // N_GROUPS, axis=-1)
    _, eidx = lax.top_k(jnp.where(emask, sel, -jnp.inf), TOPK_EXPERTS)
    gw = jnp.take_along_axis(scores, eidx, axis=-1)
    gw = gw / jnp.sum(gw, axis=-1, keepdims=True) * ROUTE_SCALE

    A = T * TOPK_EXPERTS
    e_flat = eidx.reshape(A)
    tok_flat = jnp.repeat(jnp.arange(T, dtype=jnp.int32), TOPK_EXPERTS)
    g_flat = gw.reshape(A)
    order = jnp.argsort(e_flat)
    se, st, sg = e_flat[order], tok_flat[order], g_flat[order]
    counts = jax.ops.segment_sum(jnp.ones_like(e_flat), e_flat, num_segments=N_EXPERTS)
    padded = (counts + EXPERT_BLOCK - 1) // EXPERT_BLOCK * EXPERT_BLOCK
    pad_end = jnp.cumsum(padded)
    pad_start = pad_end - padded
    start = jnp.cumsum(counts) - counts
    dest = pad_start[se] + jnp.arange(A, dtype=se.dtype) - start[se]
    nb = (A + EXPERT_BLOCK - 1) // EXPERT_BLOCK + N_EXPERTS
    rows = nb * EXPERT_BLOCK
    row_tok = jnp.zeros((rows,), jnp.int32).at[dest].set(st)
    row_g = jnp.zeros((rows,), hf.dtype).at[dest].set(sg.astype(hf.dtype))
    block_e = jnp.clip(jnp.searchsorted(pad_end, jnp.arange(nb, dtype=pad_end.dtype) * EXPERT_BLOCK, side="right"), 0, N_EXPERTS - 1)

    def body(y, args):
        tok_b, g_b, e_b = args
        xb = hf[tok_b]
        u = jax.nn.silu(xb @ w_gate[e_b]) * (xb @ w_up[e_b])
        yb = (u @ w_down[e_b]) * g_b[:, None]
        return y.at[tok_b].add(yb), None

    routed, _ = lax.scan(body, jnp.zeros((T, D), hf.dtype), (row_tok.reshape(nb, EXPERT_BLOCK), row_g.reshape(nb, EXPERT_BLOCK), block_e))
    shared = (jax.nn.silu(hf @ ws_gate) * (hf @ ws_up)) @ ws_down
    return (routed + shared).reshape(B, S, D)


def setup_inputs(seed: int = 0) -> dict:
    key = jax.random.key(seed)
    ks = jax.random.split(key, 32)
    L, D = DEPTH, D_MODEL

    def nrm(k, shape, scale):
        return jax.random.normal(k, shape, jnp.float32) * scale

    def gain(k, shape):
        return 1.0 + 0.02 * jax.random.normal(k, shape, jnp.float32)

    return {
        "x": nrm(ks[0], (BATCH, SEQ, D), 1.0),
        "c": nrm(ks[1], (BATCH, D), 1.0),
        "w_ada": nrm(ks[2], (L, D, 6 * D), 0.3 * D ** -0.5),
        "b_ada": nrm(ks[3], (L, 6 * D), 0.02),
        "g_mix_pre": gain(ks[4], (L, D)),
        "g_mix_post": gain(ks[5], (L, D)),
        "g_ffn_pre": gain(ks[6], (L, D)),
        "g_ffn_post": gain(ks[7], (L, D)),
        "w_in": nrm(ks[8], (L, D, IN_DIM), D ** -0.5),
        "conv_w": nrm(ks[9], (L, CONV_WIDTH, 2 * M_WIDTH), CONV_WIDTH ** -0.5),
        "conv_b": nrm(ks[10], (L, 2 * M_WIDTH), 0.02),
        "b_igate": nrm(ks[11], (L, M_HEADS), 0.1),
        "b_fgate": jnp.linspace(3.0, 6.0, M_HEADS, dtype=jnp.float32)[None, :] + nrm(ks[12], (L, M_HEADS), 0.02),
        "g_mlstm_head": gain(ks[13], (L, M_WIDTH)),
        "g_idx_k": gain(ks[14], (L, IDX_DIM)),
        "b_idx_k": nrm(ks[15], (L, IDX_DIM), 0.02),
        "w_out": nrm(ks[16], (L, MIX_WIDTH, D), MIX_WIDTH ** -0.5),
        "w_router": nrm(ks[17], (L, D, N_EXPERTS), D ** -0.5),
        "b_router": nrm(ks[18], (L, N_EXPERTS), 0.01),
        "w_exp_gate": nrm(ks[19], (L, N_EXPERTS, D, D_EXPERT), D ** -0.5),
        "w_exp_up": nrm(ks[20], (L, N_EXPERTS, D, D_EXPERT), D ** -0.5),
        "w_exp_down": nrm(ks[21], (L, N_EXPERTS, D_EXPERT, D), D_EXPERT ** -0.5),
        "w_sh_gate": nrm(ks[22], (L, D, D_SHARED), D ** -0.5),
        "w_sh_up": nrm(ks[23], (L, D, D_SHARED), D ** -0.5),
        "w_sh_down": nrm(ks[24], (L, D_SHARED, D), D_SHARED ** -0.5),
    }


def reference(x, c, w_ada, b_ada, g_mix_pre, g_mix_post, g_ffn_pre, g_ffn_post, w_in, conv_w, conv_b, b_igate, b_fgate, g_mlstm_head, g_idx_k, b_idx_k, w_out, w_router, b_router, w_exp_gate, w_exp_up, w_exp_down, w_sh_gate, w_sh_up, w_sh_down):
    B, S, D = x.shape
    pos = jnp.arange(S)
    offsets = np.cumsum(SPLIT_SIZES)[:-1].tolist()
    idx_w_scale = (IDX_HEADS ** -0.5) * (IDX_DIM ** -0.5)
    for l in range(DEPTH):
        mod = jax.nn.silu(c) @ w_ada[l] + b_ada[l]
        sh1, sc1, gt1, sh2, sc2, gt2 = jnp.split(mod[:, None, :], 6, axis=-1)

        h = rms_norm(x, g_mix_pre[l]) * (1.0 + sc1) + sh1
        proj = h @ w_in[l]
        mq, mk, mv, mo, mi, mf, aq, ak, av, iq, ik, iw = jnp.split(proj, offsets, axis=-1)

        qk = jax.nn.silu(causal_conv(jnp.concatenate([mq, mk], axis=-1), conv_w[l], conv_b[l]))
        mq, mk = jnp.split(qk, 2, axis=-1)
        hm = mlstm_chunkwise(mq.reshape(B, S, M_HEADS, M_HEAD_DIM), mk.reshape(B, S, M_HEADS, M_HEAD_DIM), mv.reshape(B, S, M_HEADS, M_HEAD_DIM), mi + b_igate[l], mf + b_fgate[l])
        hm = head_rms_norm(hm, g_mlstm_head[l]).reshape(B, S, M_WIDTH)
        hm = (jax.nn.sigmoid(mo.astype(jnp.float32)) * hm).astype(x.dtype)

        aq = partial_rope(aq.reshape(B, S, A_HEADS, A_HEAD_DIM), pos)
        ak = partial_rope(ak, pos)
        iq = partial_rope(iq.reshape(B, S, IDX_HEADS, IDX_DIM), pos)
        ik = partial_rope(layer_norm(ik, g_idx_k[l], b_idx_k[l]), pos)
        ha = dsa_attention(aq, ak, av, iq, ik, iw * idx_w_scale).reshape(B, S, A_WIDTH)

        y = jnp.concatenate([hm, ha], axis=-1) @ w_out[l]
        x = x + gt1 * rms_norm(y, g_mix_post[l])

        h2 = rms_norm(x, g_ffn_pre[l]) * (1.0 + sc2) + sh2
        y2 = moe_ffn(h2, w_router[l], b_router[l], w_exp_gate[l], w_exp_up[l], w_exp_down[l], w_sh_gate[l], w_sh_up[l], w_sh_down[l])
        x = x + gt2 * rms_norm(y2, g_ffn_post[l])
    return x
```

```cpp
#include <hip/hip_runtime.h>
#include <cstdio>
#include <cstdint>
#ifndef PROBE_DBL
#define PROBE_DBL -1
#endif
#define LAS __attribute__((address_space(3)))
typedef unsigned short bf16_t;
typedef short bf16x8 __attribute__((ext_vector_type(8)));
typedef float f32x4 __attribute__((ext_vector_type(4)));
typedef unsigned u32x4 __attribute__((ext_vector_type(4)));
typedef unsigned u32x2 __attribute__((ext_vector_type(2)));
typedef short v4i16_t __attribute__((ext_vector_type(4)));

constexpr int T_TOK = 65536, DM = 1024, SEQ = 4096, NB = 16;
constexpr int NPROJ = 3328; constexpr int PLD = 3072;
constexpr float EPS = 1e-6f;
constexpr int NTHR = 512;
constexpr size_t MB = 1u << 20;
constexpr size_t OFF_CTL = 0;
constexpr size_t OFF_MOD = 64 * 1024;
constexpr size_t CTL_ZERO_BYTES = 64 * 1024 + 512 * 1024;
constexpr size_t OFF_ROPE = 1 * MB;
constexpr size_t OFF_WR = 2 * MB;
constexpr size_t OFF_WIN = 3 * MB;
constexpr size_t OFF_WOUT = 10 * MB;
constexpr size_t OFF_WGU = 12 * MB;
constexpr size_t OFF_WDN = 80 * MB;
constexpr size_t OFF_ACTA = 116 * MB;
constexpr size_t OFF_P = 244 * MB;
constexpr size_t OFF_PROJ = OFF_P + 0;
constexpr size_t OFF_MQKC = OFF_P + 384 * MB;
constexpr size_t OFF_AK = OFF_P + 512 * MB;
constexpr size_t OFF_IK = OFF_P + 528 * MB;
constexpr size_t OFF_GATES = OFF_P + 536 * MB;
constexpr size_t OFF_IW = OFF_P + 538 * MB;
constexpr size_t OFF_PROJL = OFF_P + 540 * MB;
constexpr size_t OFF_HMRAW = OFF_P + 572 * MB;
constexpr size_t OFF_BITM = OFF_P + 636 * MB;
constexpr size_t OFF_GL = OFF_P + 668 * MB;
constexpr size_t OFF_Y = OFF_P + 0;
constexpr size_t OFF_H2LO = OFF_P + 128 * MB;
constexpr size_t OFF_SORTED = 932 * MB;
constexpr size_t OFF_GW = OFF_P + 272 * MB;
constexpr size_t OFF_H2Q = 868 * MB;
constexpr size_t OFF_U = 724 * MB;
constexpr size_t OFF_YE = 120 * MB;
constexpr size_t WS_NEED = 964 * MB;
constexpr int CW_BAR = 0;
constexpr int CW_CNT = 4096;
constexpr int CW_Q = 4352;
constexpr float YE_SCALE = 16.0f;

struct Params {
  const float *x, *c, *w_ada, *b_ada, *g_mix_pre, *g_mix_post, *g_ffn_pre, *g_ffn_post, *w_in, *conv_w, *conv_b, *b_igate, *b_fgate,
      *g_mlstm_head, *g_idx_k, *b_idx_k, *w_out, *w_router, *b_router, *w_exp_gate, *w_exp_up, *w_exp_down, *w_sh_gate, *w_sh_up, *w_sh_down;
  float* out; unsigned char* ws;
};

__device__ __forceinline__ unsigned f2bf(float f) { unsigned u = __builtin_bit_cast(unsigned, f); return (u + 0x7fffu + ((u >> 16) & 1u)) >> 16; }
typedef float f32x2_t __attribute__((ext_vector_type(2)));
typedef __bf16 bf16x2_t __attribute__((ext_vector_type(2)));
__device__ __forceinline__ unsigned pk2(float lo, float hi) { const f32x2_t v = {lo, hi}; const bf16x2_t b = __builtin_convertvector(v, bf16x2_t); return __builtin_bit_cast(unsigned, b); }
__device__ __forceinline__ float bf2f(unsigned h) { return __builtin_bit_cast(float, h << 16); }
__device__ __forceinline__ float bflo(unsigned w) { return __builtin_bit_cast(float, w << 16); }
__device__ __forceinline__ float bfhi(unsigned w) { return __builtin_bit_cast(float, w & 0xffff0000u); }
typedef unsigned u32x2s_t __attribute__((ext_vector_type(2)));
__device__ __forceinline__ float rowmax4(float v) {
  unsigned b = __builtin_bit_cast(unsigned, v);
  u32x2s_t r = __builtin_amdgcn_permlane16_swap(b, b, false, false);
  unsigned r0 = r.x, r1 = r.y;
  v = fmaxf(__builtin_bit_cast(float, r0), __builtin_bit_cast(float, r1));
  b = __builtin_bit_cast(unsigned, v);
  r = __builtin_amdgcn_permlane32_swap(b, b, false, false);
  r0 = r.x; r1 = r.y;
  return fmaxf(__builtin_bit_cast(float, r0), __builtin_bit_cast(float, r1));
}
__device__ __forceinline__ float rowsum4(float v) {
  unsigned b = __builtin_bit_cast(unsigned, v);
  u32x2s_t r = __builtin_amdgcn_permlane16_swap(b, b, false, false);
  unsigned r0 = r.x, r1 = r.y;
  v = __builtin_bit_cast(float, r0) + __builtin_bit_cast(float, r1);
  b = __builtin_bit_cast(unsigned, v);
  r = __builtin_amdgcn_permlane32_swap(b, b, false, false);
  r0 = r.x; r1 = r.y;
  return __builtin_bit_cast(float, r0) + __builtin_bit_cast(float, r1);
}
__device__ __forceinline__ float wave_sum(float v) {
#pragma unroll
  for (int m = 32; m >= 1; m >>= 1) v += __shfl_xor(v, m);
  return v;
}
__device__ __forceinline__ int opaque_tid() { int t = threadIdx.x; asm volatile("" : "+v"(t)); return t; }
__device__ __forceinline__ float sigmoidf_(float x) { return __builtin_amdgcn_rcpf(1.0f + __expf(-x)); }
__device__ __forceinline__ float siluf_(float x) { return x * __builtin_amdgcn_rcpf(1.0f + __expf(-x)); }

#define XB_TMO      128
#define XB_XCNT(j)  (256  + 64 * (j))
#define XB_XSUB(j)  (1280 + 64 * (j))
#define XB_XGEN(j)  (2304 + 64 * (j))
#define XB_TOP      3328
#define XB_TOPGEN   3392
#define XCD_BAR_WORDS 3456
#define XB_SPIN_CAP (1u << 24)
__device__ __forceinline__ unsigned xb_ld(unsigned* p)              { return __hip_atomic_load(p, __ATOMIC_RELAXED, __HIP_MEMORY_SCOPE_AGENT); }
__device__ __forceinline__ unsigned xb_add(unsigned* p, unsigned v) { return __hip_atomic_fetch_add(p, v, __ATOMIC_RELAXED, __HIP_MEMORY_SCOPE_AGENT); }
__device__ __forceinline__ unsigned xb_xcc_id() { return (unsigned)__builtin_amdgcn_s_getreg((3 << 11) | 20) & 0xFu; }
#define XB_SPIN(cond, bar) do { unsigned _sp = 0; while (cond) { __builtin_amdgcn_s_sleep(1); \
    if ((++_sp & 255u) == 0u) { if (xb_ld(&(bar)[XB_TMO])) break; if (_sp > XB_SPIN_CAP) { xb_add(&(bar)[XB_TMO], 1u); break; } } } } while (0)
struct XcdBarrier { unsigned* bar; volatile LAS unsigned* st; };
__device__ __forceinline__ XcdBarrier xcd_barrier_post(unsigned* bar, volatile LAS unsigned* st) {
    XcdBarrier b; b.bar = bar; b.st = st;
    if (threadIdx.x == 0) { const unsigned x = xb_xcc_id(); st[2] = x; (void)xb_add(&bar[XB_XCNT(x)], 1u); }
    return b;
}
__device__ __forceinline__ void xcd_barrier_complete(unsigned* bar, unsigned x, unsigned& nloc, unsigned& nx) {
    const unsigned G = gridDim.x * gridDim.y * gridDim.z;
    unsigned sum, cnt, mine, sp = 0u;
    for (;;) {
        sum = 0u; cnt = 0u; mine = 0u;
#pragma unroll
        for (unsigned j = 0; j < 16; ++j) { const unsigned c = xb_ld(&bar[XB_XCNT(j)]); sum += c; cnt += (c > 0u) ? 1u : 0u; mine = (j == x) ? c : mine; }
        if (sum == G) break;
        __builtin_amdgcn_s_sleep(1);
        if ((++sp & 255u) == 0u) { if (xb_ld(&bar[XB_TMO])) break; if (sp > XB_SPIN_CAP) { xb_add(&bar[XB_TMO], 1u); break; } }
    }
    nloc = mine > 0u ? mine : 1u; nx = cnt > 0u ? cnt : 1u;
}
__device__ __forceinline__ void xcd_barrier(const XcdBarrier& b) {
    asm volatile("s_waitcnt vmcnt(0)" ::: "memory");
    __syncthreads();
    if (threadIdx.x == 0) {
        unsigned* bar = b.bar;
        __builtin_amdgcn_s_waitcnt(0);
        unsigned nloc = b.st[0], nx = b.st[1]; const unsigned bx = b.st[2];
        if (nloc == 0u) { xcd_barrier_complete(bar, bx, nloc, nx); b.st[0] = nloc; b.st[1] = nx; }
        const unsigned old = xb_add(&bar[XB_XSUB(bx)], 1u);
        const unsigned gen = old / nloc;
        if (old + 1u == (gen + 1u) * nloc) {
            __builtin_amdgcn_fence(__ATOMIC_RELEASE, "agent");
            asm volatile("s_waitcnt vmcnt(0)" ::: "memory");
            const unsigned og = xb_add(&bar[XB_TOP], 1u);
            const unsigned tg = og / nx;
            if (og + 1u == (tg + 1u) * nx) xb_add(&bar[XB_TOPGEN], 1u);
            else XB_SPIN(xb_ld(&bar[XB_TOPGEN]) == tg, bar);
            __builtin_amdgcn_fence(__ATOMIC_ACQUIRE, "agent");
            xb_add(&bar[XB_XGEN(bx)], 1u);
            asm volatile("s_waitcnt vmcnt(0)" ::: "memory");
        } else {
            XB_SPIN(xb_ld(&bar[XB_XGEN(bx)]) == gen, bar);
            __builtin_amdgcn_fence(__ATOMIC_ACQUIRE, "agent");
            asm volatile("s_waitcnt vmcnt(0)" ::: "memory");
        }
    }
    __syncthreads();
}

extern __shared__ __attribute__((aligned(16))) unsigned char smem_raw[];
#define SMEM ((LAS unsigned char*)smem_raw)
constexpr int LDS_ST = 0;
constexpr int LDS_MISC = 16;
constexpr int LDS_MAIN = 1040;
constexpr int LDS_BYTES = 160 * 1024;
constexpr int GT_STAGE = 32768, TILE_LD = 132;
__device__ __forceinline__ int swz_off(int r, int c8) { return r * 128 + ((c8 ^ (r & 7)) << 4); }
template <int NSEG> struct GemmArgs { const bf16_t *A0, *A1, *A2, *B0, *B1, *B2; int lda, ldb, K; };

template <int NSEG, bool NTA = false>
__device__ __forceinline__ void gemm_mainloop(const GemmArgs<NSEG>& g, long arow0, long arow1) {
  const int tid = opaque_tid(), lane = tid & 63, wid = __builtin_amdgcn_readfirstlane(tid >> 6), wr = wid >> 2, wc = wid & 3, fr = lane & 15, fq = lane >> 4;
  const int r0 = tid >> 3, cs = ((tid & 7) ^ (r0 & 7)) * 8;
  const int nk = g.K >> 6, nsteps = NSEG * nk;
  f32x4 acc[4][2];
#pragma unroll
  for (int m = 0; m < 4; ++m)
#pragma unroll
    for (int n = 0; n < 2; ++n) acc[m][n] = (f32x4){0.f, 0.f, 0.f, 0.f};
  LAS unsigned char* ring = SMEM + LDS_MAIN;
#define GM_ISSUE(s_) do { int s1_ = (s_) < nsteps ? (s_) : nsteps - 1; int seg_ = 0, ks_ = s1_; if (NSEG > 1) { seg_ = s1_ / nk; ks_ = s1_ - seg_ * nk; } \
    const bf16_t* Ap_ = g.A0; const bf16_t* Bp_ = g.B0; if (NSEG > 1) { if (seg_ == 1) { Ap_ = g.A1; Bp_ = g.B1; } else if (seg_ == 2) { Ap_ = g.A2; Bp_ = g.B2; } } \
    LAS unsigned char* st_ = ring + ((s_) & 3) * GT_STAGE + wid * 1024; const int k0_ = ks_ * 64 + cs; \
    if (NTA) { __builtin_amdgcn_global_load_lds((const unsigned*)(Ap_ + arow0 * g.lda + k0_), (LAS unsigned*)st_, 16, 0, 2); __builtin_amdgcn_global_load_lds((const unsigned*)(Ap_ + arow1 * g.lda + k0_), (LAS unsigned*)(st_ + 8192), 16, 0, 2); } \
    else { __builtin_amdgcn_global_load_lds((const unsigned*)(Ap_ + arow0 * g.lda + k0_), (LAS unsigned*)st_, 16, 0, 0); __builtin_amdgcn_global_load_lds((const unsigned*)(Ap_ + arow1 * g.lda + k0_), (LAS unsigned*)(st_ + 8192), 16, 0, 0); } \
    __builtin_amdgcn_global_load_lds((const unsigned*)(Bp_ + (long)r0 * g.ldb + k0_), (LAS unsigned*)(st_ + 16384), 16, 0, 0); \
    __builtin_amdgcn_global_load_lds((const unsigned*)(Bp_ + (long)(r0 + 64) * g.ldb + k0_), (LAS unsigned*)(st_ + 16384 + 8192), 16, 0, 0); } while (0)
  asm volatile("s_waitcnt vmcnt(0)" ::: "memory");
  GM_ISSUE(0); GM_ISSUE(1); GM_ISSUE(2);
#pragma unroll 1
  for (int s = 0; s < nsteps; ++s) {
    asm volatile("s_waitcnt vmcnt(8)" ::: "memory");
    asm volatile("s_waitcnt lgkmcnt(0)" ::: "memory");
    __builtin_amdgcn_s_barrier();
    GM_ISSUE(s + 3);
    LAS unsigned char* sa = ring + (s & 3) * GT_STAGE;
    LAS unsigned char* sb = sa + 16384;
#pragma unroll
    for (int kk = 0; kk < 2; ++kk) {
      bf16x8 af[4], bfr[2];
#pragma unroll
      for (int m = 0; m < 4; ++m) af[m] = *(LAS bf16x8*)(sa + swz_off(wr * 64 + m * 16 + fr, kk * 4 + fq));
#pragma unroll
      for (int n = 0; n < 2; ++n) bfr[n] = *(LAS bf16x8*)(sb + swz_off(wc * 32 + n * 16 + fr, kk * 4 + fq));
#pragma unroll
      for (int m = 0; m < 4; ++m)
#pragma unroll
        for (int n = 0; n < 2; ++n) acc[m][n] = __builtin_amdgcn_mfma_f32_16x16x32_bf16(af[m], bfr[n], acc[m][n], 0, 0, 0);
    }
  }
#undef GM_ISSUE
  asm volatile("s_waitcnt vmcnt(0)" ::: "memory");
  asm volatile("s_waitcnt lgkmcnt(0)" ::: "memory");
  __builtin_amdgcn_s_barrier();
  LAS float* tile = (LAS float*)(SMEM + LDS_MAIN);
#pragma unroll
  for (int m = 0; m < 4; ++m)
#pragma unroll
    for (int n = 0; n < 2; ++n)
#pragma unroll
      for (int j = 0; j < 4; ++j) tile[(wr * 64 + m * 16 + fq * 4 + j) * TILE_LD + wc * 32 + n * 16 + fr] = acc[m][n][j];
  __syncthreads();
}
template <int NSEG, class Epi>
__device__ __forceinline__ void gemm_tile(const GemmArgs<NSEG>& g, long arow0, long arow1, Epi&& epi) {
  gemm_mainloop<NSEG>(g, arow0, arow1);
  LAS const float* tile = (LAS const float*)(SMEM + LDS_MAIN);
  const int tid = opaque_tid();
#pragma unroll 1
  for (int i = 0; i < 4; ++i) { const int id = tid + i * NTHR; epi(tile, id >> 4, (id & 15) * 8); }
  __syncthreads();
}
__device__ __forceinline__ u32x4 pack8(LAS const float* p) {
  const f32x4 v0 = *(LAS const f32x4*)p, v1 = *(LAS const f32x4*)(p + 4);
  u32x4 w; w.x = pk2(v0[0], v0[1]); w.y = pk2(v0[2], v0[3]); w.z = pk2(v1[0], v1[1]); w.w = pk2(v1[2], v1[3]); return w;
}

__device__ __forceinline__ int win_rowmap(int n) {
  if (n < 2048) return n;
  if (n < 2056) return 3136 + (n - 2048);
  if (n < 2568) return 2048 + (n - 2056);
  if (n < 2696) return 2560 + (n - 2568);
  if (n < 2824) return 2688 + (n - 2696);
  if (n < 3080) return 2816 + (n - 2824);
  if (n < 3144) return 3072 + (n - 3080);
  return n;
}
template <int KIND, int MODE>
__device__ __forceinline__ void cvt_tile(const float* src, int ld_src, int nvalid, int k0, int n0, bf16_t* dst, int ld_dst) {
  LAS bf16_t* tt = (LAS bf16_t*)(SMEM + LDS_MAIN);
  const int tid = opaque_tid();
  {
    const int n = tid & 63, kb = tid >> 6;
    const bool ok = (n0 + n) < nvalid;
#pragma unroll
    for (int i = 0; i < 8; ++i) {
      const int k = kb + 8 * i;
      float v = ok ? src[(long)(k0 + k) * ld_src + n0 + n] : 0.f;
      unsigned h = f2bf(v);
      if (MODE == 1) h = f2bf(v - bf2f(h));
      tt[n * 72 + k] = (bf16_t)h;
    }
  }
  __syncthreads();
  {
    const int n = tid >> 3, kc = tid & 7; const int nn = n0 + n;
    int r;
    if (KIND == 0) r = nn; else if (KIND == 1) r = win_rowmap(nn); else if (KIND == 2) r = (nn >> 2) * 8 + (nn & 3); else r = (nn >> 2) * 8 + 4 + (nn & 3);
    const u32x4 v = *(LAS const u32x4*)(tt + n * 72 + kc * 8);
    *(u32x4*)(dst + (long)r * ld_dst + k0 + kc * 8) = v;
  }
  __syncthreads();
}
template <int KIND>
__device__ __forceinline__ void cvt_tile8(const float* src, int ld_src, int k0, int n0, unsigned char* dst, int ld_dst, float scale) {
  LAS unsigned char* tt = SMEM + LDS_MAIN;
  const int tid = opaque_tid();
  {
    const int n = tid & 63, kb = tid >> 6;
#pragma unroll
    for (int i = 0; i < 4; ++i) {
      const int k = kb * 2 + 16 * i;
      const float v0 = __builtin_amdgcn_fmed3f(src[(long)(k0 + k) * ld_src + n0 + n] * scale, -448.f, 448.f), v1 = __builtin_amdgcn_fmed3f(src[(long)(k0 + k + 1) * ld_src + n0 + n] * scale, -448.f, 448.f);
      const int w = __builtin_amdgcn_cvt_pk_fp8_f32(v0, v1, 0, false);
      *(LAS unsigned short*)(tt + n * 80 + k) = (unsigned short)(w & 0xffff);
    }
  }
  __syncthreads();
  if (tid < 256) {
    const int n = tid >> 2, kc = tid & 3; const int nn = n0 + n;
    int r;
    if (KIND == 0) r = nn; else if (KIND == 2) r = (nn >> 2) * 8 + (nn & 3); else r = (nn >> 2) * 8 + 4 + (nn & 3);
    const u32x4 v = *(LAS const u32x4*)(tt + n * 80 + kc * 16);
    *(u32x4*)(dst + (long)r * ld_dst + k0 + kc * 16) = v;
  }
  __syncthreads();
}
__device__ __forceinline__ void sincos_d(double a, float& s, float& c) {
  const double twopi = 6.283185307179586476925286766559, inv = 0.15915494309189533576888376337251;
  const double k = __builtin_rint(a * inv);
  const double r = a - k * twopi;
  const double r2 = r * r;
  double ts = 1.0, tc = 1.0, ss = 1.0, cs = 1.0;
#pragma unroll
  for (int i = 1; i <= 13; ++i) { tc = -tc * r2 / (double)((2 * i - 1) * (2 * i)); cs += tc; ts = -ts * r2 / (double)((2 * i) * (2 * i + 1)); ss += ts; }
  s = (float)(r * ss); c = (float)cs;
}
__device__ __forceinline__ void phase0(const Params& p) {
  unsigned char* ws = p.ws;
  const int tid = opaque_tid();
  constexpr int U_WIN = 16 * 52, U_WOUT = 256, U_EG = 65 * 64, U_EU = 65 * 64, U_ED = 65 * 64, U_R = 64, U_ADA = 48, U_ROPE = 192;
  constexpr int B1 = U_WIN, B2 = B1 + U_WOUT, B3 = B2 + U_EG, B4 = B3 + U_EU, B5 = B4 + U_ED, B6 = B5 + U_R, B7 = B6 + U_ADA, B8 = B7 + U_ROPE;
  for (int u = blockIdx.x; u < B8; u += gridDim.x) {
    if (u < B1) { const int kt = u / 52, nt = u % 52; cvt_tile<1, 0>(p.w_in, 3148, 3148, kt * 64, nt * 64, (bf16_t*)(ws + OFF_WIN), 1024); }
    else if (u < B2) { const int v = u - B1, kt = v >> 4, nt = v & 15; cvt_tile<0, 0>(p.w_out, 1024, 1024, kt * 64, nt * 64, (bf16_t*)(ws + OFF_WOUT), 1024); }
    else if (u < B4) {
      const bool up = u >= B3; const int v = up ? u - B3 : u - B2; const int e = v >> 6, kt = (v >> 2) & 15, nt = v & 3;
      const float* src = (e < 64) ? ((up ? p.w_exp_up : p.w_exp_gate) + (size_t)e * 1024 * 256) : (up ? p.w_sh_up : p.w_sh_gate);
      unsigned char* dst = ws + OFF_WGU + (size_t)e * 512 * 1024;
      if (up) cvt_tile8<3>(src, 256, kt * 64, nt * 64, dst, 1024, 32.0f); else cvt_tile8<2>(src, 256, kt * 64, nt * 64, dst, 1024, 32.0f);
    }
    else if (u < B5) {
      const int v = u - B4; const int e = v >> 6, kt = (v >> 4) & 3, nt = v & 15;
      const float* src = (e < 64) ? (p.w_exp_down + (size_t)e * 256 * 1024) : p.w_sh_down;
      cvt_tile8<0>(src, 1024, kt * 64, nt * 64, ws + OFF_WDN + (size_t)e * 1024 * 256, 256, 16.0f);
    }
    else if (u < B6) {
      const int v = u - B5; const int lo = v >> 5, kt = (v >> 1) & 15, nt = v & 1;
      bf16_t* dst = (bf16_t*)(ws + OFF_WR) + (size_t)lo * 128 * 1024;
      if (lo) cvt_tile<0, 1>(p.w_router, 64, 64, kt * 64, nt * 64, dst, 1024); else cvt_tile<0, 0>(p.w_router, 64, 64, kt * 64, nt * 64, dst, 1024);
    }
    else if (u < B7) {
      const int v = u - B6;
      LAS float* sc = (LAS float*)(SMEM + LDS_MAIN);
      LAS float* part = sc + 16 * 1024;
      for (int i = tid; i < 16 * 1024; i += NTHR) sc[i] = siluf_(p.c[i]);
      __syncthreads();
      const int jl = tid & 127, dq = tid >> 7, j = v * 128 + jl;
      float acc[16];
#pragma unroll
      for (int b = 0; b < 16; ++b) acc[b] = 0.f;
      const float* wp = p.w_ada + (size_t)(dq * 256) * 6144 + j;
#pragma unroll 4
      for (int d = 0; d < 256; ++d) {
        const float w = wp[(size_t)d * 6144];
#pragma unroll
        for (int b = 0; b < 16; ++b) acc[b] += sc[b * 1024 + dq * 256 + d] * w;
      }
#pragma unroll
      for (int b = 0; b < 16; ++b) part[(dq * 16 + b) * 128 + jl] = acc[b];
      __syncthreads();
      float* mod = (float*)(ws + OFF_MOD);
      for (int i = tid; i < 16 * 128; i += NTHR) {
        const int b = i >> 7, jj = i & 127;
        mod[b * 6144 + v * 128 + jj] = ((part[(0 * 16 + b) * 128 + jj] + part[(1 * 16 + b) * 128 + jj]) + (part[(2 * 16 + b) * 128 + jj] + part[(3 * 16 + b) * 128 + jj])) + p.b_ada[v * 128 + jj];
      }
      __syncthreads();
    }
    else {
      const int v = u - B7; const int idx = v * NTHR + tid;
      const int pos = idx / 24, f = idx - pos * 24;
      const double lt = 13.122363377404328;
      float s, c;
      if (f < 16) { const double inv = exp(-lt * (double)f * (2.0 / 32.0)); sincos_d((double)pos * inv, s, c);
        float* R = (float*)(ws + OFF_ROPE); R[(pos * 16 + f) * 2] = c; R[(pos * 16 + f) * 2 + 1] = s; }
      else { const int g = f - 16; const double inv = exp(-lt * (double)g * (2.0 / 16.0)); sincos_d((double)pos * inv, s, c);
        float* R = (float*)(ws + OFF_ROPE) + 4096 * 32; R[(pos * 8 + g) * 2] = c; R[(pos * 8 + g) * 2 + 1] = s; }
    }
  }
}
namespace pg8 {
constexpr int BM = 256, BK = 64, HALF = 128, HTB = HALF * BK * 2, STAGE_BYTES = 8 * HTB;
__device__ __forceinline__ int lds_byte(int r, int c) { const int st = (r >> 4) * 2 + (c >> 5), rr = r & 15, cc = c & 31, ob = rr * 64 + cc * 2; return st * 1024 + (ob ^ (((ob >> 9) & 1) << 5)); }
__device__ __forceinline__ void stage_rc(int b, int& R, int& C) { const int st = b / 1024, sb = b % 1024, swz = sb ^ (((sb >> 9) & 1) << 5); R = (st >> 1) * 16 + swz / 64; C = (st & 1) * 32 + (swz % 64) / 2; }
__device__ __forceinline__ int perm32(int rho) { const int n = rho >> 4, i = rho & 15; return 8 * (i >> 2) + 4 * n + (i & 3); }
struct Unit { int pm, pn, e, lt; };
typedef int v8i_t __attribute__((ext_vector_type(8)));
typedef int v4i_t __attribute__((ext_vector_type(4)));
template <class Epi, class Sched, bool FP8 = false, int WI = 0>
__device__ __forceinline__ void gemm_phase(LAS unsigned char* lds, const bf16_t* Abase, const int K, const Sched& S, const Epi& E) {
    const int tid = opaque_tid(), wid = __builtin_amdgcn_readfirstlane(tid >> 6), lane = tid & 63, wr = wid >> 2, wc = wid & 3, fr = lane & 15, fq = lane >> 4;
    const int nt = K / BK;
    int Rr[2], Cc[2]; unsigned voffB[2];
#pragma unroll
    for (int i = 0; i < 2; ++i) { int R, C; stage_rc(tid * 16 + i * 8192, R, C); Rr[i] = R; Cc[i] = C * 2; const int Rb = (R & ~31) + perm32(R & 31); voffB[i] = (unsigned)(Rb * K + C) * 2u; }
    const size_t kstep = (size_t)(BK * 2);
    const size_t hstep = (size_t)HALF * K * 2;
    const unsigned ldsw = (unsigned)wid * 1024u;
    const int aoff = lds_byte(wr * 64 + fr, fq * 8), boff = lds_byte(wc * 32 + fr, fq * 8);
    const char* Ab = (const char*)Abase;
    LAS unsigned char* recb = lds + STAGE_BYTES;
#define PG8_RECISSUE(u_, slot_) do { if (Sched::REC) __builtin_amdgcn_global_load_lds((const unsigned*)(S.rec_ptr(u_) + tid * 4), (LAS unsigned*)(recb + (slot_) * 2048 + wid * 256), 4, 0, 0); } while (0)
#define PG8_AOFF(u_, slot_, row_) ((Sched::REC && S.has_rec(u_)) ? S.a_off_idx(u_, row_, *(const LAS int*)(recb + (slot_) * 2048 + (S.row_valid(u_, row_) ? (row_) : 0) * 8)) : S.a_off(u_, row_))
#define PG8_SA(b, h) (((b) * 2 + (h)) * HTB)
#define PG8_SB(b, h) ((4 + (b) * 2 + (h)) * HTB)
#define PG8_STAGEB(bufoff, gbase) do { if (!(WI & 2)) _Pragma("unroll") for (int _i = 0; _i < 2; ++_i) \
        __builtin_amdgcn_global_load_lds((const unsigned*)((const char*)(gbase) + voffB[_i]), (LAS unsigned*)(lds + (bufoff) + ldsw + _i * 8192), 16, 0, 0); } while (0)
#define PG8_STAGEA(bufoff, koff, o0, o1) do { if (!(WI & 1)) { \
        __builtin_amdgcn_global_load_lds((const unsigned*)(Ab + (koff) + (o0)), (LAS unsigned*)(lds + (bufoff) + ldsw), 16, 0, 0); \
        __builtin_amdgcn_global_load_lds((const unsigned*)(Ab + (koff) + (o1)), (LAS unsigned*)(lds + (bufoff) + ldsw + 8192), 16, 0, 0); } } while (0)
#define PG8_LDA(dst, b, h) do { if (!(WI & 8)) _Pragma("unroll") for (int m = 0; m < 4; ++m) { dst[m].lo = *(const LAS v4i_t*)(lds + PG8_SA(b, h) + aoff + m * 2048); dst[m].hi = *(const LAS v4i_t*)(lds + PG8_SA(b, h) + aoff + m * 2048 + 1024); } } while (0)
#define PG8_LDB(dst, b, h) do { if (!(WI & 8)) _Pragma("unroll") for (int n = 0; n < 2; ++n) { dst[n].lo = *(const LAS v4i_t*)(lds + PG8_SB(b, h) + boff + n * 2048); dst[n].hi = *(const LAS v4i_t*)(lds + PG8_SB(b, h) + boff + n * 2048 + 1024); } } while (0)
#define PG8_MMA(ai, bj, At, Bt) do { __builtin_amdgcn_s_setprio(1); if (!(WI & 16)) _Pragma("unroll") for (int m = 0; m < 4; ++m) _Pragma("unroll") for (int n = 0; n < 2; ++n) { \
        if (FP8) asm volatile("v_mfma_scale_f32_16x16x128_f8f6f4 %0, %1, %2, %0, %3, %4 op_sel_hi:[0,0,0]" : "+v"(acc[ai][bj][m][n]) : "v"(Bt[n]), "v"(At[m]), "v"(sclB), "v"(sclA)); \
        else { const v4i_t bl_ = Bt[n].lo, bh_ = Bt[n].hi, al_ = At[m].lo, ah_ = At[m].hi;     \
               acc[ai][bj][m][n] = __builtin_amdgcn_mfma_f32_16x16x32_bf16(__builtin_bit_cast(bf16x8, bl_), __builtin_bit_cast(bf16x8, al_), acc[ai][bj][m][n], 0, 0, 0); \
               acc[ai][bj][m][n] = __builtin_amdgcn_mfma_f32_16x16x32_bf16(__builtin_bit_cast(bf16x8, bh_), __builtin_bit_cast(bf16x8, ah_), acc[ai][bj][m][n], 0, 0, 0); } } \
        __builtin_amdgcn_s_setprio(0); } while (0)
#define PG8_WAIT_V(n) asm volatile("s_waitcnt vmcnt(" #n ")" ::: "memory")
#define PG8_WAIT_L(n) asm volatile("s_waitcnt lgkmcnt(" #n ")" ::: "memory")
#define PG8_BAR do { if (!(WI & 32)) __builtin_amdgcn_s_barrier(); } while (0)
#define PG8_SCHED __builtin_amdgcn_sched_barrier(0)
    Unit cur, nxt; int ui = 0;
    if (!S.next(0, cur)) return;
    f32x4 acc[2][2][4][2];
#pragma unroll
    for (int a = 0; a < 2; ++a)
#pragma unroll
        for (int b = 0; b < 2; ++b)
#pragma unroll
            for (int m = 0; m < 4; ++m)
#pragma unroll
                for (int n = 0; n < 2; ++n) acc[a][b][m][n] = (f32x4){0.f, 0.f, 0.f, 0.f};
    v8i_t At[4], B0[2], B1[2];
    if (WI & 8) { _Pragma("unroll") for (int m = 0; m < 4; ++m) At[m] = (v8i_t){tid, m, 3, 4, 5, 6, 7, 8}; B0[0] = B0[1] = B1[0] = B1[1] = (v8i_t){tid, 1, 2, 3, 4, 5, 6, 7}; }
    int sclA = Sched::SCALE_A, sclB = Sched::SCALE_B; asm volatile("" : "+v"(sclA), "+v"(sclB));
    const char* cB = S.b_base(cur);
    Unit nn; bool has_nn = false;
    if (Sched::REC) { has_nn = S.next(1, nn); PG8_RECISSUE(cur, 0); PG8_RECISSUE(has_nn ? nn : cur, 1); asm volatile("s_waitcnt vmcnt(0)" ::: "memory"); __syncthreads(); }
    unsigned vc00 = PG8_AOFF(cur, 0, Rr[0]) + Cc[0], vc01 = PG8_AOFF(cur, 0, Rr[1]) + Cc[1], vc10 = PG8_AOFF(cur, 0, HALF + Rr[0]) + Cc[0], vc11 = PG8_AOFF(cur, 0, HALF + Rr[1]) + Cc[1];
    int slot = 0;
    PG8_STAGEB(PG8_SB(0, 0), cB); PG8_STAGEB(PG8_SB(0, 1), cB + hstep); PG8_STAGEA(PG8_SA(0, 0), 0, vc00, vc01); PG8_STAGEA(PG8_SA(0, 1), 0, vc10, vc11);
    if (wr == 1) PG8_BAR;
    PG8_WAIT_V(2); PG8_BAR;
    PG8_STAGEB(PG8_SB(1, 0), cB + kstep); PG8_STAGEA(PG8_SA(1, 0), kstep, vc00, vc01); PG8_STAGEB(PG8_SB(1, 1), cB + hstep + kstep);
    PG8_WAIT_V(6); PG8_BAR;
    for (;;) {
        bool has_next;
        if (Sched::REC) { has_next = has_nn; nxt = nn; has_nn = S.next(ui + 2, nn); } else has_next = S.next(ui + 1, nxt);
        const char* nB = has_next ? S.b_base(nxt) : cB;
        unsigned vn00 = vc00, vn01 = vc01, vn10 = vc10, vn11 = vc11;
        const int nslot = (slot + 1) & 3;
        if (Sched::REC) { PG8_RECISSUE(has_nn ? nn : cur, (slot + 2) & 3); }
        else if (has_next) { vn00 = S.a_off(nxt, Rr[0]) + Cc[0]; vn01 = S.a_off(nxt, Rr[1]) + Cc[1]; vn10 = S.a_off(nxt, HALF + Rr[0]) + Cc[0]; vn11 = S.a_off(nxt, HALF + Rr[1]) + Cc[1]; }
#pragma unroll 1
        for (int t = 0; t < nt; t += 2) {
            const bool last = (t == nt - 2);
            const size_t ko1 = (size_t)(t + 1) * kstep;
            const size_t ko2 = last ? 0 : (size_t)(t + 2) * kstep, ko3 = ko2 + kstep;
            const char* b2 = last ? nB : cB + (size_t)(t + 2) * kstep; const char* b3 = b2 + kstep;
            if (Sched::REC && last && has_next) {
                if (S.has_rec(nxt)) {
                    const int nv = S.nvalid(nxt); LAS const unsigned char* rb = recb + nslot * 2048;
                    const int q00 = Rr[0] < nv ? Rr[0] : 0, q01 = Rr[1] < nv ? Rr[1] : 0, q10 = (HALF + Rr[0]) < nv ? (HALF + Rr[0]) : 0, q11 = (HALF + Rr[1]) < nv ? (HALF + Rr[1]) : 0;
                    const int i00 = *(LAS const int*)(rb + q00 * 8), i01 = *(LAS const int*)(rb + q01 * 8), i10 = *(LAS const int*)(rb + q10 * 8), i11 = *(LAS const int*)(rb + q11 * 8);
                    vn00 = S.a_off_idx(nxt, 0, i00) + Cc[0]; vn01 = S.a_off_idx(nxt, 0, i01) + Cc[1]; vn10 = S.a_off_idx(nxt, 0, i10) + Cc[0]; vn11 = S.a_off_idx(nxt, 0, i11) + Cc[1];
                } else { vn00 = S.a_off(nxt, Rr[0]) + Cc[0]; vn01 = S.a_off(nxt, Rr[1]) + Cc[1]; vn10 = S.a_off(nxt, HALF + Rr[0]) + Cc[0]; vn11 = S.a_off(nxt, HALF + Rr[1]) + Cc[1]; }
            }
            const unsigned o00 = last ? vn00 : vc00, o01 = last ? vn01 : vc01, o10 = last ? vn10 : vc10, o11 = last ? vn11 : vc11;
            PG8_LDB(B0, 0, 0); PG8_LDB(B1, 0, 1); PG8_SCHED; PG8_LDA(At, 0, 0); PG8_STAGEA(PG8_SA(1, 1), ko1, vc10, vc11);
            PG8_WAIT_V(8); PG8_WAIT_L(0); PG8_BAR; PG8_MMA(0, 0, At, B0); PG8_MMA(0, 1, At, B1); PG8_BAR; PG8_SCHED;
            PG8_LDA(At, 0, 1); PG8_STAGEB(PG8_SB(0, 0), b2); PG8_STAGEB(PG8_SB(0, 1), b2 + hstep); PG8_STAGEA(PG8_SA(0, 0), ko2, o00, o01);
            PG8_WAIT_V(8); PG8_WAIT_L(0); PG8_BAR; PG8_MMA(1, 0, At, B0); PG8_MMA(1, 1, At, B1); PG8_BAR; PG8_SCHED;
            PG8_LDB(B0, 1, 0); PG8_LDB(B1, 1, 1); PG8_SCHED; PG8_LDA(At, 1, 0); PG8_STAGEA(PG8_SA(0, 1), ko2, o10, o11);
            PG8_WAIT_V(8); PG8_WAIT_L(0); PG8_BAR; PG8_MMA(0, 0, At, B0); PG8_MMA(0, 1, At, B1); PG8_BAR; PG8_SCHED;
            PG8_LDA(At, 1, 1); PG8_STAGEB(PG8_SB(1, 0), b3); PG8_STAGEB(PG8_SB(1, 1), b3 + hstep); PG8_STAGEA(PG8_SA(1, 0), ko3, o00, o01);
            PG8_WAIT_V(8); PG8_WAIT_L(0); PG8_BAR; PG8_MMA(1, 0, At, B0); PG8_MMA(1, 1, At, B1); PG8_BAR; PG8_SCHED;
        }
        if (wr == 0) PG8_BAR;
        if (FP8) asm volatile("s_nop 15\n\ts_nop 15" ::: "memory");
        if (!(WI & 4)) E(acc, cur, wr, wc, fr, fq, (LAS const unsigned char*)(recb + slot * 2048));
        if (PROBE_DBL == 81 && FP8 && K == 128) E(acc, cur, wr, wc, fr, fq, (LAS const unsigned char*)(recb + slot * 2048));
        if (PROBE_DBL == 71 && FP8 && K == 512) E(acc, cur, wr, wc, fr, fq, (LAS const unsigned char*)(recb + slot * 2048));
        if (!has_next) break;
#pragma unroll
        for (int a = 0; a < 2; ++a)
#pragma unroll
            for (int b = 0; b < 2; ++b)
#pragma unroll
                for (int m = 0; m < 4; ++m)
#pragma unroll
                    for (int n = 0; n < 2; ++n) acc[a][b][m][n] = (f32x4){0.f, 0.f, 0.f, 0.f};
        cur = nxt; cB = nB; vc00 = vn00; vc01 = vn01; vc10 = vn10; vc11 = vn11; ++ui; slot = nslot;
        if (wr == 1) PG8_BAR;
    }
    PG8_WAIT_V(0);
    PG8_BAR;
#undef PG8_SA
#undef PG8_RECISSUE
#undef PG8_AOFF
#undef PG8_SB
#undef PG8_STAGEA
#undef PG8_STAGEB
#undef PG8_LDA
#undef PG8_LDB
#undef PG8_MMA
#undef PG8_WAIT_V
#undef PG8_WAIT_L
#undef PG8_BAR
#undef PG8_SCHED
}
struct DenseOrder {
    static constexpr bool REC = false; static constexpr int SCALE_A = 0, SCALE_B = 0;
    int nM, nN, nwg, G, c; const char* Bt; int K;
    __device__ __forceinline__ const char* rec_ptr(const Unit&) const { return nullptr; }
    __device__ __forceinline__ bool has_rec(const Unit&) const { return false; }
    __device__ __forceinline__ bool row_valid(const Unit&, int) const { return true; }
    __device__ __forceinline__ int nvalid(const Unit&) const { return 256; }
    __device__ __forceinline__ unsigned a_off_idx(const Unit&, int, int) const { return 0u; }
    __device__ void init(int M, int N, int K_, const bf16_t* Bt_, int G_, int c_) { nM = M / BM; nN = N / BM; nwg = nM * nN; G = G_; c = c_; Bt = (const char*)Bt_; K = K_; }
    __device__ __forceinline__ bool next(int i, Unit& u) const {
        const long L = (long)i * G + c; if (L >= nwg) return false;
        int wgid = (int)L; { const int q = nwg / 8, r = nwg % 8, xcd = wgid % 8, off = wgid / 8; wgid = (xcd < r ? xcd * (q + 1) : r * (q + 1) + (xcd - r) * q) + off; }
        const int nig = 8 * nN, gid = wgid / nig, fm = gid * 8, gsz = (nM - fm) < 8 ? (nM - fm) : 8;
        u.pm = fm + ((wgid % nig) % gsz); u.pn = (wgid % nig) / gsz; u.e = 0; u.lt = 0; return true;
    }
    __device__ __forceinline__ const char* b_base(const Unit& u) const { return Bt + (size_t)u.pn * BM * K * 2; }
    __device__ __forceinline__ unsigned a_off(const Unit& u, int row) const { return (unsigned)(u.pm * BM + row) * (unsigned)(K * 2); }
};
__device__ __forceinline__ unsigned cvt_pk_bf16(float lo, float hi) { return pk2(lo, hi); }
struct EpiStoreBf16 { bf16_t* O; int ldc;
    __device__ __forceinline__ void operator()(const f32x4 (&acc)[2][2][4][2], const Unit& u, int wr, int wc, int fr, int fq, LAS const unsigned char*) const {
        const int row0 = u.pm * BM + wr * 64 + fr, col0 = u.pn * BM + wc * 32 + 8 * fq;
#pragma unroll
        for (int ai = 0; ai < 2; ++ai)
#pragma unroll
            for (int m = 0; m < 4; ++m) { bf16_t* rowp = O + (size_t)(row0 + ai * HALF + m * 16) * ldc + col0;
#pragma unroll
                for (int bj = 0; bj < 2; ++bj) { const f32x4 v0 = acc[ai][bj][m][0], v1 = acc[ai][bj][m][1];
                    u32x4 w; w.x = pk2(v0[0], v0[1]); w.y = pk2(v0[2], v0[3]); w.z = pk2(v1[0], v1[1]); w.w = pk2(v1[2], v1[3]);
                    *(u32x4*)(rowp + bj * HALF) = w; } }
    } };
}
constexpr int LDS_PG8 = 2048;
__device__ __forceinline__ void phase1(const Params& p) {
  const int tid_ = opaque_tid(); const int lane = tid_ & 63, gw = blockIdx.x * 8 + (tid_ >> 6), nw = gridDim.x * 8;
  const float* mod = (const float*)(p.ws + OFF_MOD);
  bf16_t* H1 = (bf16_t*)(p.ws + OFF_ACTA);
  float4 g[4];
#pragma unroll
  for (int i = 0; i < 4; ++i) g[i] = *(const float4*)(p.g_mix_pre + (lane + 64 * i) * 4);
  float4 vn[4];
  if (gw < T_TOK) {
#pragma unroll
    for (int i = 0; i < 4; ++i) vn[i] = ((const float4*)(p.x + (size_t)gw * 1024))[lane + 64 * i];
  }
#pragma unroll 1
  for (int row = gw; row < T_TOK; row += nw) {
    float4 v[4]; float ss = 0.f;
#pragma unroll
    for (int i = 0; i < 4; ++i) { v[i] = vn[i]; ss += v[i].x * v[i].x + v[i].y * v[i].y + v[i].z * v[i].z + v[i].w * v[i].w; }
    { const int rn = (row + nw < T_TOK) ? row + nw : row;
#pragma unroll
      for (int i = 0; i < 4; ++i) vn[i] = ((const float4*)(p.x + (size_t)rn * 1024))[lane + 64 * i]; }
    ss = wave_sum(ss);
    const float rs = rsqrtf(ss * (1.0f / 1024.f) + EPS);
    const int b = row >> 12;
    const float* sh = mod + b * 6144; const float* sc = sh + 1024;
#pragma unroll
    for (int i = 0; i < 4; ++i) {
      const int c = (lane + 64 * i) * 4;
      const float4 s1 = *(const float4*)(sc + c), h1 = *(const float4*)(sh + c);
      u32x2 w;
      w.x = pk2(v[i].x * rs * g[i].x * (1.f + s1.x) + h1.x, v[i].y * rs * g[i].y * (1.f + s1.y) + h1.y);
      w.y = pk2(v[i].z * rs * g[i].z * (1.f + s1.z) + h1.z, v[i].w * rs * g[i].w * (1.f + s1.w) + h1.w);
      *(u32x2*)(H1 + (size_t)row * 1024 + c) = w;
    }
  }
}

struct EpiProj { bf16_t* O; float* OL;
  __device__ __forceinline__ void operator()(const f32x4 (&acc)[2][2][4][2], const pg8::Unit& u, int wr, int wc, int fr, int fq, LAS const unsigned char*) const {
    const int row0 = u.pm * 256 + wr * 64 + fr;
    if (u.pn < 12) {
      const int col0 = u.pn * 256 + wc * 32 + 8 * fq;
#pragma unroll
      for (int ai = 0; ai < 2; ++ai)
#pragma unroll
        for (int m = 0; m < 4; ++m) { bf16_t* rowp = O + (size_t)(row0 + ai * 128 + m * 16) * PLD + col0;
#pragma unroll
          for (int bj = 0; bj < 2; ++bj) { const f32x4 v0 = acc[ai][bj][m][0], v1 = acc[ai][bj][m][1];
            u32x4 w; w.x = pk2(v0[0], v0[1]); w.y = pk2(v0[2], v0[3]); w.z = pk2(v1[0], v1[1]); w.w = pk2(v1[2], v1[3]);
            *(u32x4*)(rowp + bj * 128) = w; } }
    } else {
      const int col0 = wc * 32 + 8 * fq;
#pragma unroll
      for (int ai = 0; ai < 2; ++ai)
#pragma unroll
        for (int m = 0; m < 4; ++m) { float* rowp = OL + (size_t)(row0 + ai * 128 + m * 16) * 128 + col0;
          *(f32x4*)rowp = acc[ai][0][m][0]; *(f32x4*)(rowp + 4) = acc[ai][0][m][1]; }
    }
  } };
__device__ __forceinline__ void phase2(const Params& p) {
  pg8::DenseOrder S; S.init(T_TOK, NPROJ, 1024, (const bf16_t*)(p.ws + OFF_WIN), gridDim.x, blockIdx.x);
  EpiProj E{(bf16_t*)(p.ws + OFF_PROJ), (float*)(p.ws + OFF_PROJL)};
  pg8::gemm_phase(SMEM + LDS_PG8, (const bf16_t*)(p.ws + OFF_ACTA), 1024, S, E);
}

__device__ __forceinline__ void unpack8(const u32x4 v, float (&o)[8]) { o[0] = bflo(v.x); o[1] = bfhi(v.x); o[2] = bflo(v.y); o[3] = bfhi(v.y); o[4] = bflo(v.z); o[5] = bfhi(v.z); o[6] = bflo(v.w); o[7] = bfhi(v.w); }
__device__ __forceinline__ u32x4 packf8(const float (&o)[8]) { u32x4 w; w.x = pk2(o[0], o[1]); w.y = pk2(o[2], o[3]); w.z = pk2(o[4], o[5]); w.w = pk2(o[6], o[7]); return w; }
__device__ __forceinline__ void rope8(float (&own)[8], const float (&oth)[8], bool first, const float* cs) {
#pragma unroll
  for (int i = 0; i < 8; ++i) { const float c = cs[2 * i], s = cs[2 * i + 1]; own[i] = first ? (own[i] * c - oth[i] * s) : (own[i] * c + oth[i] * s); }
}
__device__ __forceinline__ void phase2b(const Params& p) {
  const bf16_t* PROJ = (const bf16_t*)(p.ws + OFF_PROJ); const float* PL = (const float*)(p.ws + OFF_PROJL);
  bf16_t* dst = (bf16_t*)(p.ws + OFF_MQKC); bf16_t* AKR = (bf16_t*)(p.ws + OFF_AK); bf16_t* IK = (bf16_t*)(p.ws + OFF_IK);
  const float* R128 = (const float*)(p.ws + OFF_ROPE); const float* R64 = R128 + 4096 * 32;
  const unsigned gtid = blockIdx.x * NTHR + opaque_tid(), gstride = gridDim.x * NTHR;
  for (unsigned id = gtid; id < (unsigned)(T_TOK / 8) * 128u; id += gstride) {
    const size_t tok0 = (size_t)(id >> 7) * 8; const int c0 = (int)(id & 127u) * 8; const int pos0 = (int)(tok0 & 4095);
    u32x4 raw[11];
#pragma unroll
    for (int r = 0; r < 11; ++r) raw[r] = (pos0 + r - 3 >= 0) ? *(const u32x4*)(PROJ + (tok0 + r - 3) * PLD + c0) : (u32x4){0u, 0u, 0u, 0u};
    float w[4][8], bias[8];
#pragma unroll
    for (int j = 0; j < 4; ++j) { const float4 w0 = *(const float4*)(p.conv_w + j * 1024 + c0), w1 = *(const float4*)(p.conv_w + j * 1024 + c0 + 4);
      w[j][0] = w0.x; w[j][1] = w0.y; w[j][2] = w0.z; w[j][3] = w0.w; w[j][4] = w1.x; w[j][5] = w1.y; w[j][6] = w1.z; w[j][7] = w1.w; }
    { const float4 b0 = *(const float4*)(p.conv_b + c0), b1 = *(const float4*)(p.conv_b + c0 + 4);
      bias[0] = b0.x; bias[1] = b0.y; bias[2] = b0.z; bias[3] = b0.w; bias[4] = b1.x; bias[5] = b1.y; bias[6] = b1.z; bias[7] = b1.w; }
    const float sc = (c0 >= 512) ? 0.08838834764831845f : 1.0f;
#pragma unroll
    for (int t = 0; t < 8; ++t) {
      float acc[8];
#pragma unroll
      for (int i = 0; i < 8; ++i) acc[i] = bias[i];
#pragma unroll
      for (int j = 0; j < 4; ++j) { float v[8]; unpack8(raw[t + j], v);
#pragma unroll
        for (int i = 0; i < 8; ++i) acc[i] += v[i] * w[j][i]; }
#pragma unroll
      for (int i = 0; i < 8; ++i) acc[i] = acc[i] * __builtin_amdgcn_rcpf(1.0f + __expf(-acc[i])) * sc;
      *(u32x4*)(dst + (tok0 + t) * 1024 + c0) = packf8(acc);
    }
  }
  for (unsigned id = gtid; id < (unsigned)T_TOK * 16u; id += gstride) {
    const size_t tok = id >> 4; const int c0 = (int)(id & 15u) * 8; const int pos = (int)(tok & 4095);
    float own[8]; unpack8(*(const u32x4*)(PROJ + tok * PLD + 2560 + c0), own);
    if (c0 < 32) { float oth[8]; unpack8(*(const u32x4*)(PROJ + tok * PLD + 2560 + (c0 ^ 16)), oth); rope8(own, oth, c0 < 16, R128 + (size_t)pos * 32 + (c0 & 15) * 2); }
    *(u32x4*)(AKR + tok * 128 + c0) = packf8(own);
  }
  {
    const int tid_ = opaque_tid(); const int lane = tid_ & 63, gwv = blockIdx.x * 8 + (tid_ >> 6), nwv = gridDim.x * 8;
    const float gk = p.g_idx_k[lane], bk = p.b_idx_k[lane];
    for (int tok = gwv; tok < T_TOK; tok += nwv) {
      const int pos = tok & 4095;
      const float* tr = PL + (size_t)tok * 128;
      const float v = tr[lane];
      const float mu = wave_sum(v) * (1.f / 64.f);
      const float d = v - mu;
      const float var = wave_sum(d * d) * (1.f / 64.f);
      float y = d * rsqrtf(var + EPS) * gk + bk;
      const float yo = __shfl_xor(y, 8);
      if (lane < 16) { const float cs = R64[(size_t)pos * 16 + (lane & 7) * 2], sn = R64[(size_t)pos * 16 + (lane & 7) * 2 + 1]; y = (lane < 8) ? (y * cs - yo * sn) : (y * cs + yo * sn); }
      const float yn = __shfl_down(y, 1);
      if ((lane & 1) == 0) *(unsigned*)(IK + (size_t)tok * 64 + lane) = pk2(y, yn);
      if (lane < 8) ((float*)(p.ws + OFF_GATES))[(size_t)tok * 8 + lane] = tr[64 + lane] + ((lane < 4) ? p.b_igate[lane] : p.b_fgate[lane - 4]);
      else if (lane < 12) ((float*)(p.ws + OFF_IW))[(size_t)tok * 4 + (lane - 8)] = tr[72 + (lane - 8)] * 0.0625f;
    }
  }
  {
    const int tid_ = opaque_tid(); const int lane = tid_ & 63, gwv = blockIdx.x * 8 + (tid_ >> 6), nwv = gridDim.x * 8;
    float* GLb = (float*)(p.ws + OFF_GL); float* GLa = GLb + 64 * 4096; float* GLm = GLa + 64 * 4096; float* SEG = GLm + 64 * 4096;
    for (int item = gwv; item < 512; item += nwv) {
      const int bh = item >> 3, seg = item & 7, b = bh >> 2, h = bh & 3;
      const float bi = p.b_igate[h], bfg = p.b_fgate[h];
      float bl = 0.f, ml = -1e30f;
      for (int c = 0; c < 8; ++c) {
        const int ts = seg * 512 + c * 64 + lane; const size_t tok = (size_t)b * 4096 + ts;
        const float ig = PL[tok * 128 + 64 + h] + bi, fg = PL[tok * 128 + 68 + h] + bfg;
        const float lf = fminf(fg, 0.f) - log1pf(expf(-fabsf(fg)));
        float cs = lf;
#pragma unroll
        for (int off = 1; off < 64; off <<= 1) { const float t = __shfl_up(cs, off); if (lane >= off) cs += t; }
        const float bloc = bl + cs, aloc = ig - bloc;
        float mx = aloc;
#pragma unroll
        for (int off = 1; off < 64; off <<= 1) { const float t = __shfl_up(mx, off); if (lane >= off) mx = fmaxf(mx, t); }
        const float mloc = fmaxf(ml, mx);
        GLb[bh * 4096 + ts] = bloc; GLa[bh * 4096 + ts] = aloc; GLm[bh * 4096 + ts] = mloc;
        bl = __shfl(bloc, 63); ml = __shfl(mloc, 63);
      }
      if (lane == 0) { SEG[(bh * 8 + seg) * 2] = bl; SEG[(bh * 8 + seg) * 2 + 1] = ml; }
    }
  }
}
namespace ml {
constexpr int QS = 0, KS = 17408, VS = 34816, VWS = 54272, PS = 73728, CB = 82944, SEGT = 122112, GA = 122624;
constexpr int QLD = 136, VLD = 152, TLD = 72;
}
__device__ __forceinline__ bf16x8 ml_tr(LAS const bf16_t* p0, int rowstride) {
  const v4i16_t a = __builtin_amdgcn_ds_read_tr16_b64_v4i16((LAS v4i16_t*)p0), b = __builtin_amdgcn_ds_read_tr16_b64_v4i16((LAS v4i16_t*)(p0 + 4 * rowstride));
  bf16x8 r; r[0] = a[0]; r[1] = a[1]; r[2] = a[2]; r[3] = a[3]; r[4] = b[0]; r[5] = b[1]; r[6] = b[2]; r[7] = b[3]; return r;
}
__device__ __forceinline__ void mlstm_item(const Params& p, int id) {
  using namespace ml;
  const int tid = opaque_tid(), lane = tid & 63, w = tid >> 6, fr = lane & 15, fq = lane >> 4;
  const int b = id >> 2, h = id & 3;
  const size_t tok0 = (size_t)b * 4096;
  LAS unsigned char* L = SMEM + LDS_MAIN;
  LAS bf16_t* Qs = (LAS bf16_t*)(L + QS); LAS bf16_t* Ks = (LAS bf16_t*)(L + KS); LAS bf16_t* Vs = (LAS bf16_t*)(L + VS); LAS bf16_t* VWs = (LAS bf16_t*)(L + VWS);
  LAS bf16_t* Ps = (LAS bf16_t*)(L + PS); LAS bf16_t* Cb = (LAS bf16_t*)(L + CB);
  LAS float* segt = (LAS float*)(L + SEGT); LAS float* gab = (LAS float*)(L + GA);
  const float* GLb = (const float*)(p.ws + OFF_GL) + (size_t)(b * 4 + h) * 4096; const float* GLa = GLb + 64 * 4096; const float* GLm = GLa + 64 * 4096; const float* SEG = (const float*)(p.ws + OFF_GL) + 3 * 64 * 4096 + (b * 4 + h) * 16;
  const bf16_t* MQKC = (const bf16_t*)(p.ws + OFF_MQKC); const bf16_t* MV = (const bf16_t*)(p.ws + OFF_PROJ) + 1024 + h * 128; const bf16_t* MO = (const bf16_t*)(p.ws + OFF_PROJ) + 1536 + h * 128;
  bf16_t* A2 = (bf16_t*)(p.ws + OFF_ACTA) + h * 128;

  f32x4 Cacc[2][9];
#pragma unroll
  for (int i = 0; i < 2; ++i)
#pragma unroll
    for (int j = 0; j < 9; ++j) Cacc[i][j] = (f32x4){0.f, 0.f, 0.f, 0.f};
  for (int i = tid; i < 144 * QLD; i += NTHR) Cb[i] = 0;
  for (int i = tid; i < 64 * VLD; i += NTHR) { const int col = i % VLD; Vs[i] = (col == 128) ? (bf16_t)0x3F80 : (bf16_t)0; VWs[i] = 0; }
  if (tid == 0) { float bo = 0.f, mp = -1e30f; for (int k = 0; k < 8; ++k) { segt[2 * k] = bo; segt[2 * k + 1] = mp; mp = fmaxf(mp, SEG[2 * k + 1] - bo); bo += SEG[2 * k]; } }
  u32x4 q0, q1, k0, k1, v0, v1; float ga0 = 0.f, ga1 = 0.f, gb = 0.f, gm = 0.f, gme = 0.f, gmp = 0.f;
  const int srow = tid >> 4, scc = tid & 15;
  const int gs = tid & 63;
  auto gload = [&](int c) {
    const size_t t0 = tok0 + (size_t)c * 64;
    q0 = *(const u32x4*)(MQKC + (t0 + srow) * 1024 + h * 128 + scc * 8); q1 = *(const u32x4*)(MQKC + (t0 + srow + 32) * 1024 + h * 128 + scc * 8);
    k0 = *(const u32x4*)(MQKC + (t0 + srow) * 1024 + 512 + h * 128 + scc * 8); k1 = *(const u32x4*)(MQKC + (t0 + srow + 32) * 1024 + 512 + h * 128 + scc * 8);
    v0 = *(const u32x4*)(MV + (t0 + srow) * PLD + scc * 8); v1 = *(const u32x4*)(MV + (t0 + srow + 32) * PLD + scc * 8);
    ga0 = GLa[c * 64 + srow]; ga1 = GLa[c * 64 + srow + 32];
    const int ts = c * 64 + gs; gb = GLb[ts]; gm = GLm[ts]; gme = GLm[c * 64 + 63]; gmp = GLm[(c > 0) ? (c * 64 - 1) : 0];
  };
  auto sstore = [&](int cs) {
    *(LAS u32x4*)(Qs + srow * QLD + scc * 8) = q0; *(LAS u32x4*)(Qs + (srow + 32) * QLD + scc * 8) = q1;
    *(LAS u32x4*)(Ks + srow * QLD + scc * 8) = k0; *(LAS u32x4*)(Ks + (srow + 32) * QLD + scc * 8) = k1;
    *(LAS u32x4*)(Vs + srow * VLD + scc * 8) = v0; *(LAS u32x4*)(Vs + (srow + 32) * VLD + scc * 8) = v1;
    const float bo = segt[2 * (cs >> 3)], mpv = segt[2 * (cs >> 3) + 1];
    const float Mend = fmaxf(mpv, gme - bo);
    const float w0 = __expf(ga0 - bo - Mend), w1 = __expf(ga1 - bo - Mend);
    { float f[8]; unpack8(v0, f);
#pragma unroll
      for (int i = 0; i < 8; ++i) f[i] *= w0;
      *(LAS u32x4*)(VWs + srow * VLD + scc * 8) = packf8(f);
      unpack8(v1, f);
#pragma unroll
      for (int i = 0; i < 8; ++i) f[i] *= w1;
      *(LAS u32x4*)(VWs + (srow + 32) * VLD + scc * 8) = packf8(f); }
    if (scc == 0) { VWs[srow * VLD + 128] = (bf16_t)f2bf(w0); VWs[(srow + 32) * VLD + 128] = (bf16_t)f2bf(w1); }
    if (tid < 64) {
      LAS float* ga = gab + (cs & 1) * 336;
      const float gav = (gs < 32) ? ga0 : ga1;
      (void)gav;
      const float a = GLa[cs * 64 + gs] - bo, Bs = bo + gb, Mt = fmaxf(mpv, gm - bo);
      float Mp = -1e30f;
      if (cs > 0) { const int sp = (cs * 64 - 1) >> 9; Mp = fmaxf(segt[2 * sp + 1], gmp - segt[2 * sp]); }
      ga[gs] = a; ga[64 + gs] = Mt; ga[128 + gs] = __expf(Mp - Mt); ga[192 + gs] = __expf(-(Bs + Mt));
      if (gs == 0) ga[320] = __expf(Mp - Mend);
    }
  };
  __syncthreads();
  gload(0); sstore(0);
  __syncthreads();
  const int tt = w >> 1, st0 = (w & 1) * 2;
  const int trq = fr >> 2, trp = fr & 3;
#pragma unroll 1
  for (int c = 0; c < 64; ++c) {
    if (c < 63) gload(c + 1);
    LAS const float* ga = gab + (c & 1) * 336;
    {
      f32x4 S[2];
#pragma unroll
      for (int i = 0; i < 2; ++i) S[i] = (f32x4){0.f, 0.f, 0.f, 0.f};
#pragma unroll
      for (int kk = 0; kk < 4; ++kk) {
        const bf16x8 bq = *(LAS bf16x8*)(Qs + (tt * 16 + fr) * QLD + kk * 32 + fq * 8);
#pragma unroll
        for (int i = 0; i < 2; ++i) if (st0 + i <= tt) {
          const bf16x8 ak = *(LAS bf16x8*)(Ks + ((st0 + i) * 16 + fr) * QLD + kk * 32 + fq * 8);
          S[i] = __builtin_amdgcn_mfma_f32_16x16x32_bf16(ak, bq, S[i], 0, 0, 0);
        }
      }
      const int t = tt * 16 + fr; const float Mt = ga[64 + t];
#pragma unroll
      for (int i = 0; i < 2; ++i) {
        const int s0 = (st0 + i) * 16 + fq * 4;
        const f32x4 as = *(LAS const f32x4*)(ga + s0);
        float pv[4];
#pragma unroll
        for (int j = 0; j < 4; ++j) pv[j] = (s0 + j <= t) ? S[i][j] * __expf(as[j] - Mt) : 0.f;
        u32x2 pw; pw.x = pk2(pv[0], pv[1]); pw.y = pk2(pv[2], pv[3]);
        *(LAS u32x2*)(Ps + t * TLD + s0) = pw;
      }
    }
    __syncthreads();
    if (w < 4) {
      f32x4 N1[9];
#pragma unroll
      for (int j = 0; j < 9; ++j) N1[j] = (f32x4){0.f, 0.f, 0.f, 0.f};
#pragma unroll
      for (int kk = 0; kk < 4; ++kk) {
        const bf16x8 bq = *(LAS bf16x8*)(Qs + (w * 16 + fr) * QLD + kk * 32 + fq * 8);
#pragma unroll
        for (int j = 0; j < 9; ++j) { const bf16x8 ac = *(LAS bf16x8*)(Cb + (j * 16 + fr) * QLD + kk * 32 + fq * 8); N1[j] = __builtin_amdgcn_mfma_f32_16x16x32_bf16(ac, bq, N1[j], 0, 0, 0); }
      }
      const int t = w * 16 + fr; const float inter = ga[128 + t], low = ga[192 + t];
#pragma unroll
      for (int j = 0; j < 9; ++j) N1[j] = N1[j] * inter;
#pragma unroll
      for (int kk = 0; kk < 2; ++kk) {
        const bf16x8 bp = *(LAS bf16x8*)(Ps + (w * 16 + fr) * TLD + kk * 32 + fq * 8);
        LAS const bf16_t* vb = Vs + (kk * 32 + fq * 8 + trq) * VLD + trp * 4;
#pragma unroll
        for (int j = 0; j < 9; ++j) { const bf16x8 av = ml_tr(vb + j * 16, VLD); N1[j] = __builtin_amdgcn_mfma_f32_16x16x32_bf16(av, bp, N1[j], 0, 0, 0); }
      }
      const float dsrc = N1[8][0];
      const float dn = fmaxf(fabsf(__shfl(dsrc, fr)), low);
      const float inv = __builtin_amdgcn_rcpf(dn);
      float ss = 0.f;
#pragma unroll
      for (int j = 0; j < 8; ++j)
#pragma unroll
        for (int r = 0; r < 4; ++r) { const float hv = N1[j][r] * inv; N1[j][r] = hv; ss += hv * hv; }
      ss += __shfl_xor(ss, 16); ss += __shfl_xor(ss, 32);
      const float rs = rsqrtf(ss * (1.f / 128.f) + EPS);
      bf16_t* op = A2 + (tok0 + (size_t)c * 64 + t) * 1024 + fq * 4;
#pragma unroll
      for (int j = 0; j < 8; ++j) {
        const float4 gh = *(const float4*)(p.g_mlstm_head + h * 128 + j * 16 + fq * 4);
        const u32x2 mo = *(const u32x2*)(MO + (tok0 + (size_t)c * 64 + t) * PLD + j * 16 + fq * 4);
        const float o0 = N1[j][0] * rs * gh.x * sigmoidf_(bflo(mo.x)), o1 = N1[j][1] * rs * gh.y * sigmoidf_(bfhi(mo.x));
        const float o2 = N1[j][2] * rs * gh.z * sigmoidf_(bflo(mo.y)), o3 = N1[j][3] * rs * gh.w * sigmoidf_(bfhi(mo.y));
        u32x2 hw; hw.x = pk2(o0, o1); hw.y = pk2(o2, o3);
        *(u32x2*)(op + j * 16) = hw;
      }
    } else {
      const float dcy = ga[320];
#pragma unroll
      for (int i = 0; i < 2; ++i)
#pragma unroll
        for (int j = 0; j < 9; ++j) Cacc[i][j] = Cacc[i][j] * dcy;
#pragma unroll
      for (int kk = 0; kk < 2; ++kk) {
        LAS const bf16_t* kb0 = Ks + (kk * 32 + fq * 8 + trq) * QLD + trp * 4;
        LAS const bf16_t* vwb = VWs + (kk * 32 + fq * 8 + trq) * VLD + trp * 4;
        bf16x8 akt[2];
#pragma unroll
        for (int i = 0; i < 2; ++i) akt[i] = ml_tr(kb0 + ((w - 4) * 2 + i) * 16, QLD);
#pragma unroll
        for (int j = 0; j < 9; ++j) {
          const bf16x8 bv = ml_tr(vwb + j * 16, VLD);
#pragma unroll
          for (int i = 0; i < 2; ++i) Cacc[i][j] = __builtin_amdgcn_mfma_f32_16x16x32_bf16(akt[i], bv, Cacc[i][j], 0, 0, 0);
        }
      }
    }
    __syncthreads();
    if (w >= 4) {
#pragma unroll
      for (int i = 0; i < 2; ++i)
#pragma unroll
        for (int j = 0; j < 9; ++j) { u32x2 cw; cw.x = pk2(Cacc[i][j][0], Cacc[i][j][1]); cw.y = pk2(Cacc[i][j][2], Cacc[i][j][3]);
          *(LAS u32x2*)(Cb + (j * 16 + fr) * QLD + ((w - 4) * 2 + i) * 16 + fq * 4) = cw; }
    }
    if (c < 63) sstore(c + 1);
    __syncthreads();
  }
}
namespace ds {
constexpr int KEYS = 0, HIST = 131072;
constexpr int KT = 0, VT = 34816, PW = 71680, MSK = 108544;
constexpr int KLD = 136, VLD = 72;
}
__device__ __forceinline__ unsigned score_key16(float s4096) {
  const float t = __builtin_amdgcn_fmed3f(s4096, -32767.0f, 32767.0f);
  return (unsigned)(32768 + (int)floorf(t));
}
__device__ __forceinline__ void hist_find(LAS const unsigned* hist, int lane, unsigned target, unsigned& bin, unsigned& above) {
  const u32x4 h4 = *(LAS const u32x4*)(hist + 4 * lane);
  const unsigned lsum = h4.x + h4.y + h4.z + h4.w;
  unsigned suf = lsum;
#pragma unroll
  for (int off = 1; off < 64; off <<= 1) { const unsigned t = __shfl_down(suf, off); if (lane + off < 64) suf += t; }
  unsigned cum = suf - lsum; bool found = false; unsigned fb = 0, fa = 0;
  { const unsigned hv = h4.w; if (!found && cum < target && cum + hv >= target) { found = true; fb = 4 * lane + 3; fa = cum; } cum += hv; }
  { const unsigned hv = h4.z; if (!found && cum < target && cum + hv >= target) { found = true; fb = 4 * lane + 2; fa = cum; } cum += hv; }
  { const unsigned hv = h4.y; if (!found && cum < target && cum + hv >= target) { found = true; fb = 4 * lane + 1; fa = cum; } cum += hv; }
  { const unsigned hv = h4.x; if (!found && cum < target && cum + hv >= target) { found = true; fb = 4 * lane + 0; fa = cum; } cum += hv; }
  const unsigned long long m = __ballot(found);
  const int src = m ? (__ffsll((long long)m) - 1) : 0;
  bin = __shfl(fb, src); above = __shfl(fa, src);
}
typedef long long i64; typedef long long i64x2 __attribute__((ext_vector_type(2)));
__device__ __forceinline__ bf16x8 tr_pair(LAS const bf16_t* p0, LAS const bf16_t* p1) {
  const v4i16_t a = __builtin_amdgcn_ds_read_tr16_b64_v4i16((LAS v4i16_t*)p0), b = __builtin_amdgcn_ds_read_tr16_b64_v4i16((LAS v4i16_t*)p1);
  bf16x8 r; r[0] = a[0]; r[1] = a[1]; r[2] = a[2]; r[3] = a[3]; r[4] = b[0]; r[5] = b[1]; r[6] = b[2]; r[7] = b[3]; return r;
}
__device__ __forceinline__ void dsa_item(const Params& p, int b, int qc) {
  using namespace ds;
  const int tid = opaque_tid(), lane = tid & 63, w = tid >> 6, fr = lane & 15, fq = lane >> 4;
  LAS unsigned char* L = SMEM + LDS_MAIN;
  const size_t kb = (size_t)b * 4096;
  const size_t q0 = kb + (size_t)qc * 64;
  const int n = (qc + 1) * 64, ntile = qc + 1;
  unsigned long long* BITM = (unsigned long long*)(p.ws + OFF_BITM);
  unsigned char* BITB = (unsigned char*)(p.ws + OFF_BITM);
  const bf16_t* IQ = (const bf16_t*)(p.ws + OFF_PROJ) + 2816; const float* R128 = (const float*)(p.ws + OFF_ROPE); const float* R64 = R128 + 4096 * 32;
  const bf16_t* IK = (const bf16_t*)(p.ws + OFF_IK); const float* IW = (const float*)(p.ws + OFF_IW);
  for (int rep_s = 0; rep_s < ((PROBE_DBL == 33) ? 2 : 1); ++rep_s)
  if (n <= 256) {
    for (int i = tid; i < 64 * ntile; i += NTHR) { const int q = i / ntile, kt = i - q * ntile; BITM[(q0 + q) * 64 + kt] = ~0ull; }
  } else {
    LAS unsigned short* keys = (LAS unsigned short*)(L + KEYS);
    LAS unsigned* hist = (LAS unsigned*)(L + HIST) + w * 256;
    const int nk16 = n >> 4, nblk = (n + 511) >> 9;
#pragma unroll 1
    for (int g = 0; g < 4; ++g) {
      const size_t qg = q0 + g * 16;
      bf16x8 af[4][2]; f32x4 iw[4];
#pragma unroll
      for (int hh = 0; hh < 4; ++hh)
#pragma unroll
        for (int ks = 0; ks < 2; ++ks) {
          const bf16_t* src = IQ + (qg + fr) * PLD + hh * 64 + ks * 32 + fq * 8;
          u32x4 raw = *(const u32x4*)src;
          if (ks == 0 && fq < 2) { float own[8], oth[8]; unpack8(raw, own); unpack8(*(const u32x4*)(IQ + (qg + fr) * PLD + hh * 64 + (fq ^ 1) * 8), oth);
            rope8(own, oth, fq == 0, R64 + (size_t)((qg + fr) & 4095) * 16); raw = packf8(own); }
          af[hh][ks] = __builtin_bit_cast(bf16x8, raw);
        }
#pragma unroll
      for (int j = 0; j < 4; ++j) iw[j] = *(const f32x4*)(IW + (qg + fq * 4 + j) * 4) * 4096.0f;
      for (int rep_a = 0; rep_a < ((PROBE_DBL == 35) ? 2 : 1); ++rep_a)
      {
        const int nbat = n >> 6;
        bf16x8 bc[4][2], bn[4][2];
        {
          const int bt = (w < nbat) ? w : 0;
#pragma unroll
          for (int u = 0; u < 4; ++u) { const bf16_t* kp = IK + (kb + (size_t)(bt * 4 + u) * 16 + fr) * 64 + fq * 8; bc[u][0] = *(const bf16x8*)kp; bc[u][1] = *(const bf16x8*)(kp + 32); }
        }
        for (int bt = w; bt < nbat; bt += 8) {
          const int btn = (bt + 8 < nbat) ? bt + 8 : bt;
#pragma unroll
          for (int u = 0; u < 4; ++u) { const bf16_t* kp = IK + (kb + (size_t)(btn * 4 + u) * 16 + fr) * 64 + fq * 8; bn[u][0] = *(const bf16x8*)kp; bn[u][1] = *(const bf16x8*)(kp + 32); }
#pragma unroll
          for (int u = 0; u < 4; ++u) {
            float sc[4] = {0.f, 0.f, 0.f, 0.f};
#pragma unroll
            for (int hh = 0; hh < 4; ++hh) {
              f32x4 a = (f32x4){0.f, 0.f, 0.f, 0.f};
              a = __builtin_amdgcn_mfma_f32_16x16x32_bf16(af[hh][0], bc[u][0], a, 0, 0, 0);
              a = __builtin_amdgcn_mfma_f32_16x16x32_bf16(af[hh][1], bc[u][1], a, 0, 0, 0);
#pragma unroll
              for (int j = 0; j < 4; ++j) sc[j] += iw[j][hh] * fmaxf(a[j], 0.f);
            }
#pragma unroll
            for (int j = 0; j < 4; ++j) keys[(fq * 4 + j) * 4096 + (bt * 4 + u) * 16 + fr] = (unsigned short)score_key16(sc[j]);
          }
#pragma unroll
          for (int u = 0; u < 4; ++u) { bc[u][0] = bn[u][0]; bc[u][1] = bn[u][1]; }
        }
      }
      __syncthreads();
#pragma unroll 1
      for (int qq = 0; qq < ((PROBE_DBL == 36) ? 4 : 2); ++qq) {
        const int ql = w * 2 + (qq & 1);
        LAS const unsigned short* kq = keys + ql * 4096;
        *(LAS u32x4*)(hist + 4 * lane) = (u32x4){0u, 0u, 0u, 0u};
        for (int blk = 0; blk < nblk; ++blk) {
          const int k0i = blk * 512 + lane * 8;
          if (k0i < n) {
            const u32x4 kv = *(LAS const u32x4*)(kq + k0i);
            __hip_atomic_fetch_add(hist + ((kv.x >> 8) & 255u), 1u, __ATOMIC_RELAXED, __HIP_MEMORY_SCOPE_WORKGROUP); __hip_atomic_fetch_add(hist + (kv.x >> 24), 1u, __ATOMIC_RELAXED, __HIP_MEMORY_SCOPE_WORKGROUP);
            __hip_atomic_fetch_add(hist + ((kv.y >> 8) & 255u), 1u, __ATOMIC_RELAXED, __HIP_MEMORY_SCOPE_WORKGROUP); __hip_atomic_fetch_add(hist + (kv.y >> 24), 1u, __ATOMIC_RELAXED, __HIP_MEMORY_SCOPE_WORKGROUP);
            __hip_atomic_fetch_add(hist + ((kv.z >> 8) & 255u), 1u, __ATOMIC_RELAXED, __HIP_MEMORY_SCOPE_WORKGROUP); __hip_atomic_fetch_add(hist + (kv.z >> 24), 1u, __ATOMIC_RELAXED, __HIP_MEMORY_SCOPE_WORKGROUP);
            __hip_atomic_fetch_add(hist + ((kv.w >> 8) & 255u), 1u, __ATOMIC_RELAXED, __HIP_MEMORY_SCOPE_WORKGROUP); __hip_atomic_fetch_add(hist + (kv.w >> 24), 1u, __ATOMIC_RELAXED, __HIP_MEMORY_SCOPE_WORKGROUP);
          }
        }
        asm volatile("s_waitcnt lgkmcnt(0)" ::: "memory");
        unsigned bin1, above1; hist_find(hist, lane, 256u, bin1, above1);
        *(LAS u32x4*)(hist + 4 * lane) = (u32x4){0u, 0u, 0u, 0u};
        for (int blk = 0; blk < nblk; ++blk) {
          const int k0i = blk * 512 + lane * 8;
          if (k0i < n) {
            const u32x4 kv = *(LAS const u32x4*)(kq + k0i);
#define DS_P2(word) { const unsigned ka = (word) & 0xffffu, kb2 = (word) >> 16; \
              if ((ka >> 8) == bin1) __hip_atomic_fetch_add(hist + (ka & 255u), 1u, __ATOMIC_RELAXED, __HIP_MEMORY_SCOPE_WORKGROUP); \
              if ((kb2 >> 8) == bin1) __hip_atomic_fetch_add(hist + (kb2 & 255u), 1u, __ATOMIC_RELAXED, __HIP_MEMORY_SCOPE_WORKGROUP); }
            DS_P2(kv.x) DS_P2(kv.y) DS_P2(kv.z) DS_P2(kv.w)
#undef DS_P2
          }
        }
        asm volatile("s_waitcnt lgkmcnt(0)" ::: "memory");
        unsigned bin2, above2; hist_find(hist, lane, 256u - above1, bin2, above2);
        const unsigned tau = (bin1 << 8) | bin2, rties = 256u - above1 - above2;
        unsigned tbase = 0;
        for (int blk = 0; blk < nblk; ++blk) {
          const int k0i = blk * 512 + lane * 8;
          u32x4 kv = (u32x4){0u, 0u, 0u, 0u};
          if (k0i < n) kv = *(LAS const u32x4*)(kq + k0i);
          unsigned kk[8] = {kv.x & 0xffffu, kv.x >> 16, kv.y & 0xffffu, kv.y >> 16, kv.z & 0xffffu, kv.z >> 16, kv.w & 0xffffu, kv.w >> 16};
          unsigned ne = 0;
#pragma unroll
          for (int e = 0; e < 8; ++e) ne += (kk[e] == tau) ? 1u : 0u;
          if (k0i >= n) ne = 0;
          unsigned mbyte = 0;
          if (__ballot(ne != 0u) == 0ull) {
#pragma unroll
            for (int e = 0; e < 8; ++e) mbyte |= (kk[e] > tau) ? (1u << e) : 0u;
          } else {
            unsigned inc = ne;
#pragma unroll
            for (int off = 1; off < 64; off <<= 1) { const unsigned t = __shfl_up(inc, off); if (lane >= off) inc += t; }
            unsigned rank = tbase + inc - ne;
#pragma unroll
            for (int e = 0; e < 8; ++e) { const bool eq = kk[e] == tau; const bool sel = (kk[e] > tau) || (eq && rank < rties); mbyte |= sel ? (1u << e) : 0u; rank += eq ? 1u : 0u; }
            tbase += __shfl(inc, 63);
          }
          if (k0i < n) BITB[(qg + ql) * 512 + blk * 64 + lane] = (unsigned char)mbyte;
        }
      }
      __syncthreads();
    }
  }
  asm volatile("s_waitcnt vmcnt(0)" ::: "memory");
  __threadfence_block();
  __syncthreads();
  const bf16_t* AQ = (const bf16_t*)(p.ws + OFF_PROJ) + 2048; const bf16_t* AK = (const bf16_t*)(p.ws + OFF_AK); const bf16_t* AV = (const bf16_t*)(p.ws + OFF_PROJ) + 2688;
  bf16_t* A2 = (bf16_t*)(p.ws + OFF_ACTA);
  const float qscale = 0.08838834764831845f * 1.4426950408889634f;
  constexpr int RS = 36864;
  const int wv = __builtin_amdgcn_readfirstlane(w);
  const int prow0 = wv * 4 + (lane >> 4), prow1 = 32 + prow0;
  const int pch0 = (lane & 15) ^ (prow0 & 15), pch1 = (lane & 15) ^ (prow1 & 15);
  const unsigned koff0 = (unsigned)(prow0 * 128 + pch0 * 8) * 2u, koff1 = (unsigned)(prow1 * 128 + pch1 * 8) * 2u;
  const unsigned voff0 = (unsigned)(prow0 * PLD + pch0 * 8) * 2u, voff1 = (unsigned)(prow1 * PLD + pch1 * 8) * 2u;
  const unsigned moff = (unsigned)(((tid & 127) >> 1) * 512 + (tid & 1) * 4);
#define DS_GLDS(gp, ldsoff, sz) __builtin_amdgcn_global_load_lds((const unsigned*)(gp), (LAS unsigned*)(L + (ldsoff)), sz, 0, 0)
#define DS_ISSUE(kt_, stg_) do { const size_t t0_ = kb + (size_t)(kt_) * 64; const int so_ = (stg_) * RS; \
    DS_GLDS((const char*)(AK + t0_ * 128) + koff0, so_ + wv * 1024, 16); DS_GLDS((const char*)(AK + t0_ * 128) + koff1, so_ + 8192 + wv * 1024, 16); \
    DS_GLDS((const char*)(AV + t0_ * PLD) + voff0, so_ + 16384 + wv * 1024, 16); DS_GLDS((const char*)(AV + t0_ * PLD) + voff1, so_ + 16384 + 8192 + wv * 1024, 16); \
    DS_GLDS((const char*)(BITM + q0 * 64 + (kt_)) + moff, so_ + 32768 + wv * 256, 4); } while (0)
#pragma unroll 1
  for (int hp = 0; hp < ((PROBE_DBL == 34) ? 2 : 1); ++hp) {
    const int hd0 = (w >> 2) * 2, qh = (w & 3) * 16;
    bf16x8 qf[2][4];
#pragma unroll
    for (int hx = 0; hx < 2; ++hx)
#pragma unroll
      for (int kk = 0; kk < 4; ++kk) {
        const bf16_t* src = AQ + (q0 + qh + fr) * PLD + (hd0 + hx) * 128 + kk * 32 + fq * 8;
        float own[8]; unpack8(*(const u32x4*)src, own);
        if (kk == 0) { float oth[8]; unpack8(*(const u32x4*)(AQ + (q0 + qh + fr) * PLD + (hd0 + hx) * 128 + (fq ^ 2) * 8), oth);
          rope8(own, oth, fq < 2, R128 + (size_t)((q0 + qh + fr) & 4095) * 32 + (fq & 1) * 16); }
#pragma unroll
        for (int i = 0; i < 8; ++i) own[i] *= qscale;
        qf[hx][kk] = __builtin_bit_cast(bf16x8, packf8(own));
      }
    f32x4 O[2][8];
#pragma unroll
    for (int hx = 0; hx < 2; ++hx)
#pragma unroll
      for (int di = 0; di < 8; ++di) O[hx][di] = (f32x4){0.f, 0.f, 0.f, 0.f};
    float mrun[2] = {-1e30f, -1e30f};
    f32x4 Lacc[2] = {(f32x4){0.f, 0.f, 0.f, 0.f}, (f32x4){0.f, 0.f, 0.f, 0.f}};
    const bf16x8 ones8 = __builtin_bit_cast(bf16x8, (u32x4){0x3F803F80u, 0x3F803F80u, 0x3F803F80u, 0x3F803F80u});
    const unsigned r15 = (unsigned)(fq * 4 + (fr >> 2));
    const unsigned vrb = r15 * 256u + (unsigned)(fr & 1) * 8u, vcx = (unsigned)((fr & 3) >> 1);
    const unsigned va0 = vrb + (((0u + vcx) ^ r15) << 4), va1 = vrb + (((2u + vcx) ^ r15) << 4), va2 = vrb + (((4u + vcx) ^ r15) << 4), va3 = vrb + (((6u + vcx) ^ r15) << 4);
    const unsigned va4 = vrb + (((8u + vcx) ^ r15) << 4), va5 = vrb + (((10u + vcx) ^ r15) << 4), va6 = vrb + (((12u + vcx) ^ r15) << 4), va7 = vrb + (((14u + vcx) ^ r15) << 4);
    asm volatile("s_waitcnt vmcnt(0)" ::: "memory");
    DS_ISSUE(0, 0);
    DS_ISSUE((ntile > 1) ? 1 : 0, 1);
#pragma unroll 1
    for (int kt = 0; kt < ntile; ++kt) {
      const int stg = kt % 3;
      asm volatile("s_waitcnt vmcnt(5)" ::: "memory");
      asm volatile("s_waitcnt lgkmcnt(0)" ::: "memory");
      __builtin_amdgcn_s_barrier();
      { const int ktn = (kt + 2 < ntile) ? kt + 2 : ntile - 1; DS_ISSUE(ktn, (kt + 2) % 3); }
      LAS const unsigned char* Kt = L + stg * RS;
      f32x4 S[2][4];
#pragma unroll
      for (int hx = 0; hx < 2; ++hx)
#pragma unroll
        for (int ni = 0; ni < 4; ++ni) S[hx][ni] = (f32x4){0.f, 0.f, 0.f, 0.f};
#pragma unroll
      for (int kk = 0; kk < 4; ++kk)
#pragma unroll
        for (int ni = 0; ni < 4; ++ni) {
          const bf16x8 ak = *(LAS const bf16x8*)(Kt + (ni * 16 + fr) * 256 + (((kk * 4 + fq) ^ fr) << 4));
          S[0][ni] = __builtin_amdgcn_mfma_f32_16x16x32_bf16(ak, qf[0][kk], S[0][ni], 0, 0, 0);
          S[1][ni] = __builtin_amdgcn_mfma_f32_16x16x32_bf16(ak, qf[1][kk], S[1][ni], 0, 0, 0);
        }
#define DS_TRI(o0, o1, aa, ab, ac, ad, r0, r1, r2, r3, r4, r5, r6, r7) asm volatile( \
        "ds_read_b64_tr_b16 %0, %8 offset:" #o0 "\n\tds_read_b64_tr_b16 %1, %8 offset:" #o1 "\n\tds_read_b64_tr_b16 %2, %9 offset:" #o0 "\n\tds_read_b64_tr_b16 %3, %9 offset:" #o1 "\n\t" \
        "ds_read_b64_tr_b16 %4, %10 offset:" #o0 "\n\tds_read_b64_tr_b16 %5, %10 offset:" #o1 "\n\tds_read_b64_tr_b16 %6, %11 offset:" #o0 "\n\tds_read_b64_tr_b16 %7, %11 offset:" #o1 \
        : "=&v"(r0), "=&v"(r1), "=&v"(r2), "=&v"(r3), "=&v"(r4), "=&v"(r5), "=&v"(r6), "=&v"(r7) : "v"((aa) + sb), "v"((ab) + sb), "v"((ac) + sb), "v"((ad) + sb) : "memory")
#define DS_TRW(r0, r1, r2, r3, r4, r5, r6, r7) asm volatile("s_waitcnt lgkmcnt(0)" : "+v"(r0), "+v"(r1), "+v"(r2), "+v"(r3), "+v"(r4), "+v"(r5), "+v"(r6), "+v"(r7) :: "memory")
      const unsigned sb = (unsigned)(LDS_MAIN + stg * RS + 16384);
      LAS const unsigned* wp = (LAS const unsigned*)(Kt + 32768 + (qh + fr) * 8);
      const unsigned mlo = wp[0] >> (fq * 4), mhi = wp[1] >> (fq * 4);
      unsigned pm[4][2];
#pragma unroll
      for (int ni = 0; ni < 4; ++ni)
#pragma unroll
        for (int jp = 0; jp < 2; ++jp) {
          const unsigned m = (ni < 2) ? mlo : mhi; const int sh = 16 * (ni & 1) + 2 * jp;
          const unsigned lo = (unsigned)__builtin_amdgcn_sbfe((int)m, sh, 1), hi = (unsigned)__builtin_amdgcn_sbfe((int)m, sh + 1, 1);
          pm[ni][jp] = (lo & 0xffffu) | (hi << 16);
        }
      i64 t0, t1, t2, t3, t4, t5, t6, t7, u0, u1, u2, u3, u4, u5, u6, u7;
      __builtin_amdgcn_sched_barrier(0);
      DS_TRI(0, 4096, va0, va1, va2, va3, t0, t1, t2, t3, t4, t5, t6, t7);
      __builtin_amdgcn_sched_barrier(0);
      unsigned pk[2][4][2];
#pragma unroll
      for (int hx = 0; hx < 2; ++hx) {
        float mx = fmaxf(fmaxf(S[hx][0][0], S[hx][0][1]), fmaxf(S[hx][0][2], S[hx][0][3]));
#pragma unroll
        for (int ni = 1; ni < 4; ++ni) mx = fmaxf(mx, fmaxf(fmaxf(S[hx][ni][0], S[hx][ni][1]), fmaxf(S[hx][ni][2], S[hx][ni][3])));
        mx = rowmax4(mx);
        const float mnew = fmaxf(mrun[hx], mx);
        const float alpha = __builtin_amdgcn_exp2f(mrun[hx] - mnew);
        mrun[hx] = mnew;
#pragma unroll
        for (int ni = 0; ni < 4; ++ni)
#pragma unroll
          for (int jp = 0; jp < 2; ++jp)
            pk[hx][ni][jp] = pk2(__builtin_amdgcn_exp2f(S[hx][ni][2 * jp] - mnew), __builtin_amdgcn_exp2f(S[hx][ni][2 * jp + 1] - mnew)) & pm[ni][jp];
        if (__ballot(alpha != 1.0f) != 0ull) {
#pragma unroll
          for (int di = 0; di < 8; ++di) O[hx][di] = O[hx][di] * alpha;
          Lacc[hx] = Lacc[hx] * alpha;
        }
      }
#define DS_PV(di, ta, tb) { const bf16x8 av = __builtin_bit_cast(bf16x8, (i64x2){ta, tb}); \
        O[0][di] = __builtin_amdgcn_mfma_f32_16x16x32_bf16(av, pb0, O[0][di], 0, 0, 0); O[1][di] = __builtin_amdgcn_mfma_f32_16x16x32_bf16(av, pb1, O[1][di], 0, 0, 0); }
      DS_TRW(t0, t1, t2, t3, t4, t5, t6, t7);
      {
        u32x4 pw;
        pw.x = pk[0][0][0]; pw.y = pk[0][0][1]; pw.z = pk[0][1][0]; pw.w = pk[0][1][1];
        const bf16x8 pb0 = __builtin_bit_cast(bf16x8, pw);
        pw.x = pk[1][0][0]; pw.y = pk[1][0][1]; pw.z = pk[1][1][0]; pw.w = pk[1][1][1];
        const bf16x8 pb1 = __builtin_bit_cast(bf16x8, pw);
        DS_TRI(0, 4096, va4, va5, va6, va7, u0, u1, u2, u3, u4, u5, u6, u7);
        __builtin_amdgcn_sched_barrier(0);
        Lacc[0] = __builtin_amdgcn_mfma_f32_16x16x32_bf16(ones8, pb0, Lacc[0], 0, 0, 0);
        Lacc[1] = __builtin_amdgcn_mfma_f32_16x16x32_bf16(ones8, pb1, Lacc[1], 0, 0, 0);
        DS_PV(0, t0, t1) DS_PV(1, t2, t3) DS_PV(2, t4, t5) DS_PV(3, t6, t7)
        __builtin_amdgcn_sched_barrier(0);
        DS_TRW(u0, u1, u2, u3, u4, u5, u6, u7);
        DS_TRI(8192, 12288, va0, va1, va2, va3, t0, t1, t2, t3, t4, t5, t6, t7);
        __builtin_amdgcn_sched_barrier(0);
        DS_PV(4, u0, u1) DS_PV(5, u2, u3) DS_PV(6, u4, u5) DS_PV(7, u6, u7)
        __builtin_amdgcn_sched_barrier(0);
      }
      {
        u32x4 pw;
        pw.x = pk[0][2][0]; pw.y = pk[0][2][1]; pw.z = pk[0][3][0]; pw.w = pk[0][3][1];
        const bf16x8 pb0 = __builtin_bit_cast(bf16x8, pw);
        pw.x = pk[1][2][0]; pw.y = pk[1][2][1]; pw.z = pk[1][3][0]; pw.w = pk[1][3][1];
        const bf16x8 pb1 = __builtin_bit_cast(bf16x8, pw);
        DS_TRW(t0, t1, t2, t3, t4, t5, t6, t7);
        DS_TRI(8192, 12288, va4, va5, va6, va7, u0, u1, u2, u3, u4, u5, u6, u7);
        __builtin_amdgcn_sched_barrier(0);
        Lacc[0] = __builtin_amdgcn_mfma_f32_16x16x32_bf16(ones8, pb0, Lacc[0], 0, 0, 0);
        Lacc[1] = __builtin_amdgcn_mfma_f32_16x16x32_bf16(ones8, pb1, Lacc[1], 0, 0, 0);
        DS_PV(0, t0, t1) DS_PV(1, t2, t3) DS_PV(2, t4, t5) DS_PV(3, t6, t7)
        __builtin_amdgcn_sched_barrier(0);
        DS_TRW(u0, u1, u2, u3, u4, u5, u6, u7);
        DS_PV(4, u0, u1) DS_PV(5, u2, u3) DS_PV(6, u4, u5) DS_PV(7, u6, u7)
      }
#undef DS_PV
#undef DS_TRI
#undef DS_TRW
    }
    asm volatile("s_waitcnt vmcnt(0)" ::: "memory");
#pragma unroll
    for (int hx = 0; hx < 2; ++hx) {
      const float inv = 1.0f / Lacc[hx][0];
      bf16_t* op = A2 + (q0 + qh + fr) * 1024 + 512 + (hd0 + hx) * 128 + fq * 4;
#pragma unroll
      for (int di = 0; di < 8; ++di) { u32x2 wv2; wv2.x = pk2(O[hx][di][0] * inv, O[hx][di][1] * inv); wv2.y = pk2(O[hx][di][2] * inv, O[hx][di][3] * inv); *(u32x2*)(op + di * 16) = wv2; }
    }
    __syncthreads();
  }
#undef DS_ISSUE
#undef DS_GLDS
}
__device__ __forceinline__ void phase3(const Params& p) {
  for (int rep = 0; rep < ((PROBE_DBL == 31) ? 2 : 1); ++rep)
  for (int id = blockIdx.x; id < 64; id += gridDim.x) { mlstm_item(p, id); __syncthreads(); }
  unsigned* qctr = (unsigned*)(p.ws + OFF_CTL) + CW_Q;
  LAS unsigned* qk = (LAS unsigned*)(SMEM + LDS_MISC);
  for (;;) {
    __syncthreads();
    if (threadIdx.x == 0) qk[0] = __hip_atomic_fetch_add(qctr, 1u, __ATOMIC_RELAXED, __HIP_MEMORY_SCOPE_AGENT);
    __syncthreads();
    const unsigned k = qk[0];
    if (k >= 1024u) break;
    dsa_item(p, (int)(k & 15u), 63 - (int)(k >> 4));
  }
}
struct EpiY { bf16_t* Y; int m0, n0;
  __device__ __forceinline__ void operator()(LAS const float* tile, int r, int c0) const { *(u32x4*)(Y + (size_t)(m0 + r) * 1024 + n0 + c0) = pack8(tile + r * TILE_LD + c0); } };
__device__ __forceinline__ void rows6(const Params& p, int row0) {
  const int tid_ = opaque_tid(); const int lane = tid_ & 63, wv = tid_ >> 6;
  const float* mb = (const float*)(p.ws + OFF_MOD) + (row0 >> 12) * 6144;
  const bf16_t* Y = (const bf16_t*)(p.ws + OFF_Y);
  bf16_t* H2 = (bf16_t*)(p.ws + OFF_ACTA); bf16_t* H2L = (bf16_t*)(p.ws + OFF_H2LO);
  float4 gpo[4], gt1[4], gpr[4], sh2[4], sc2[4];
#pragma unroll
  for (int i = 0; i < 4; ++i) { const int c = (lane + 64 * i) * 4; gpo[i] = *(const float4*)(p.g_mix_post + c); gt1[i] = *(const float4*)(mb + 2048 + c);
    gpr[i] = *(const float4*)(p.g_ffn_pre + c); sh2[i] = *(const float4*)(mb + 3072 + c); sc2[i] = *(const float4*)(mb + 4096 + c); }
  u32x2 yn[4]; float4 xn[4];
  const int rfirst = row0 + wv * 32;
#pragma unroll
  for (int i = 0; i < 4; ++i) { const int c = (lane + 64 * i) * 4; yn[i] = __builtin_nontemporal_load((const u32x2*)(Y + (size_t)rfirst * 1024 + c)); xn[i] = *(const float4*)(p.x + (size_t)rfirst * 1024 + c); }
#pragma unroll 1
  for (int r = 0; r < 32; ++r) {
    const int row = rfirst + r;
    u32x2 yc[4]; float4 xc[4];
#pragma unroll
    for (int i = 0; i < 4; ++i) { yc[i] = yn[i]; xc[i] = xn[i]; }
    if (r + 1 < 32) {
#pragma unroll
      for (int i = 0; i < 4; ++i) { const int c = (lane + 64 * i) * 4; yn[i] = __builtin_nontemporal_load((const u32x2*)(Y + (size_t)(row + 1) * 1024 + c)); xn[i] = *(const float4*)(p.x + (size_t)(row + 1) * 1024 + c); }
    }
    float y[16], xv[16]; float ssy = 0.f;
#pragma unroll
    for (int i = 0; i < 4; ++i) {
      y[4 * i] = bflo(yc[i].x); y[4 * i + 1] = bfhi(yc[i].x); y[4 * i + 2] = bflo(yc[i].y); y[4 * i + 3] = bfhi(yc[i].y);
      xv[4 * i] = xc[i].x; xv[4 * i + 1] = xc[i].y; xv[4 * i + 2] = xc[i].z; xv[4 * i + 3] = xc[i].w;
#pragma unroll
      for (int k = 0; k < 4; ++k) ssy += y[4 * i + k] * y[4 * i + k];
    }
    ssy = wave_sum(ssy);
    const float rsy = rsqrtf(ssy * (1.f / 1024.f) + EPS);
    float ss1 = 0.f;
#pragma unroll
    for (int i = 0; i < 4; ++i) {
      const int c = (lane + 64 * i) * 4;
      xv[4 * i] += gt1[i].x * (y[4 * i] * rsy * gpo[i].x); xv[4 * i + 1] += gt1[i].y * (y[4 * i + 1] * rsy * gpo[i].y);
      xv[4 * i + 2] += gt1[i].z * (y[4 * i + 2] * rsy * gpo[i].z); xv[4 * i + 3] += gt1[i].w * (y[4 * i + 3] * rsy * gpo[i].w);
      { u32x2 xb; xb.x = pk2(xv[4 * i], xv[4 * i + 1]); xb.y = pk2(xv[4 * i + 2], xv[4 * i + 3]); *(u32x2*)((bf16_t*)(p.out + (size_t)row * 1024) + c) = xb; }
#pragma unroll
      for (int k = 0; k < 4; ++k) ss1 += xv[4 * i + k] * xv[4 * i + k];
    }
    ss1 = wave_sum(ss1);
    const float rs1 = rsqrtf(ss1 * (1.f / 1024.f) + EPS);
#pragma unroll
    for (int i = 0; i < 4; ++i) {
      const int c = (lane + 64 * i) * 4;
      const float h0 = xv[4 * i] * rs1 * gpr[i].x * (1.f + sc2[i].x) + sh2[i].x, h1 = xv[4 * i + 1] * rs1 * gpr[i].y * (1.f + sc2[i].y) + sh2[i].y;
      const float h2 = xv[4 * i + 2] * rs1 * gpr[i].z * (1.f + sc2[i].z) + sh2[i].z, h3 = xv[4 * i + 3] * rs1 * gpr[i].w * (1.f + sc2[i].w) + sh2[i].w;
      const unsigned hw0 = pk2(h0, h1), hw1 = pk2(h2, h3);
      u32x2 hi; hi.x = hw0; hi.y = hw1;
      u32x2 lo; lo.x = pk2(h0 - bflo(hw0), h1 - bfhi(hw0)); lo.y = pk2(h2 - bflo(hw1), h3 - bfhi(hw1));
      *(u32x2*)(H2 + (size_t)row * 1024 + c) = hi; *(u32x2*)(H2L + (size_t)row * 1024 + c) = lo;
      { int q8 = __builtin_amdgcn_cvt_pk_fp8_f32(__builtin_amdgcn_fmed3f(h0, -448.f, 448.f), __builtin_amdgcn_fmed3f(h1, -448.f, 448.f), 0, false); q8 = __builtin_amdgcn_cvt_pk_fp8_f32(__builtin_amdgcn_fmed3f(h2, -448.f, 448.f), __builtin_amdgcn_fmed3f(h3, -448.f, 448.f), q8, true); *(int*)(p.ws + OFF_H2Q + (size_t)row * 1024 + c) = q8; }
    }
  }
}
constexpr int LDS_RT = LDS_MAIN + 4 * GT_STAGE;
constexpr int LDS_RTX = LDS_RT + 512 + 320 + 1024;
__device__ __forceinline__ void route6g(const Params& p, int mt_begin, int mt_end) {
  const int tid = opaque_tid();
  GemmArgs<3> g{}; g.lda = 1024; g.ldb = 1024; g.K = 1024;
  const bf16_t* Hh = (const bf16_t*)(p.ws + OFF_ACTA); const bf16_t* Hl = (const bf16_t*)(p.ws + OFF_H2LO);
  const bf16_t* Wh = (const bf16_t*)(p.ws + OFF_WR); const bf16_t* Wl = Wh + 128 * 1024;
  g.A0 = Hh; g.B0 = Wh; g.A1 = Hl; g.B1 = Wh; g.A2 = Hh; g.B2 = Wl;
  unsigned* cnt = (unsigned*)(p.ws + OFF_CTL) + CW_CNT;
  int* SORTED = (int*)(p.ws + OFF_SORTED); float* GW = (float*)(p.ws + OFF_GW);
  LAS unsigned* cntl = (LAS unsigned*)(SMEM + LDS_RT); LAS unsigned* basel = cntl + 64;
  for (int rep6 = ((PROBE_DBL == 66) ? 0 : 1); rep6 < 2; ++rep6)
  for (int mt = mt_begin; mt < mt_end; ++mt) {
    const long ar = (long)mt * 128 + (tid >> 3);
    if (tid < 64) cntl[tid] = 0u;
    gemm_mainloop<3, true>(g, ar, ar + 64);
    LAS float* tile = (LAS float*)(SMEM + LDS_MAIN);
    const int tok = mt * 128 + tid;
    LAS int* rei = (LAS int*)(SMEM + LDS_RTX) + tid * 8; LAS float* rgw = (LAS float*)(SMEM + LDS_RTX + 4096) + tid * 8; LAS unsigned* rrk = (LAS unsigned*)(SMEM + LDS_RTX + 8192) + tid * 8;
    if (tid < 128) {
      LAS float* tr = tile + tid * TILE_LD;
      for (int e = 0; e < 64; ++e) { const float s = sigmoidf_(tr[e]); tr[64 + e] = s; tr[e] = s + p.b_router[e]; }
      float gs[8];
#pragma unroll
      for (int gi = 0; gi < 8; ++gi) {
        float m1 = -INFINITY, m2 = -INFINITY;
#pragma unroll
        for (int k = 0; k < 8; ++k) { const float v = tr[gi * 8 + k]; if (v > m1) { m2 = m1; m1 = v; } else if (v > m2) m2 = v; }
        gs[gi] = m1 + m2;
      }
#pragma unroll
      for (int gi = 0; gi < 8; ++gi) {
        int rank = 0;
#pragma unroll
        for (int gj = 0; gj < 8; ++gj) rank += (gs[gj] > gs[gi] || (gs[gj] == gs[gi] && gj < gi)) ? 1 : 0;
        if (rank >= 4) {
#pragma unroll
          for (int k = 0; k < 8; ++k) tr[gi * 8 + k] = -INFINITY; }
      }
      float gsum = 0.f;
#pragma unroll 1
      for (int it = 0; it < 8; ++it) {
        float best = -INFINITY; int bi = 0;
        for (int e = 0; e < 64; ++e) { const float v = tr[e]; if (v > best) { best = v; bi = e; } }
        const float sv = tr[64 + bi];
        rei[it] = bi; rgw[it] = sv; gsum += sv; tr[bi] = -INFINITY;
      }
      const float gn = 2.5f / gsum;
#pragma unroll 1
      for (int it = 0; it < 8; ++it) { rgw[it] *= gn; rrk[it] = __hip_atomic_fetch_add(cntl + rei[it], 1u, __ATOMIC_RELAXED, __HIP_MEMORY_SCOPE_WORKGROUP); }
    }
    __syncthreads();
    if (tid < 64) { const unsigned c = cntl[tid]; basel[tid] = (c && rep6 == 1) ? __hip_atomic_fetch_add(cnt + tid, c, __ATOMIC_RELAXED, __HIP_MEMORY_SCOPE_AGENT) : 0u; }
    __syncthreads();
    if (tid < 128 && rep6 == 1) {
#pragma unroll 1
      for (int it = 0; it < 8; ++it) {
        const int e = rei[it];
        const unsigned pos = basel[e] + rrk[it];
        u32x2 rec; rec.x = (unsigned)(tok * 8 + it); rec.y = __builtin_bit_cast(unsigned, rgw[it]);
        *(u32x2*)(SORTED + ((size_t)e * 65536 + pos) * 2) = rec;
      }
    }
    __syncthreads();
  }
}

struct PanelOrder {
  static constexpr bool REC = false; static constexpr int SCALE_A = 0, SCALE_B = 0;
  int pm; const char* Bt;
  __device__ __forceinline__ bool next(int i, pg8::Unit& u) const { if (i >= 4) return false; u.pm = pm; u.pn = i; u.e = 0; u.lt = 0; return true; }
  __device__ __forceinline__ const char* b_base(const pg8::Unit& u) const { return Bt + (size_t)u.pn * 256 * 1024 * 2; }
  __device__ __forceinline__ unsigned a_off(const pg8::Unit& u, int row) const { return (unsigned)(u.pm * 256 + row) * 2048u; }
  __device__ __forceinline__ const char* rec_ptr(const pg8::Unit&) const { return nullptr; }
  __device__ __forceinline__ bool has_rec(const pg8::Unit&) const { return false; }
  __device__ __forceinline__ bool row_valid(const pg8::Unit&, int) const { return true; }
  __device__ __forceinline__ int nvalid(const pg8::Unit&) const { return 256; }
  __device__ __forceinline__ unsigned a_off_idx(const pg8::Unit&, int, int) const { return 0u; }
};
__device__ __forceinline__ void phase56(const Params& p) {
#pragma unroll 1
  for (int pm = blockIdx.x; pm < 256; pm += gridDim.x) {
    PanelOrder S{pm, (const char*)(p.ws + OFF_WOUT)};
    pg8::EpiStoreBf16 E{(bf16_t*)(p.ws + OFF_Y), 1024};
    pg8::gemm_phase(SMEM + LDS_PG8, (const bf16_t*)(p.ws + OFF_ACTA), 1024, S, E);
    rows6(p, pm * 256);
    asm volatile("s_waitcnt vmcnt(0)" ::: "memory");
    __syncthreads();
    route6g(p, pm * 2, pm * 2 + 2);
  }
}
constexpr int LDS_PRE = LDS_PG8 + 131072 + 8192 + 256;
constexpr int LDS_TAB = LDS_PRE + 1024;
typedef float f32x2 __attribute__((ext_vector_type(2)));
__device__ __forceinline__ void moe_prefix(const Params& p) {
  LAS int* pre = (LAS int*)(SMEM + LDS_PRE); LAS unsigned char* tab = SMEM + LDS_TAB;
  const unsigned* cnt = (const unsigned*)(p.ws + OFF_CTL) + CW_CNT;
  __syncthreads();
  if (threadIdx.x < 64) {
    const int e = threadIdx.x; const int c = (int)cnt[e]; const int nt_ = (c + 255) >> 8; int inc = nt_;
#pragma unroll
    for (int d = 1; d < 64; d <<= 1) { const int o = __shfl_up(inc, d, 64); if (e >= d) inc += o; }
    const int beg = inc - nt_;
    pre[e] = beg; if (e == 63) pre[64] = inc; pre[128 + e] = c;
    for (int t = beg; t < inc; ++t) tab[t] = (unsigned char)e;
  }
  __syncthreads();
}
template <int SA, int SB, int NT>
struct MoeOrder {
  static constexpr bool REC = true;
  static constexpr int SCALE_A = SA * 0x01010101, SCALE_B = SB * 0x01010101;
  int R, nwg, G, c, hf, mode, rowbytes, routed; const unsigned* cnt; const int* list; const char* W; size_t estride, tstride;
  __device__ __forceinline__ bool next(int i, pg8::Unit& u) const {
    const int cc = (c & 7) * (G >> 3) + (c >> 3);
    const int L = i * G + cc; if (L >= nwg) return false;
    u.pm = L / NT; u.pn = L - u.pm * NT;
    if (u.pm >= routed) { u.e = 64; u.lt = u.pm - routed; }
    else { u.e = (int)(SMEM + LDS_TAB)[u.pm]; u.lt = u.pm - ((LAS const int*)(SMEM + LDS_PRE))[u.e]; }
    return true;
  }
  __device__ __forceinline__ const char* b_base(const pg8::Unit& u) const { return W + (size_t)u.e * estride + (size_t)u.pn * tstride; }
  __device__ __forceinline__ const char* rec_ptr(const pg8::Unit& u) const { return (const char*)(list + ((size_t)(u.e < 64 ? u.e : 0) * 65536 + (u.e < 64 ? u.lt * 256 : 0)) * 2); }
  __device__ __forceinline__ bool has_rec(const pg8::Unit& u) const { return u.e < 64; }
  __device__ __forceinline__ bool row_valid(const pg8::Unit& u, int row) const { return (u.lt * 256 + row) < ((LAS const int*)(SMEM + LDS_PRE))[128 + (u.e < 64 ? u.e : 0)]; }
  __device__ __forceinline__ int nvalid(const pg8::Unit& u) const { return ((LAS const int*)(SMEM + LDS_PRE))[128 + (u.e < 64 ? u.e : 0)] - u.lt * 256; }
  __device__ __forceinline__ unsigned a_off_idx(const pg8::Unit& u, int row, int idx) const { const int arow = (mode == 0) ? (idx >> 3) : idx; return (unsigned)arow * (unsigned)rowbytes; }
  __device__ __forceinline__ unsigned a_off(const pg8::Unit& u, int row) const {
    const int tl = u.lt * 256 + row; const int arow = (mode == 0) ? tl : (524288 + tl);
    return (unsigned)arow * (unsigned)rowbytes;
  }
};
constexpr int LDS_EPI = LDS_TAB + 2560;
#define EPI_BAR() do { asm volatile("s_waitcnt lgkmcnt(0)" ::: "memory"); __builtin_amdgcn_s_barrier(); } while (0)
struct EpiU { unsigned char* U; const unsigned* cnt; const int* list; int hf;
  __device__ __forceinline__ void operator()(const f32x4 (&acc)[2][2][4][2], const pg8::Unit& u, int wr, int wc, int fr, int fq, LAS const unsigned char* rec) const {
    const bool rt = u.e < 64;
    const int nrow = rt ? ((LAS const int*)(SMEM + LDS_PRE))[128 + u.e] : 0x7fffffff;
    LAS unsigned char* st = SMEM + LDS_EPI;
    const int tid = (wr * 4 + wc) * 64 + fq * 16 + fr;
    const int c16 = tid & 7;
    int ridx[2][2];
#pragma unroll
    for (int ai = 0; ai < 2; ++ai)
#pragma unroll
      for (int i = 0; i < 2; ++i) ridx[ai][i] = *(LAS const int*)(rec + (ai * 128 + ((tid + 512 * i) >> 3)) * 8);
    unsigned char* dp[2][2]; bool ok[2][2];
#pragma unroll
    for (int ai = 0; ai < 2; ++ai)
#pragma unroll
      for (int i = 0; i < 2; ++i) {
        const int li = u.lt * 256 + ai * 128 + ((tid + 512 * i) >> 3);
        ok[ai][i] = li < nrow;
        const int ur = rt ? ridx[ai][i] : (524288 + li);
        dp[ai][i] = U + (size_t)ur * 256 + u.pn * 128 + c16 * 16;
      }
#pragma unroll
    for (int ai = 0; ai < 2; ++ai) {
#pragma unroll
      for (int m = 0; m < 4; ++m)
#pragma unroll
        for (int bj = 0; bj < 2; ++bj) {
          const f32x4 g = acc[ai][bj][m][0], up = acc[ai][bj][m][1];
          float uu[4];
#pragma unroll
          for (int i = 0; i < 4; ++i) uu[i] = __builtin_amdgcn_fmed3f(siluf_(g[i]) * up[i] * 4.0f, -448.f, 448.f);
          int w8 = __builtin_amdgcn_cvt_pk_fp8_f32(uu[0], uu[1], 0, false);
          w8 = __builtin_amdgcn_cvt_pk_fp8_f32(uu[2], uu[3], w8, true);
          *(LAS int*)(st + (wr * 64 + m * 16 + fr) * 144 + bj * 64 + wc * 16 + 4 * fq) = w8;
        }
      EPI_BAR();
#pragma unroll
      for (int i = 0; i < 2; ++i) {
        const int row = (tid + 512 * i) >> 3;
        if (ok[ai][i]) { const u32x4 v = *(LAS const u32x4*)(st + row * 144 + c16 * 16); *(u32x4*)dp[ai][i] = v; }
      }
      EPI_BAR();
    }
  } };
__device__ __forceinline__ void phase7(const Params& p) {
  const int hf = 0; moe_prefix(p);
  const int routed = ((LAS const int*)(SMEM + LDS_PRE))[64];
  MoeOrder<127, 122, 2> S; S.R = routed + 256; S.nwg = S.R * 2; S.G = gridDim.x; S.c = blockIdx.x; S.hf = hf; S.mode = 0; S.rowbytes = 1024; S.routed = routed;
  S.cnt = (const unsigned*)(p.ws + OFF_CTL) + CW_CNT; S.list = (const int*)(p.ws + OFF_SORTED);
  S.W = (const char*)(p.ws + OFF_WGU); S.estride = (size_t)512 * 1024; S.tstride = (size_t)256 * 1024;
  EpiU E{p.ws + OFF_U, S.cnt, S.list, hf};
  pg8::gemm_phase<EpiU, MoeOrder<127, 122, 2>, true>(SMEM + LDS_PG8, (const bf16_t*)(p.ws + OFF_H2Q), 512, S, E);
}
struct EpiYE { unsigned char* YE; const float* GW; const unsigned* cnt; const int* list; int hf; int pmode;
  __device__ __forceinline__ void operator()(const f32x4 (&acc)[2][2][4][2], const pg8::Unit& u, int wr, int wc, int fr, int fq, LAS const unsigned char* rec) const {
    const bool rt = u.e < 64;
    const int nrow = rt ? ((LAS const int*)(SMEM + LDS_PRE))[128 + u.e] : 0x7fffffff;
    LAS unsigned char* st = SMEM + LDS_EPI;
    const int tid = (wr * 4 + wc) * 64 + fq * 16 + fr;
    const int c16 = tid & 7;
    int gwb[2][4], ridx[2][2];
#pragma unroll
    for (int ai = 0; ai < 2; ++ai) {
#pragma unroll
      for (int m = 0; m < 4; ++m) gwb[ai][m] = ((LAS const int*)(rec + (ai * 128 + wr * 64 + m * 16 + fr) * 8))[1];
#pragma unroll
      for (int i = 0; i < 2; ++i) ridx[ai][i] = *(LAS const int*)(rec + (ai * 128 + ((tid + 512 * i) >> 3)) * 8);
    }
    unsigned char* dp[2][2]; bool ok[2][2];
#pragma unroll
    for (int ai = 0; ai < 2; ++ai)
#pragma unroll
      for (int i = 0; i < 2; ++i) {
        const int li = u.lt * 256 + ai * 128 + ((tid + 512 * i) >> 3);
        ok[ai][i] = li < nrow;
        const int idx = ridx[ai][i];
        const int dst = rt ? ((idx >> 3) * 9 + (idx & 7)) : (li * 9 + 8);
        dp[ai][i] = YE + (size_t)dst * 1024 + u.pn * 256 + c16 * 16;
      }
#pragma unroll
    for (int ai = 0; ai < 2; ++ai) {
      float sc[4];
#pragma unroll
      for (int m = 0; m < 4; ++m) { const int gb = gwb[ai][m]; sc[m] = rt ? YE_SCALE * __builtin_bit_cast(float, gb) : YE_SCALE; }
#pragma unroll
      for (int bj = 0; bj < 2; ++bj) {
#pragma unroll
        for (int m = 0; m < 4; ++m) {
          const f32x4 v0 = acc[ai][bj][m][0] * sc[m], v1 = acc[ai][bj][m][1] * sc[m];
          float o[8] = {v0[0], v0[1], v0[2], v0[3], v1[0], v1[1], v1[2], v1[3]};
#pragma unroll
          for (int i = 0; i < 8; ++i) o[i] = __builtin_amdgcn_fmed3f(o[i], -448.f, 448.f);
          int w0 = 0, w1 = 0;
          w0 = __builtin_amdgcn_cvt_pk_fp8_f32(o[0], o[1], w0, false); w0 = __builtin_amdgcn_cvt_pk_fp8_f32(o[2], o[3], w0, true);
          w1 = __builtin_amdgcn_cvt_pk_fp8_f32(o[4], o[5], w1, false); w1 = __builtin_amdgcn_cvt_pk_fp8_f32(o[6], o[7], w1, true);
          u32x2 w; w.x = (unsigned)w0; w.y = (unsigned)w1;
          *(LAS u32x2*)(st + (wr * 64 + m * 16 + fr) * 144 + wc * 32 + 8 * fq) = w;
        }
        EPI_BAR();
#pragma unroll
        for (int i = 0; i < 2; ++i) {
          const int row = (tid + 512 * i) >> 3;
          if (ok[ai][i]) {
            const u32x4 v = *(LAS const u32x4*)(st + row * 144 + c16 * 16);
            if (PROBE_DBL != 83 || pmode == 0 || v.x == 0x7fc12345u) *(u32x4*)(dp[ai][i] + bj * 128) = v;
          }
        }
        EPI_BAR();
      }
    }
  } };
__device__ __forceinline__ void phase8(const Params& p, const int pmode = 0) {
  const int hf = 0; moe_prefix(p);
  const int routed = ((LAS const int*)(SMEM + LDS_PRE))[64];
  MoeOrder<125, 123, 4> S; S.R = routed + 256; S.nwg = S.R * 4; S.G = gridDim.x; S.c = blockIdx.x; S.hf = hf; S.mode = 1; S.rowbytes = 256; S.routed = routed;
  S.cnt = (const unsigned*)(p.ws + OFF_CTL) + CW_CNT; S.list = (const int*)(p.ws + OFF_SORTED);
  S.W = (const char*)(p.ws + OFF_WDN); S.estride = (size_t)1024 * 256; S.tstride = (size_t)256 * 256;
  EpiYE E{p.ws + OFF_YE, (const float*)(p.ws + OFF_GW), S.cnt, S.list, hf, pmode};
#ifdef PROBE_WI
  if (pmode) pg8::gemm_phase<EpiYE, MoeOrder<125, 123, 4>, true, PROBE_WI>(SMEM + LDS_PG8, (const bf16_t*)(p.ws + OFF_U), 128, S, E); else
#endif
  pg8::gemm_phase<EpiYE, MoeOrder<125, 123, 4>, true>(SMEM + LDS_PG8, (const bf16_t*)(p.ws + OFF_U), 128, S, E);
}
__device__ __forceinline__ void phase9(const Params& p) {
  const int tid_ = opaque_tid(); const int lane = tid_ & 63, gw = blockIdx.x * 8 + (tid_ >> 6), nw = gridDim.x * 8;
  const float* mod = (const float*)(p.ws + OFF_MOD);
  const unsigned char* YE = p.ws + OFF_YE;
  const int c = lane * 16;
  float4 gp[4];
#pragma unroll
  for (int i = 0; i < 4; ++i) gp[i] = *(const float4*)(p.g_ffn_post + c + 4 * i);
  u32x4 vn[9]; u32x4 xn[2];
  if (gw < T_TOK) {
#pragma unroll
    for (int s = 0; s < 9; ++s) vn[s] = *(const u32x4*)(YE + ((size_t)gw * 9 + s) * 1024 + c);
    xn[0] = *(const u32x4*)((const bf16_t*)(p.out + (size_t)gw * 1024) + c); xn[1] = *(const u32x4*)((const bf16_t*)(p.out + (size_t)gw * 1024) + c + 8);
  }
  for (int rep9 = ((PROBE_DBL == 9) ? 0 : 1); rep9 < 2; ++rep9)
#pragma unroll 1
  for (int row = gw; row < T_TOK; row += nw) {
    const int b = row >> 12;
    u32x4 vc[9]; u32x4 xc[2];
#pragma unroll
    for (int s = 0; s < 9; ++s) vc[s] = vn[s];
    xc[0] = xn[0]; xc[1] = xn[1];
    { const int rn = (row + nw < T_TOK) ? row + nw : row;
#pragma unroll
      for (int s = 0; s < 9; ++s) vn[s] = *(const u32x4*)(YE + ((size_t)rn * 9 + s) * 1024 + c);
      xn[0] = *(const u32x4*)((const bf16_t*)(p.out + (size_t)rn * 1024) + c); xn[1] = *(const u32x4*)((const bf16_t*)(p.out + (size_t)rn * 1024) + c + 8); }
    float acc[16];
#pragma unroll
    for (int i = 0; i < 16; ++i) acc[i] = 0.f;
#pragma unroll
    for (int s = 0; s < 9; ++s) {
      const unsigned vw[4] = {vc[s].x, vc[s].y, vc[s].z, vc[s].w};
#pragma unroll
      for (int k = 0; k < 4; ++k) {
        const f32x2 lo = __builtin_amdgcn_cvt_pk_f32_fp8((int)vw[k], false), hi = __builtin_amdgcn_cvt_pk_f32_fp8((int)vw[k], true);
        acc[4 * k] += lo[0]; acc[4 * k + 1] += lo[1]; acc[4 * k + 2] += hi[0]; acc[4 * k + 3] += hi[1];
      }
    }
    float ss = 0.f;
#pragma unroll
    for (int i = 0; i < 16; ++i) { acc[i] *= (1.0f / YE_SCALE); ss += acc[i] * acc[i]; }
    ss = wave_sum(ss);
    const float rs = rsqrtf(ss * (1.f / 1024.f) + EPS);
    float* op = p.out + (size_t)row * 1024 + c;
#pragma unroll
    for (int i = 0; i < 4; ++i) {
      const unsigned xw0 = (i == 0) ? xc[0].x : (i == 1) ? xc[0].z : (i == 2) ? xc[1].x : xc[1].z, xw1 = (i == 0) ? xc[0].y : (i == 1) ? xc[0].w : (i == 2) ? xc[1].y : xc[1].w;
      float4 x1 = make_float4(bflo(xw0), bfhi(xw0), bflo(xw1), bfhi(xw1));
      const float4 gt = *(const float4*)(mod + b * 6144 + 5120 + c + 4 * i);
      x1.x += gt.x * (acc[4 * i] * rs * gp[i].x); x1.y += gt.y * (acc[4 * i + 1] * rs * gp[i].y); x1.z += gt.z * (acc[4 * i + 2] * rs * gp[i].z); x1.w += gt.w * (acc[4 * i + 3] * rs * gp[i].w);
      if (rep9 == 1) *(float4*)(op + 4 * i) = x1; else if (x1.x == 123456.789f) *(float4*)(op + 4 * i) = x1;
    }
  }
}

#define DBL(n, call) do { call; if (PROBE_DBL == (n)) { xcd_barrier(bar); call; } } while (0)
#ifndef STOP_AFTER
#define STOP_AFTER 99
#endif
__global__ void __launch_bounds__(NTHR) fwd_kernel(Params p) {
  volatile LAS unsigned* st = (volatile LAS unsigned*)(SMEM + LDS_ST);
  if (threadIdx.x < 4) st[threadIdx.x] = 0u;
  __syncthreads();
  XcdBarrier bar = xcd_barrier_post((unsigned*)(p.ws + OFF_CTL) + CW_BAR, st);
  __syncthreads();
  DBL(0, phase0(p));  xcd_barrier(bar);
  DBL(1, phase1(p));  xcd_barrier(bar);
  DBL(2, phase2(p));  xcd_barrier(bar);
  DBL(20, phase2b(p)); xcd_barrier(bar);
  DBL(3, phase3(p));  xcd_barrier(bar);
  phase56(p); xcd_barrier(bar);
  DBL(7, phase7(p)); xcd_barrier(bar);
  DBL(8, phase8(p)); if (PROBE_DBL == 83) { xcd_barrier(bar); phase8(p, 1); } xcd_barrier(bar);
  phase9(p);
}

extern "C" void kernel_launch(void* const* d_in, const int* in_sizes, int n_in, void* d_out, int out_size, void* d_ws, size_t ws_size, hipStream_t stream) {
  static int grid_blocks = 0;
  if (!grid_blocks) {
    int dev = 0, cus = 0, per_cu = 0;
    (void)hipGetDevice(&dev);
    (void)hipDeviceGetAttribute(&cus, hipDeviceAttributeMultiprocessorCount, dev);
    (void)hipFuncSetAttribute((const void*)fwd_kernel, hipFuncAttributeMaxDynamicSharedMemorySize, LDS_BYTES);
    (void)hipOccupancyMaxActiveBlocksPerMultiprocessor(&per_cu, (const void*)fwd_kernel, NTHR, LDS_BYTES);
    grid_blocks = cus;
    if (per_cu < 1 || ws_size < WS_NEED || n_in != 25) fprintf(stderr, "kernel_launch: per_cu=%d ws=%zu need=%zu n_in=%d\n", per_cu, ws_size, (size_t)WS_NEED, n_in);
  }
  (void)hipMemsetAsync((char*)d_ws + OFF_CTL, 0, CTL_ZERO_BYTES, stream);
  Params p{};
  const float** f = (const float**)&p;
  for (int i = 0; i < 25; ++i) f[i] = (const float*)d_in[i];
  p.out = (float*)d_out; p.ws = (unsigned char*)d_ws;
  void* args[] = {&p};
  hipError_t e = hipLaunchCooperativeKernel((void*)fwd_kernel, dim3(grid_blocks), dim3(NTHR), args, LDS_BYTES, stream);
  if (e != hipSuccess) fprintf(stderr, "cooperative launch failed: %s (grid %d)\n", hipGetErrorString(e), grid_blocks);
}
```

```cpp
#include <hip/hip_runtime.h>
#include <cstdio>
#include <cstdint>
#ifndef PROBE_DBL
#define PROBE_DBL -1
#endif
#define LAS __attribute__((address_space(3)))
typedef unsigned short bf16_t;
typedef short bf16x8 __attribute__((ext_vector_type(8)));
typedef float f32x4 __attribute__((ext_vector_type(4)));
typedef unsigned u32x4 __attribute__((ext_vector_type(4)));
typedef unsigned u32x2 __attribute__((ext_vector_type(2)));
typedef short v4i16_t __attribute__((ext_vector_type(4)));

constexpr int T_TOK = 65536, DM = 1024, SEQ = 4096, NB = 16;
constexpr int NPROJ = 3328; constexpr int PLD = 3072;
constexpr float EPS = 1e-6f;
constexpr int NTHR = 512;
constexpr size_t MB = 1u << 20;
constexpr size_t OFF_CTL = 0;
constexpr size_t OFF_MOD = 64 * 1024;
constexpr size_t CTL_ZERO_BYTES = 64 * 1024 + 512 * 1024;
constexpr size_t OFF_ROPE = 1 * MB;
constexpr size_t OFF_WR = 2 * MB;
constexpr size_t OFF_WIN = 3 * MB;
constexpr size_t OFF_WOUT = 10 * MB;
constexpr size_t OFF_WGU = 12 * MB;
constexpr size_t OFF_WDN = 80 * MB;
constexpr size_t OFF_ACTA = 116 * MB;
constexpr size_t OFF_P = 244 * MB;
constexpr size_t OFF_PROJ = OFF_P + 0;
constexpr size_t OFF_MQKC = OFF_P + 384 * MB;
constexpr size_t OFF_AK = OFF_P + 512 * MB;
constexpr size_t OFF_IK = OFF_P + 528 * MB;
constexpr size_t OFF_GATES = OFF_P + 536 * MB;
constexpr size_t OFF_IW = OFF_P + 538 * MB;
constexpr size_t OFF_PROJL = OFF_P + 540 * MB;
constexpr size_t OFF_HMRAW = OFF_P + 572 * MB;
constexpr size_t OFF_BITM = OFF_P + 636 * MB;
constexpr size_t OFF_GL = OFF_P + 668 * MB;
constexpr size_t OFF_Y = OFF_P + 0;
constexpr size_t OFF_H2LO = OFF_P + 128 * MB;
constexpr size_t OFF_SORTED = 932 * MB;
constexpr size_t OFF_GW = OFF_P + 272 * MB;
constexpr size_t OFF_H2Q = 868 * MB;
constexpr size_t OFF_U = 724 * MB;
constexpr size_t OFF_YE = 120 * MB;
constexpr size_t WS_NEED = 964 * MB;
constexpr int CW_BAR = 0;
constexpr int CW_CNT = 4096;
constexpr int CW_Q = 4352;
constexpr float YE_SCALE = 16.0f;

struct Params {
  const float *x, *c, *w_ada, *b_ada, *g_mix_pre, *g_mix_post, *g_ffn_pre, *g_ffn_post, *w_in, *conv_w, *conv_b, *b_igate, *b_fgate,
      *g_mlstm_head, *g_idx_k, *b_idx_k, *w_out, *w_router, *b_router, *w_exp_gate, *w_exp_up, *w_exp_down, *w_sh_gate, *w_sh_up, *w_sh_down;
  float* out; unsigned char* ws;
};

__device__ __forceinline__ unsigned f2bf(float f) { unsigned u = __builtin_bit_cast(unsigned, f); return (u + 0x7fffu + ((u >> 16) & 1u)) >> 16; }
typedef float f32x2_t __attribute__((ext_vector_type(2)));
typedef __bf16 bf16x2_t __attribute__((ext_vector_type(2)));
__device__ __forceinline__ unsigned pk2(float lo, float hi) { const f32x2_t v = {lo, hi}; const bf16x2_t b = __builtin_convertvector(v, bf16x2_t); return __builtin_bit_cast(unsigned, b); }
__device__ __forceinline__ float bf2f(unsigned h) { return __builtin_bit_cast(float, h << 16); }
__device__ __forceinline__ float bflo(unsigned w) { return __builtin_bit_cast(float, w << 16); }
__device__ __forceinline__ float bfhi(unsigned w) { return __builtin_bit_cast(float, w & 0xffff0000u); }
typedef short v2i16_t __attribute__((ext_vector_type(2)));
__device__ __forceinline__ int cvt4_fp8(float a, float b, float c, float d) {
  v2i16_t q = {0, 0};
  q = __builtin_amdgcn_cvt_scalef32_pk_fp8_f32(q, a, b, 1.0f, false);
  q = __builtin_amdgcn_cvt_scalef32_pk_fp8_f32(q, c, d, 1.0f, true);
  return __builtin_bit_cast(int, q);
}
__device__ __forceinline__ float mul_s(float a, float b) { float r; asm("v_mul_f32 %0, %1, %2" : "=v"(r) : "v"(a), "v"(b)); return r; }
typedef unsigned u32x2s_t __attribute__((ext_vector_type(2)));
__device__ __forceinline__ float rowmax4(float v) {
  unsigned b = __builtin_bit_cast(unsigned, v);
  u32x2s_t r = __builtin_amdgcn_permlane16_swap(b, b, false, false);
  unsigned r0 = r.x, r1 = r.y;
  v = fmaxf(__builtin_bit_cast(float, r0), __builtin_bit_cast(float, r1));
  b = __builtin_bit_cast(unsigned, v);
  r = __builtin_amdgcn_permlane32_swap(b, b, false, false);
  r0 = r.x; r1 = r.y;
  return fmaxf(__builtin_bit_cast(float, r0), __builtin_bit_cast(float, r1));
}
__device__ __forceinline__ float rowsum4(float v) {
  unsigned b = __builtin_bit_cast(unsigned, v);
  u32x2s_t r = __builtin_amdgcn_permlane16_swap(b, b, false, false);
  unsigned r0 = r.x, r1 = r.y;
  v = __builtin_bit_cast(float, r0) + __builtin_bit_cast(float, r1);
  b = __builtin_bit_cast(unsigned, v);
  r = __builtin_amdgcn_permlane32_swap(b, b, false, false);
  r0 = r.x; r1 = r.y;
  return __builtin_bit_cast(float, r0) + __builtin_bit_cast(float, r1);
}
__device__ __forceinline__ float wave_sum(float v) {
#pragma unroll
  for (int m = 32; m >= 1; m >>= 1) v += __shfl_xor(v, m);
  return v;
}
__device__ __forceinline__ int opaque_tid() { int t = threadIdx.x; asm volatile("" : "+v"(t)); return t; }
__device__ __forceinline__ float sigmoidf_(float x) { return __builtin_amdgcn_rcpf(1.0f + __expf(-x)); }
__device__ __forceinline__ float siluf_(float x) { return x * __builtin_amdgcn_rcpf(1.0f + __expf(-x)); }

#define XB_TMO      128
#define XB_XCNT(j)  (256  + 64 * (j))
#define XB_XSUB(j)  (1280 + 64 * (j))
#define XB_XGEN(j)  (2304 + 64 * (j))
#define XB_TOP      3328
#define XB_TOPGEN   3392
#define XCD_BAR_WORDS 3456
#define XB_SPIN_CAP (1u << 24)
__device__ __forceinline__ unsigned xb_ld(unsigned* p)              { return __hip_atomic_load(p, __ATOMIC_RELAXED, __HIP_MEMORY_SCOPE_AGENT); }
__device__ __forceinline__ unsigned xb_add(unsigned* p, unsigned v) { return __hip_atomic_fetch_add(p, v, __ATOMIC_RELAXED, __HIP_MEMORY_SCOPE_AGENT); }
__device__ __forceinline__ unsigned xb_xcc_id() { return (unsigned)__builtin_amdgcn_s_getreg((3 << 11) | 20) & 0xFu; }
#define XB_SPIN(cond, bar) do { unsigned _sp = 0; while (cond) { __builtin_amdgcn_s_sleep(1); \
    if ((++_sp & 255u) == 0u) { if (xb_ld(&(bar)[XB_TMO])) break; if (_sp > XB_SPIN_CAP) { xb_add(&(bar)[XB_TMO], 1u); break; } } } } while (0)
struct XcdBarrier { unsigned* bar; volatile LAS unsigned* st; };
__device__ __forceinline__ XcdBarrier xcd_barrier_post(unsigned* bar, volatile LAS unsigned* st) {
    XcdBarrier b; b.bar = bar; b.st = st;
    if (threadIdx.x == 0) { const unsigned x = xb_xcc_id(); st[2] = x; (void)xb_add(&bar[XB_XCNT(x)], 1u); }
    return b;
}
__device__ __forceinline__ void xcd_barrier_complete(unsigned* bar, unsigned x, unsigned& nloc, unsigned& nx) {
    const unsigned G = gridDim.x * gridDim.y * gridDim.z;
    unsigned sum, cnt, mine, sp = 0u;
    for (;;) {
        sum = 0u; cnt = 0u; mine = 0u;
#pragma unroll
        for (unsigned j = 0; j < 16; ++j) { const unsigned c = xb_ld(&bar[XB_XCNT(j)]); sum += c; cnt += (c > 0u) ? 1u : 0u; mine = (j == x) ? c : mine; }
        if (sum == G) break;
        __builtin_amdgcn_s_sleep(1);
        if ((++sp & 255u) == 0u) { if (xb_ld(&bar[XB_TMO])) break; if (sp > XB_SPIN_CAP) { xb_add(&bar[XB_TMO], 1u); break; } }
    }
    nloc = mine > 0u ? mine : 1u; nx = cnt > 0u ? cnt : 1u;
}
__device__ __forceinline__ void xcd_barrier(const XcdBarrier& b) {
    asm volatile("s_waitcnt vmcnt(0)" ::: "memory");
    __syncthreads();
    if (threadIdx.x == 0) {
        unsigned* bar = b.bar;
        __builtin_amdgcn_s_waitcnt(0);
        unsigned nloc = b.st[0], nx = b.st[1]; const unsigned bx = b.st[2];
        if (nloc == 0u) { xcd_barrier_complete(bar, bx, nloc, nx); b.st[0] = nloc; b.st[1] = nx; }
        const unsigned old = xb_add(&bar[XB_XSUB(bx)], 1u);
        const unsigned gen = old / nloc;
        if (old + 1u == (gen + 1u) * nloc) {
            __builtin_amdgcn_fence(__ATOMIC_RELEASE, "agent");
            asm volatile("s_waitcnt vmcnt(0)" ::: "memory");
            const unsigned og = xb_add(&bar[XB_TOP], 1u);
            const unsigned tg = og / nx;
            if (og + 1u == (tg + 1u) * nx) xb_add(&bar[XB_TOPGEN], 1u);
            else XB_SPIN(xb_ld(&bar[XB_TOPGEN]) == tg, bar);
            __builtin_amdgcn_fence(__ATOMIC_ACQUIRE, "agent");
            xb_add(&bar[XB_XGEN(bx)], 1u);
            asm volatile("s_waitcnt vmcnt(0)" ::: "memory");
        } else {
            XB_SPIN(xb_ld(&bar[XB_XGEN(bx)]) == gen, bar);
            __builtin_amdgcn_fence(__ATOMIC_ACQUIRE, "agent");
            asm volatile("s_waitcnt vmcnt(0)" ::: "memory");
        }
    }
    __syncthreads();
}

extern __shared__ __attribute__((aligned(16))) unsigned char smem_raw[];
#define SMEM ((LAS unsigned char*)smem_raw)
constexpr int LDS_ST = 0;
constexpr int LDS_MISC = 16;
constexpr int LDS_MAIN = 1040;
constexpr int LDS_BYTES = 160 * 1024;
constexpr int GT_STAGE = 32768, TILE_LD = 132;
__device__ __forceinline__ int swz_off(int r, int c8) { return r * 128 + ((c8 ^ (r & 7)) << 4); }
template <int NSEG> struct GemmArgs { const bf16_t *A0, *A1, *A2, *B0, *B1, *B2; int lda, ldb, K; };

template <int NSEG, bool NTA = false>
__device__ __forceinline__ void gemm_mainloop(const GemmArgs<NSEG>& g, long arow0, long arow1) {
  const int tid = opaque_tid(), lane = tid & 63, wid = __builtin_amdgcn_readfirstlane(tid >> 6), wr = wid >> 2, wc = wid & 3, fr = lane & 15, fq = lane >> 4;
  const int r0 = tid >> 3, cs = ((tid & 7) ^ (r0 & 7)) * 8;
  const int nk = g.K >> 6, nsteps = NSEG * nk;
  f32x4 acc[4][2];
#pragma unroll
  for (int m = 0; m < 4; ++m)
#pragma unroll
    for (int n = 0; n < 2; ++n) acc[m][n] = (f32x4){0.f, 0.f, 0.f, 0.f};
  LAS unsigned char* ring = SMEM + LDS_MAIN;
#define GM_ISSUE(s_) do { int s1_ = (s_) < nsteps ? (s_) : nsteps - 1; int seg_ = 0, ks_ = s1_; if (NSEG > 1) { seg_ = s1_ / nk; ks_ = s1_ - seg_ * nk; } \
    const bf16_t* Ap_ = g.A0; const bf16_t* Bp_ = g.B0; if (NSEG > 1) { if (seg_ == 1) { Ap_ = g.A1; Bp_ = g.B1; } else if (seg_ == 2) { Ap_ = g.A2; Bp_ = g.B2; } } \
    LAS unsigned char* st_ = ring + ((s_) & 3) * GT_STAGE + wid * 1024; const int k0_ = ks_ * 64 + cs; \
    if (NTA) { __builtin_amdgcn_global_load_lds((const unsigned*)(Ap_ + arow0 * g.lda + k0_), (LAS unsigned*)st_, 16, 0, 2); __builtin_amdgcn_global_load_lds((const unsigned*)(Ap_ + arow1 * g.lda + k0_), (LAS unsigned*)(st_ + 8192), 16, 0, 2); } \
    else { __builtin_amdgcn_global_load_lds((const unsigned*)(Ap_ + arow0 * g.lda + k0_), (LAS unsigned*)st_, 16, 0, 0); __builtin_amdgcn_global_load_lds((const unsigned*)(Ap_ + arow1 * g.lda + k0_), (LAS unsigned*)(st_ + 8192), 16, 0, 0); } \
    __builtin_amdgcn_global_load_lds((const unsigned*)(Bp_ + (long)r0 * g.ldb + k0_), (LAS unsigned*)(st_ + 16384), 16, 0, 0); \
    __builtin_amdgcn_global_load_lds((const unsigned*)(Bp_ + (long)(r0 + 64) * g.ldb + k0_), (LAS unsigned*)(st_ + 16384 + 8192), 16, 0, 0); } while (0)
  asm volatile("s_waitcnt vmcnt(0)" ::: "memory");
  GM_ISSUE(0); GM_ISSUE(1); GM_ISSUE(2);
#pragma unroll 1
  for (int s = 0; s < nsteps; ++s) {
    asm volatile("s_waitcnt vmcnt(8)" ::: "memory");
    asm volatile("s_waitcnt lgkmcnt(0)" ::: "memory");
    __builtin_amdgcn_s_barrier();
    GM_ISSUE(s + 3);
    LAS unsigned char* sa = ring + (s & 3) * GT_STAGE;
    LAS unsigned char* sb = sa + 16384;
#pragma unroll
    for (int kk = 0; kk < 2; ++kk) {
      bf16x8 af[4], bfr[2];
#pragma unroll
      for (int m = 0; m < 4; ++m) af[m] = *(LAS bf16x8*)(sa + swz_off(wr * 64 + m * 16 + fr, kk * 4 + fq));
#pragma unroll
      for (int n = 0; n < 2; ++n) bfr[n] = *(LAS bf16x8*)(sb + swz_off(wc * 32 + n * 16 + fr, kk * 4 + fq));
#pragma unroll
      for (int m = 0; m < 4; ++m)
#pragma unroll
        for (int n = 0; n < 2; ++n) acc[m][n] = __builtin_amdgcn_mfma_f32_16x16x32_bf16(af[m], bfr[n], acc[m][n], 0, 0, 0);
    }
  }
#undef GM_ISSUE
  asm volatile("s_waitcnt vmcnt(0)" ::: "memory");
  asm volatile("s_waitcnt lgkmcnt(0)" ::: "memory");
  __builtin_amdgcn_s_barrier();
  LAS float* tile = (LAS float*)(SMEM + LDS_MAIN);
#pragma unroll
  for (int m = 0; m < 4; ++m)
#pragma unroll
    for (int n = 0; n < 2; ++n)
#pragma unroll
      for (int j = 0; j < 4; ++j) tile[(wr * 64 + m * 16 + fq * 4 + j) * TILE_LD + wc * 32 + n * 16 + fr] = acc[m][n][j];
  __syncthreads();
}
template <int NSEG, class Epi>
__device__ __forceinline__ void gemm_tile(const GemmArgs<NSEG>& g, long arow0, long arow1, Epi&& epi) {
  gemm_mainloop<NSEG>(g, arow0, arow1);
  LAS const float* tile = (LAS const float*)(SMEM + LDS_MAIN);
  const int tid = opaque_tid();
#pragma unroll 1
  for (int i = 0; i < 4; ++i) { const int id = tid + i * NTHR; epi(tile, id >> 4, (id & 15) * 8); }
  __syncthreads();
}
__device__ __forceinline__ u32x4 pack8(LAS const float* p) {
  const f32x4 v0 = *(LAS const f32x4*)p, v1 = *(LAS const f32x4*)(p + 4);
  u32x4 w; w.x = pk2(v0[0], v0[1]); w.y = pk2(v0[2], v0[3]); w.z = pk2(v1[0], v1[1]); w.w = pk2(v1[2], v1[3]); return w;
}

__device__ __forceinline__ int win_rowmap(int n) {
  if (n < 2048) return n;
  if (n < 2056) return 3136 + (n - 2048);
  if (n < 2568) return 2048 + (n - 2056);
  if (n < 2696) return 2560 + (n - 2568);
  if (n < 2824) return 2688 + (n - 2696);
  if (n < 3080) return 2816 + (n - 2824);
  if (n < 3144) return 3072 + (n - 3080);
  return n;
}
template <int KIND, int MODE>
__device__ __forceinline__ void cvt_tile(const float* src, int ld_src, int nvalid, int k0, int n0, bf16_t* dst, int ld_dst) {
  LAS bf16_t* tt = (LAS bf16_t*)(SMEM + LDS_MAIN);
  const int tid = opaque_tid();
  {
    const int n = tid & 63, kb = tid >> 6;
    const bool ok = (n0 + n) < nvalid;
#pragma unroll
    for (int i = 0; i < 8; ++i) {
      const int k = kb + 8 * i;
      float v = ok ? src[(long)(k0 + k) * ld_src + n0 + n] : 0.f;
      unsigned h = f2bf(v);
      if (MODE == 1) h = f2bf(v - bf2f(h));
      tt[n * 72 + k] = (bf16_t)h;
    }
  }
  __syncthreads();
  {
    const int n = tid >> 3, kc = tid & 7; const int nn = n0 + n;
    int r;
    if (KIND == 0) r = nn; else if (KIND == 1) r = win_rowmap(nn); else if (KIND == 2) r = (nn >> 2) * 8 + (nn & 3); else r = (nn >> 2) * 8 + 4 + (nn & 3);
    const u32x4 v = *(LAS const u32x4*)(tt + n * 72 + kc * 8);
    *(u32x4*)(dst + (long)r * ld_dst + k0 + kc * 8) = v;
  }
  __syncthreads();
}
template <int KIND>
__device__ __forceinline__ void cvt_tile8(const float* src, int ld_src, int k0, int n0, unsigned char* dst, int ld_dst, float scale) {
  LAS unsigned char* tt = SMEM + LDS_MAIN;
  const int tid = opaque_tid();
  {
    const int n = tid & 63, kb = tid >> 6;
#pragma unroll
    for (int i = 0; i < 4; ++i) {
      const int k = kb * 2 + 16 * i;
      const float v0 = __builtin_amdgcn_fmed3f(src[(long)(k0 + k) * ld_src + n0 + n] * scale, -448.f, 448.f), v1 = __builtin_amdgcn_fmed3f(src[(long)(k0 + k + 1) * ld_src + n0 + n] * scale, -448.f, 448.f);
      v2i16_t wq = {0, 0}; wq = __builtin_amdgcn_cvt_scalef32_pk_fp8_f32(wq, v0, v1, 1.0f, false); const int w = __builtin_bit_cast(int, wq);
      *(LAS unsigned short*)(tt + n * 80 + k) = (unsigned short)(w & 0xffff);
    }
  }
  __syncthreads();
  if (tid < 256) {
    const int n = tid >> 2, kc = tid & 3; const int nn = n0 + n;
    int r;
    if (KIND == 0) r = nn; else if (KIND == 2) r = (nn >> 2) * 8 + (nn & 3); else r = (nn >> 2) * 8 + 4 + (nn & 3);
    const u32x4 v = *(LAS const u32x4*)(tt + n * 80 + kc * 16);
    *(u32x4*)(dst + (long)r * ld_dst + k0 + kc * 16) = v;
  }
  __syncthreads();
}
__device__ __forceinline__ void sincos_d(double a, float& s, float& c) {
  const double twopi = 6.283185307179586476925286766559, inv = 0.15915494309189533576888376337251;
  const double k = __builtin_rint(a * inv);
  const double r = a - k * twopi;
  const double r2 = r * r;
  double ts = 1.0, tc = 1.0, ss = 1.0, cs = 1.0;
#pragma unroll
  for (int i = 1; i <= 13; ++i) { tc = -tc * r2 / (double)((2 * i - 1) * (2 * i)); cs += tc; ts = -ts * r2 / (double)((2 * i) * (2 * i + 1)); ss += ts; }
  s = (float)(r * ss); c = (float)cs;
}
__device__ __forceinline__ void phase0(const Params& p) {
  unsigned char* ws = p.ws;
  const int tid = opaque_tid();
  constexpr int U_WIN = 16 * 52, U_WOUT = 256, U_EG = 65 * 64, U_EU = 65 * 64, U_ED = 65 * 64, U_R = 64, U_ADA = 48, U_ROPE = 192;
  constexpr int B1 = U_WIN, B2 = B1 + U_WOUT, B3 = B2 + U_EG, B4 = B3 + U_EU, B5 = B4 + U_ED, B6 = B5 + U_R, B7 = B6 + U_ADA, B8 = B7 + U_ROPE;
  for (int u = blockIdx.x; u < B8; u += gridDim.x) {
    if (u < B1) { const int kt = u / 52, nt = u % 52; cvt_tile<1, 0>(p.w_in, 3148, 3148, kt * 64, nt * 64, (bf16_t*)(ws + OFF_WIN), 1024); }
    else if (u < B2) { const int v = u - B1, kt = v >> 4, nt = v & 15; cvt_tile<0, 0>(p.w_out, 1024, 1024, kt * 64, nt * 64, (bf16_t*)(ws + OFF_WOUT), 1024); }
    else if (u < B4) {
      const bool up = u >= B3; const int v = up ? u - B3 : u - B2; const int e = v >> 6, kt = (v >> 2) & 15, nt = v & 3;
      const float* src = (e < 64) ? ((up ? p.w_exp_up : p.w_exp_gate) + (size_t)e * 1024 * 256) : (up ? p.w_sh_up : p.w_sh_gate);
      unsigned char* dst = ws + OFF_WGU + (size_t)e * 512 * 1024;
      if (up) cvt_tile8<3>(src, 256, kt * 64, nt * 64, dst, 1024, 32.0f); else cvt_tile8<2>(src, 256, kt * 64, nt * 64, dst, 1024, 32.0f);
    }
    else if (u < B5) {
      const int v = u - B4; const int e = v >> 6, kt = (v >> 4) & 3, nt = v & 15;
      const float* src = (e < 64) ? (p.w_exp_down + (size_t)e * 256 * 1024) : p.w_sh_down;
      cvt_tile8<0>(src, 1024, kt * 64, nt * 64, ws + OFF_WDN + (size_t)e * 1024 * 256, 256, 16.0f);
    }
    else if (u < B6) {
      const int v = u - B5; const int lo = v >> 5, kt = (v >> 1) & 15, nt = v & 1;
      bf16_t* dst = (bf16_t*)(ws + OFF_WR) + (size_t)lo * 128 * 1024;
      if (lo) cvt_tile<0, 1>(p.w_router, 64, 64, kt * 64, nt * 64, dst, 1024); else cvt_tile<0, 0>(p.w_router, 64, 64, kt * 64, nt * 64, dst, 1024);
    }
    else if (u < B7) {
      const int v = u - B6;
      LAS float* sc = (LAS float*)(SMEM + LDS_MAIN);
      LAS float* part = sc + 16 * 1024;
      for (int i = tid; i < 16 * 1024; i += NTHR) sc[i] = siluf_(p.c[i]);
      __syncthreads();
      const int jl = tid & 127, dq = tid >> 7, j = v * 128 + jl;
      float acc[16];
#pragma unroll
      for (int b = 0; b < 16; ++b) acc[b] = 0.f;
      const float* wp = p.w_ada + (size_t)(dq * 256) * 6144 + j;
#pragma unroll 4
      for (int d = 0; d < 256; ++d) {
        const float w = wp[(size_t)d * 6144];
#pragma unroll
        for (int b = 0; b < 16; ++b) acc[b] += sc[b * 1024 + dq * 256 + d] * w;
      }
#pragma unroll
      for (int b = 0; b < 16; ++b) part[(dq * 16 + b) * 128 + jl] = acc[b];
      __syncthreads();
      float* mod = (float*)(ws + OFF_MOD);
      for (int i = tid; i < 16 * 128; i += NTHR) {
        const int b = i >> 7, jj = i & 127;
        mod[b * 6144 + v * 128 + jj] = ((part[(0 * 16 + b) * 128 + jj] + part[(1 * 16 + b) * 128 + jj]) + (part[(2 * 16 + b) * 128 + jj] + part[(3 * 16 + b) * 128 + jj])) + p.b_ada[v * 128 + jj];
      }
      __syncthreads();
    }
    else {
      const int v = u - B7; const int idx = v * NTHR + tid;
      const int pos = idx / 24, f = idx - pos * 24;
      const double lt = 13.122363377404328;
      float s, c;
      if (f < 16) { const double inv = exp(-lt * (double)f * (2.0 / 32.0)); sincos_d((double)pos * inv, s, c);
        float* R = (float*)(ws + OFF_ROPE); R[(pos * 16 + f) * 2] = c; R[(pos * 16 + f) * 2 + 1] = s; }
      else { const int g = f - 16; const double inv = exp(-lt * (double)g * (2.0 / 16.0)); sincos_d((double)pos * inv, s, c);
        float* R = (float*)(ws + OFF_ROPE) + 4096 * 32; R[(pos * 8 + g) * 2] = c; R[(pos * 8 + g) * 2 + 1] = s; }
    }
  }
}
namespace pg8 {
constexpr int BM = 256, BK = 64, HALF = 128, HTB = HALF * BK * 2, STAGE_BYTES = 8 * HTB;
__device__ __forceinline__ int lds_byte(int r, int c) { const int st = (r >> 4) * 2 + (c >> 5), rr = r & 15, cc = c & 31, ob = rr * 64 + cc * 2; return st * 1024 + (ob ^ (((ob >> 9) & 1) << 5)); }
__device__ __forceinline__ void stage_rc(int b, int& R, int& C) { const int st = b / 1024, sb = b % 1024, swz = sb ^ (((sb >> 9) & 1) << 5); R = (st >> 1) * 16 + swz / 64; C = (st & 1) * 32 + (swz % 64) / 2; }
__device__ __forceinline__ int perm32(int rho) { const int n = rho >> 4, i = rho & 15; return 8 * (i >> 2) + 4 * n + (i & 3); }
struct Unit { int pm, pn, e, lt; };
typedef int v8i_t __attribute__((ext_vector_type(8)));
typedef int v4i_t __attribute__((ext_vector_type(4)));
template <class Epi, class Sched, bool FP8 = false, int WI = 0>
__device__ __forceinline__ void gemm_phase(LAS unsigned char* lds, const bf16_t* Abase, const int K, const Sched& S, const Epi& E) {
    const int tid = opaque_tid(), wid = __builtin_amdgcn_readfirstlane(tid >> 6), lane = tid & 63, wr = wid >> 2, wc = wid & 3, fr = lane & 15, fq = lane >> 4;
    const int nt = K / BK;
    int Rr[2], Cc[2]; unsigned voffB[2];
#pragma unroll
    for (int i = 0; i < 2; ++i) { int R, C; stage_rc(tid * 16 + i * 8192, R, C); Rr[i] = R; Cc[i] = C * 2; const int Rb = (R & ~31) + perm32(R & 31); voffB[i] = (unsigned)(Rb * K + C) * 2u; }
    const size_t kstep = (size_t)(BK * 2);
    const size_t hstep = (size_t)HALF * K * 2;
    const unsigned ldsw = (unsigned)wid * 1024u;
    const int aoff = lds_byte(wr * 64 + fr, fq * 8), boff = lds_byte(wc * 32 + fr, fq * 8);
    const char* Ab = (const char*)Abase;
    LAS unsigned char* recb = lds + STAGE_BYTES;
#define PG8_RECISSUE(u_, slot_) do { if (Sched::REC) __builtin_amdgcn_global_load_lds((const unsigned*)(S.rec_ptr(u_) + tid * 4), (LAS unsigned*)(recb + (slot_) * 2048 + wid * 256), 4, 0, 0); } while (0)
#define PG8_AOFF(u_, slot_, row_) ((Sched::REC && S.has_rec(u_)) ? S.a_off_idx(u_, row_, *(const LAS int*)(recb + (slot_) * 2048 + (S.row_valid(u_, row_) ? (row_) : 0) * 8)) : S.a_off(u_, row_))
#define PG8_SA(b, h) (((b) * 2 + (h)) * HTB)
#define PG8_SB(b, h) ((4 + (b) * 2 + (h)) * HTB)
#define PG8_STAGEB(bufoff, gbase) do { if (!(WI & 2)) _Pragma("unroll") for (int _i = 0; _i < 2; ++_i) \
        __builtin_amdgcn_global_load_lds((const unsigned*)((const char*)(gbase) + voffB[_i]), (LAS unsigned*)(lds + (bufoff) + ldsw + _i * 8192), 16, 0, 0); } while (0)
#define PG8_STAGEA(bufoff, koff, o0, o1) do { if (!(WI & 1)) { \
        __builtin_amdgcn_global_load_lds((const unsigned*)(Ab + (koff) + (o0)), (LAS unsigned*)(lds + (bufoff) + ldsw), 16, 0, 0); \
        __builtin_amdgcn_global_load_lds((const unsigned*)(Ab + (koff) + (o1)), (LAS unsigned*)(lds + (bufoff) + ldsw + 8192), 16, 0, 0); } } while (0)
#define PG8_LDA(dst, b, h) do { if (!(WI & 8)) _Pragma("unroll") for (int m = 0; m < 4; ++m) { dst[m].lo = *(const LAS v4i_t*)(lds + PG8_SA(b, h) + aoff + m * 2048); dst[m].hi = *(const LAS v4i_t*)(lds + PG8_SA(b, h) + aoff + m * 2048 + 1024); } } while (0)
#define PG8_LDB(dst, b, h) do { if (!(WI & 8)) _Pragma("unroll") for (int n = 0; n < 2; ++n) { dst[n].lo = *(const LAS v4i_t*)(lds + PG8_SB(b, h) + boff + n * 2048); dst[n].hi = *(const LAS v4i_t*)(lds + PG8_SB(b, h) + boff + n * 2048 + 1024); } } while (0)
#define PG8_MMA(ai, bj, At, Bt) do { __builtin_amdgcn_s_setprio(1); if (!(WI & 16)) _Pragma("unroll") for (int m = 0; m < 4; ++m) _Pragma("unroll") for (int n = 0; n < 2; ++n) { \
        if (FP8) asm volatile("v_mfma_scale_f32_16x16x128_f8f6f4 %0, %1, %2, %0, %3, %4 op_sel_hi:[0,0,0]" : "+v"(acc[ai][bj][m][n]) : "v"(Bt[n]), "v"(At[m]), "v"(sclB), "v"(sclA)); \
        else { const v4i_t bl_ = Bt[n].lo, bh_ = Bt[n].hi, al_ = At[m].lo, ah_ = At[m].hi;     \
               acc[ai][bj][m][n] = __builtin_amdgcn_mfma_f32_16x16x32_bf16(__builtin_bit_cast(bf16x8, bl_), __builtin_bit_cast(bf16x8, al_), acc[ai][bj][m][n], 0, 0, 0); \
               acc[ai][bj][m][n] = __builtin_amdgcn_mfma_f32_16x16x32_bf16(__builtin_bit_cast(bf16x8, bh_), __builtin_bit_cast(bf16x8, ah_), acc[ai][bj][m][n], 0, 0, 0); } } \
        __builtin_amdgcn_s_setprio(0); } while (0)
#define PG8_WAIT_V(n) asm volatile("s_waitcnt vmcnt(" #n ")" ::: "memory")
#define PG8_WAIT_VF(f) do { if (Sched::BSTAT && (f)) asm volatile("s_waitcnt vmcnt(4)" ::: "memory"); else asm volatile("s_waitcnt vmcnt(8)" ::: "memory"); } while (0)
#define PG8_WAIT_VG(f) do { if (Sched::BSTAT && (f)) asm volatile("s_waitcnt vmcnt(5)" ::: "memory"); else asm volatile("s_waitcnt vmcnt(8)" ::: "memory"); } while (0)
#define PG8_WAIT_L(n) asm volatile("s_waitcnt lgkmcnt(" #n ")" ::: "memory")
#define PG8_BAR do { if (!(WI & 32)) __builtin_amdgcn_s_barrier(); } while (0)
#define PG8_SCHED __builtin_amdgcn_sched_barrier(0)
    Unit cur, nxt; int ui = 0;
    if (!S.next(0, cur)) return;
    f32x4 acc[2][2][4][2];
#pragma unroll
    for (int a = 0; a < 2; ++a)
#pragma unroll
        for (int b = 0; b < 2; ++b)
#pragma unroll
            for (int m = 0; m < 4; ++m)
#pragma unroll
                for (int n = 0; n < 2; ++n) acc[a][b][m][n] = (f32x4){0.f, 0.f, 0.f, 0.f};
    v8i_t At[4], B0[2], B1[2];
    if (WI & 8) { _Pragma("unroll") for (int m = 0; m < 4; ++m) At[m] = (v8i_t){tid, m, 3, 4, 5, 6, 7, 8}; B0[0] = B0[1] = B1[0] = B1[1] = (v8i_t){tid, 1, 2, 3, 4, 5, 6, 7}; }
    int sclA = Sched::SCALE_A, sclB = Sched::SCALE_B; asm volatile("" : "+v"(sclA), "+v"(sclB));
    const char* cB = S.b_base(cur);
    Unit nn; bool has_nn = false;
    if (Sched::REC) { has_nn = S.next(1, nn); PG8_RECISSUE(cur, 0); PG8_RECISSUE(has_nn ? nn : cur, 1); asm volatile("s_waitcnt vmcnt(0)" ::: "memory"); __syncthreads(); }
    unsigned vc00 = PG8_AOFF(cur, 0, Rr[0]) + Cc[0], vc01 = PG8_AOFF(cur, 0, Rr[1]) + Cc[1], vc10 = PG8_AOFF(cur, 0, HALF + Rr[0]) + Cc[0], vc11 = PG8_AOFF(cur, 0, HALF + Rr[1]) + Cc[1];
    int slot = 0; bool skp = false;
    PG8_STAGEB(PG8_SB(0, 0), cB); PG8_STAGEB(PG8_SB(0, 1), cB + hstep); PG8_STAGEA(PG8_SA(0, 0), 0, vc00, vc01); PG8_STAGEA(PG8_SA(0, 1), 0, vc10, vc11);
    if (wr == 1) PG8_BAR;
    PG8_WAIT_V(2); PG8_BAR;
    PG8_STAGEB(PG8_SB(1, 0), cB + kstep); PG8_STAGEA(PG8_SA(1, 0), kstep, vc00, vc01); PG8_STAGEB(PG8_SB(1, 1), cB + hstep + kstep);
    PG8_WAIT_V(6); PG8_BAR;
    for (;;) {
        bool has_next;
        if (Sched::REC) { has_next = has_nn; nxt = nn; has_nn = S.next(ui + 2, nn); } else has_next = S.next(ui + 1, nxt);
        const char* nB = has_next ? S.b_base(nxt) : cB;
        unsigned vn00 = vc00, vn01 = vc01, vn10 = vc10, vn11 = vc11;
        const int nslot = (slot + 1) & 3;
        if (Sched::REC) { PG8_RECISSUE(has_nn ? nn : cur, (slot + 2) & 3); }
        else if (has_next) { vn00 = S.a_off(nxt, Rr[0]) + Cc[0]; vn01 = S.a_off(nxt, Rr[1]) + Cc[1]; vn10 = S.a_off(nxt, HALF + Rr[0]) + Cc[0]; vn11 = S.a_off(nxt, HALF + Rr[1]) + Cc[1]; }
#pragma unroll 1
        for (int t = 0; t < nt; t += 2) {
            const bool last = (t == nt - 2);
            const bool skb = Sched::BSTAT && last && has_next && (nB == cB);
            const size_t ko1 = (size_t)(t + 1) * kstep;
            const size_t ko2 = last ? 0 : (size_t)(t + 2) * kstep, ko3 = ko2 + kstep;
            const char* b2 = last ? nB : cB + (size_t)(t + 2) * kstep; const char* b3 = b2 + kstep;
            if (Sched::REC && last && has_next) {
                if (S.has_rec(nxt)) {
                    const int nv = S.nvalid(nxt); LAS const unsigned char* rb = recb + nslot * 2048;
                    const int q00 = Rr[0] < nv ? Rr[0] : 0, q01 = Rr[1] < nv ? Rr[1] : 0, q10 = (HALF + Rr[0]) < nv ? (HALF + Rr[0]) : 0, q11 = (HALF + Rr[1]) < nv ? (HALF + Rr[1]) : 0;
                    const int i00 = *(LAS const int*)(rb + q00 * 8), i01 = *(LAS const int*)(rb + q01 * 8), i10 = *(LAS const int*)(rb + q10 * 8), i11 = *(LAS const int*)(rb + q11 * 8);
                    vn00 = S.a_off_idx(nxt, 0, i00) + Cc[0]; vn01 = S.a_off_idx(nxt, 0, i01) + Cc[1]; vn10 = S.a_off_idx(nxt, 0, i10) + Cc[0]; vn11 = S.a_off_idx(nxt, 0, i11) + Cc[1];
                } else { vn00 = S.a_off(nxt, Rr[0]) + Cc[0]; vn01 = S.a_off(nxt, Rr[1]) + Cc[1]; vn10 = S.a_off(nxt, HALF + Rr[0]) + Cc[0]; vn11 = S.a_off(nxt, HALF + Rr[1]) + Cc[1]; }
            }
            const unsigned o00 = last ? vn00 : vc00, o01 = last ? vn01 : vc01, o10 = last ? vn10 : vc10, o11 = last ? vn11 : vc11;
            PG8_LDB(B0, 0, 0); PG8_LDB(B1, 0, 1); PG8_SCHED; PG8_LDA(At, 0, 0); PG8_STAGEA(PG8_SA(1, 1), ko1, vc10, vc11);
            PG8_WAIT_VG(skp); PG8_WAIT_L(0); PG8_BAR; PG8_MMA(0, 0, At, B0); PG8_MMA(0, 1, At, B1); PG8_BAR; PG8_SCHED;
            PG8_LDA(At, 0, 1); if (!skb) { PG8_STAGEB(PG8_SB(0, 0), b2); PG8_STAGEB(PG8_SB(0, 1), b2 + hstep); } PG8_STAGEA(PG8_SA(0, 0), ko2, o00, o01);
            PG8_WAIT_VG(skb); PG8_WAIT_L(0); PG8_BAR; PG8_MMA(1, 0, At, B0); PG8_MMA(1, 1, At, B1); PG8_BAR; PG8_SCHED;
            PG8_LDB(B0, 1, 0); PG8_LDB(B1, 1, 1); PG8_SCHED; PG8_LDA(At, 1, 0); PG8_STAGEA(PG8_SA(0, 1), ko2, o10, o11);
            PG8_WAIT_VF(skb); PG8_WAIT_L(0); PG8_BAR; PG8_MMA(0, 0, At, B0); PG8_MMA(0, 1, At, B1); PG8_BAR; PG8_SCHED;
            PG8_LDA(At, 1, 1); if (!skb) { PG8_STAGEB(PG8_SB(1, 0), b3); PG8_STAGEB(PG8_SB(1, 1), b3 + hstep); } PG8_STAGEA(PG8_SA(1, 0), ko3, o00, o01);
            PG8_WAIT_VF(skb); PG8_WAIT_L(0);
            skp = skb; PG8_BAR; PG8_MMA(1, 0, At, B0); PG8_MMA(1, 1, At, B1); PG8_BAR; PG8_SCHED;
        }
        if (wr == 0) PG8_BAR;
        if (FP8) asm volatile("s_nop 15\n\ts_nop 15" ::: "memory");
        if (!(WI & 4)) E(acc, cur, wr, wc, fr, fq, (LAS const unsigned char*)(recb + slot * 2048));
        if (PROBE_DBL == 81 && FP8 && K == 128) E(acc, cur, wr, wc, fr, fq, (LAS const unsigned char*)(recb + slot * 2048));
        if (PROBE_DBL == 71 && FP8 && K == 512) E(acc, cur, wr, wc, fr, fq, (LAS const unsigned char*)(recb + slot * 2048));
        if (!has_next) break;
#pragma unroll
        for (int a = 0; a < 2; ++a)
#pragma unroll
            for (int b = 0; b < 2; ++b)
#pragma unroll
                for (int m = 0; m < 4; ++m)
#pragma unroll
                    for (int n = 0; n < 2; ++n) acc[a][b][m][n] = (f32x4){0.f, 0.f, 0.f, 0.f};
        cur = nxt; cB = nB; vc00 = vn00; vc01 = vn01; vc10 = vn10; vc11 = vn11; ++ui; slot = nslot;
        if (wr == 1) PG8_BAR;
    }
    PG8_WAIT_V(0);
    PG8_BAR;
#undef PG8_SA
#undef PG8_RECISSUE
#undef PG8_AOFF
#undef PG8_SB
#undef PG8_STAGEA
#undef PG8_STAGEB
#undef PG8_LDA
#undef PG8_LDB
#undef PG8_MMA
#undef PG8_WAIT_V
#undef PG8_WAIT_VF
#undef PG8_WAIT_VG
#undef PG8_WAIT_L
#undef PG8_BAR
#undef PG8_SCHED
}
struct DenseOrder {
    static constexpr bool REC = false, BSTAT = false; static constexpr int SCALE_A = 0, SCALE_B = 0;
    int nM, nN, nwg, G, c; const char* Bt; int K;
    __device__ __forceinline__ const char* rec_ptr(const Unit&) const { return nullptr; }
    __device__ __forceinline__ bool has_rec(const Unit&) const { return false; }
    __device__ __forceinline__ bool row_valid(const Unit&, int) const { return true; }
    __device__ __forceinline__ int nvalid(const Unit&) const { return 256; }
    __device__ __forceinline__ unsigned a_off_idx(const Unit&, int, int) const { return 0u; }
    __device__ void init(int M, int N, int K_, const bf16_t* Bt_, int G_, int c_) { nM = M / BM; nN = N / BM; nwg = nM * nN; G = G_; c = c_; Bt = (const char*)Bt_; K = K_; }
    __device__ __forceinline__ bool next(int i, Unit& u) const {
        const long L = (long)i * G + c; if (L >= nwg) return false;
        int wgid = (int)L; { const int q = nwg / 8, r = nwg % 8, xcd = wgid % 8, off = wgid / 8; wgid = (xcd < r ? xcd * (q + 1) : r * (q + 1) + (xcd - r) * q) + off; }
        const int nig = 8 * nN, gid = wgid / nig, fm = gid * 8, gsz = (nM - fm) < 8 ? (nM - fm) : 8;
        u.pm = fm + ((wgid % nig) % gsz); u.pn = (wgid % nig) / gsz; u.e = 0; u.lt = 0; return true;
    }
    __device__ __forceinline__ const char* b_base(const Unit& u) const { return Bt + (size_t)u.pn * BM * K * 2; }
    __device__ __forceinline__ unsigned a_off(const Unit& u, int row) const { return (unsigned)(u.pm * BM + row) * (unsigned)(K * 2); }
};
__device__ __forceinline__ unsigned cvt_pk_bf16(float lo, float hi) { return pk2(lo, hi); }
struct EpiStoreBf16 { bf16_t* O; int ldc;
    __device__ __forceinline__ void operator()(const f32x4 (&acc)[2][2][4][2], const Unit& u, int wr, int wc, int fr, int fq, LAS const unsigned char*) const {
        const int row0 = u.pm * BM + wr * 64 + fr, col0 = u.pn * BM + wc * 32 + 8 * fq;
#pragma unroll
        for (int ai = 0; ai < 2; ++ai)
#pragma unroll
            for (int m = 0; m < 4; ++m) { bf16_t* rowp = O + (size_t)(row0 + ai * HALF + m * 16) * ldc + col0;
#pragma unroll
                for (int bj = 0; bj < 2; ++bj) { const f32x4 v0 = acc[ai][bj][m][0], v1 = acc[ai][bj][m][1];
                    u32x4 w; w.x = pk2(v0[0], v0[1]); w.y = pk2(v0[2], v0[3]); w.z = pk2(v1[0], v1[1]); w.w = pk2(v1[2], v1[3]);
                    *(u32x4*)(rowp + bj * HALF) = w; } }
    } };
}
constexpr int LDS_PG8 = 2048;
__device__ __forceinline__ void phase1(const Params& p) {
  const int tid_ = opaque_tid(); const int lane = tid_ & 63, gw = blockIdx.x * 8 + (tid_ >> 6), nw = gridDim.x * 8;
  const float* mod = (const float*)(p.ws + OFF_MOD);
  bf16_t* H1 = (bf16_t*)(p.ws + OFF_ACTA);
  float4 g[4];
#pragma unroll
  for (int i = 0; i < 4; ++i) g[i] = *(const float4*)(p.g_mix_pre + (lane + 64 * i) * 4);
  float4 vn[4];
  if (gw < T_TOK) {
#pragma unroll
    for (int i = 0; i < 4; ++i) vn[i] = ((const float4*)(p.x + (size_t)gw * 1024))[lane + 64 * i];
  }
#pragma unroll 1
  for (int row = gw; row < T_TOK; row += nw) {
    float4 v[4]; float ss = 0.f;
#pragma unroll
    for (int i = 0; i < 4; ++i) { v[i] = vn[i]; ss += v[i].x * v[i].x + v[i].y * v[i].y + v[i].z * v[i].z + v[i].w * v[i].w; }
    { const int rn = (row + nw < T_TOK) ? row + nw : row;
#pragma unroll
      for (int i = 0; i < 4; ++i) vn[i] = ((const float4*)(p.x + (size_t)rn * 1024))[lane + 64 * i]; }
    ss = wave_sum(ss);
    const float rs = rsqrtf(ss * (1.0f / 1024.f) + EPS);
    const int b = row >> 12;
    const float* sh = mod + b * 6144; const float* sc = sh + 1024;
#pragma unroll
    for (int i = 0; i < 4; ++i) {
      const int c = (lane + 64 * i) * 4;
      const float4 s1 = *(const float4*)(sc + c), h1 = *(const float4*)(sh + c);
      u32x2 w;
      w.x = pk2(v[i].x * rs * g[i].x * (1.f + s1.x) + h1.x, v[i].y * rs * g[i].y * (1.f + s1.y) + h1.y);
      w.y = pk2(v[i].z * rs * g[i].z * (1.f + s1.z) + h1.z, v[i].w * rs * g[i].w * (1.f + s1.w) + h1.w);
      *(u32x2*)(H1 + (size_t)row * 1024 + c) = w;
    }
  }
}

struct EpiProj { bf16_t* O; float* OL;
  __device__ __forceinline__ void operator()(const f32x4 (&acc)[2][2][4][2], const pg8::Unit& u, int wr, int wc, int fr, int fq, LAS const unsigned char*) const {
    const int row0 = u.pm * 256 + wr * 64 + fr;
    if (u.pn < 12) {
      const int col0 = u.pn * 256 + wc * 32 + 8 * fq;
#pragma unroll
      for (int ai = 0; ai < 2; ++ai)
#pragma unroll
        for (int m = 0; m < 4; ++m) { bf16_t* rowp = O + (size_t)(row0 + ai * 128 + m * 16) * PLD + col0;
#pragma unroll
          for (int bj = 0; bj < 2; ++bj) { const f32x4 v0 = acc[ai][bj][m][0], v1 = acc[ai][bj][m][1];
            u32x4 w; w.x = pk2(v0[0], v0[1]); w.y = pk2(v0[2], v0[3]); w.z = pk2(v1[0], v1[1]); w.w = pk2(v1[2], v1[3]);
            *(u32x4*)(rowp + bj * 128) = w; } }
    } else {
      const int col0 = wc * 32 + 8 * fq;
#pragma unroll
      for (int ai = 0; ai < 2; ++ai)
#pragma unroll
        for (int m = 0; m < 4; ++m) { float* rowp = OL + (size_t)(row0 + ai * 128 + m * 16) * 128 + col0;
          *(f32x4*)rowp = acc[ai][0][m][0]; *(f32x4*)(rowp + 4) = acc[ai][0][m][1]; }
    }
  } };
__device__ __forceinline__ void phase2(const Params& p) {
  pg8::DenseOrder S; S.init(T_TOK, NPROJ, 1024, (const bf16_t*)(p.ws + OFF_WIN), gridDim.x, blockIdx.x);
  EpiProj E{(bf16_t*)(p.ws + OFF_PROJ), (float*)(p.ws + OFF_PROJL)};
  pg8::gemm_phase(SMEM + LDS_PG8, (const bf16_t*)(p.ws + OFF_ACTA), 1024, S, E);
}

__device__ __forceinline__ void unpack8(const u32x4 v, float (&o)[8]) { o[0] = bflo(v.x); o[1] = bfhi(v.x); o[2] = bflo(v.y); o[3] = bfhi(v.y); o[4] = bflo(v.z); o[5] = bfhi(v.z); o[6] = bflo(v.w); o[7] = bfhi(v.w); }
__device__ __forceinline__ u32x4 packf8(const float (&o)[8]) { u32x4 w; w.x = pk2(o[0], o[1]); w.y = pk2(o[2], o[3]); w.z = pk2(o[4], o[5]); w.w = pk2(o[6], o[7]); return w; }
__device__ __forceinline__ void rope8(float (&own)[8], const float (&oth)[8], bool first, const float* cs) {
#pragma unroll
  for (int i = 0; i < 8; ++i) { const float c = cs[2 * i], s = cs[2 * i + 1]; own[i] = first ? (own[i] * c - oth[i] * s) : (own[i] * c + oth[i] * s); }
}
__device__ __forceinline__ void phase2b(const Params& p) {
  const bf16_t* PROJ = (const bf16_t*)(p.ws + OFF_PROJ); const float* PL = (const float*)(p.ws + OFF_PROJL);
  bf16_t* dst = (bf16_t*)(p.ws + OFF_MQKC); bf16_t* AKR = (bf16_t*)(p.ws + OFF_AK); bf16_t* IK = (bf16_t*)(p.ws + OFF_IK);
  const float* R128 = (const float*)(p.ws + OFF_ROPE); const float* R64 = R128 + 4096 * 32;
  const unsigned gtid = blockIdx.x * NTHR + opaque_tid(), gstride = gridDim.x * NTHR;
  for (unsigned id = gtid; id < (unsigned)(T_TOK / 8) * 128u; id += gstride) {
    const size_t tok0 = (size_t)(id >> 7) * 8; const int c0 = (int)(id & 127u) * 8; const int pos0 = (int)(tok0 & 4095);
    u32x4 raw[11];
#pragma unroll
    for (int r = 0; r < 11; ++r) raw[r] = (pos0 + r - 3 >= 0) ? *(const u32x4*)(PROJ + (tok0 + r - 3) * PLD + c0) : (u32x4){0u, 0u, 0u, 0u};
    float w[4][8], bias[8];
#pragma unroll
    for (int j = 0; j < 4; ++j) { const float4 w0 = *(const float4*)(p.conv_w + j * 1024 + c0), w1 = *(const float4*)(p.conv_w + j * 1024 + c0 + 4);
      w[j][0] = w0.x; w[j][1] = w0.y; w[j][2] = w0.z; w[j][3] = w0.w; w[j][4] = w1.x; w[j][5] = w1.y; w[j][6] = w1.z; w[j][7] = w1.w; }
    { const float4 b0 = *(const float4*)(p.conv_b + c0), b1 = *(const float4*)(p.conv_b + c0 + 4);
      bias[0] = b0.x; bias[1] = b0.y; bias[2] = b0.z; bias[3] = b0.w; bias[4] = b1.x; bias[5] = b1.y; bias[6] = b1.z; bias[7] = b1.w; }
    const float sc = (c0 >= 512) ? 0.08838834764831845f : 1.0f;
#pragma unroll
    for (int t = 0; t < 8; ++t) {
      float acc[8];
#pragma unroll
      for (int i = 0; i < 8; ++i) acc[i] = bias[i];
#pragma unroll
      for (int j = 0; j < 4; ++j) { float v[8]; unpack8(raw[t + j], v);
#pragma unroll
        for (int i = 0; i < 8; ++i) acc[i] += v[i] * w[j][i]; }
#pragma unroll
      for (int i = 0; i < 8; ++i) acc[i] = acc[i] * __builtin_amdgcn_rcpf(1.0f + __expf(-acc[i])) * sc;
      *(u32x4*)(dst + (tok0 + t) * 1024 + c0) = packf8(acc);
    }
  }
  for (unsigned id = gtid; id < (unsigned)T_TOK * 16u; id += gstride) {
    const size_t tok = id >> 4; const int c0 = (int)(id & 15u) * 8; const int pos = (int)(tok & 4095);
    float own[8]; unpack8(*(const u32x4*)(PROJ + tok * PLD + 2560 + c0), own);
    if (c0 < 32) { float oth[8]; unpack8(*(const u32x4*)(PROJ + tok * PLD + 2560 + (c0 ^ 16)), oth); rope8(own, oth, c0 < 16, R128 + (size_t)pos * 32 + (c0 & 15) * 2); }
    *(u32x4*)(AKR + tok * 128 + c0) = packf8(own);
  }
  {
    const int tid_ = opaque_tid(); const int lane = tid_ & 63, gwv = blockIdx.x * 8 + (tid_ >> 6), nwv = gridDim.x * 8;
    const float gk = p.g_idx_k[lane], bk = p.b_idx_k[lane];
    for (int tok = gwv; tok < T_TOK; tok += nwv) {
      const int pos = tok & 4095;
      const float* tr = PL + (size_t)tok * 128;
      const float v = tr[lane];
      const float mu = wave_sum(v) * (1.f / 64.f);
      const float d = v - mu;
      const float var = wave_sum(d * d) * (1.f / 64.f);
      float y = d * rsqrtf(var + EPS) * gk + bk;
      const float yo = __shfl_xor(y, 8);
      if (lane < 16) { const float cs = R64[(size_t)pos * 16 + (lane & 7) * 2], sn = R64[(size_t)pos * 16 + (lane & 7) * 2 + 1]; y = (lane < 8) ? (y * cs - yo * sn) : (y * cs + yo * sn); }
      const float yn = __shfl_down(y, 1);
      if ((lane & 1) == 0) *(unsigned*)(IK + (size_t)tok * 64 + lane) = pk2(y, yn);
      if (lane < 8) ((float*)(p.ws + OFF_GATES))[(size_t)tok * 8 + lane] = tr[64 + lane] + ((lane < 4) ? p.b_igate[lane] : p.b_fgate[lane - 4]);
      else if (lane < 12) ((float*)(p.ws + OFF_IW))[(size_t)tok * 4 + (lane - 8)] = tr[72 + (lane - 8)] * 0.0625f;
    }
  }
  {
    const int tid_ = opaque_tid(); const int lane = tid_ & 63, gwv = blockIdx.x * 8 + (tid_ >> 6), nwv = gridDim.x * 8;
    float* GLb = (float*)(p.ws + OFF_GL); float* GLa = GLb + 64 * 4096; float* GLm = GLa + 64 * 4096; float* SEG = GLm + 64 * 4096;
    for (int item = gwv; item < 512; item += nwv) {
      const int bh = item >> 3, seg = item & 7, b = bh >> 2, h = bh & 3;
      const float bi = p.b_igate[h], bfg = p.b_fgate[h];
      float bl = 0.f, ml = -1e30f;
      for (int c = 0; c < 8; ++c) {
        const int ts = seg * 512 + c * 64 + lane; const size_t tok = (size_t)b * 4096 + ts;
        const float ig = PL[tok * 128 + 64 + h] + bi, fg = PL[tok * 128 + 68 + h] + bfg;
        const float lf = fminf(fg, 0.f) - log1pf(expf(-fabsf(fg)));
        float cs = lf;
#pragma unroll
        for (int off = 1; off < 64; off <<= 1) { const float t = __shfl_up(cs, off); if (lane >= off) cs += t; }
        const float bloc = bl + cs, aloc = ig - bloc;
        float mx = aloc;
#pragma unroll
        for (int off = 1; off < 64; off <<= 1) { const float t = __shfl_up(mx, off); if (lane >= off) mx = fmaxf(mx, t); }
        const float mloc = fmaxf(ml, mx);
        GLb[bh * 4096 + ts] = bloc; GLa[bh * 4096 + ts] = aloc; GLm[bh * 4096 + ts] = mloc;
        bl = __shfl(bloc, 63); ml = __shfl(mloc, 63);
      }
      if (lane == 0) { SEG[(bh * 8 + seg) * 2] = bl; SEG[(bh * 8 + seg) * 2 + 1] = ml; }
    }
  }
}
namespace ml {
constexpr int QS = 0, KS = 17408, VS = 34816, VWS = 54272, PS = 73728, CB = 82944, SEGT = 122112, GA = 122624;
constexpr int QLD = 136, VLD = 152, TLD = 72;
}
__device__ __forceinline__ bf16x8 ml_tr(LAS const bf16_t* p0, int rowstride) {
  const v4i16_t a = __builtin_amdgcn_ds_read_tr16_b64_v4i16((LAS v4i16_t*)p0), b = __builtin_amdgcn_ds_read_tr16_b64_v4i16((LAS v4i16_t*)(p0 + 4 * rowstride));
  bf16x8 r; r[0] = a[0]; r[1] = a[1]; r[2] = a[2]; r[3] = a[3]; r[4] = b[0]; r[5] = b[1]; r[6] = b[2]; r[7] = b[3]; return r;
}
__device__ __forceinline__ void mlstm_item(const Params& p, int id) {
  using namespace ml;
  const int tid = opaque_tid(), lane = tid & 63, w = tid >> 6, fr = lane & 15, fq = lane >> 4;
  const int b = id >> 2, h = id & 3;
  const size_t tok0 = (size_t)b * 4096;
  LAS unsigned char* L = SMEM + LDS_MAIN;
  LAS bf16_t* Qs = (LAS bf16_t*)(L + QS); LAS bf16_t* Ks = (LAS bf16_t*)(L + KS); LAS bf16_t* Vs = (LAS bf16_t*)(L + VS); LAS bf16_t* VWs = (LAS bf16_t*)(L + VWS);
  LAS bf16_t* Ps = (LAS bf16_t*)(L + PS); LAS bf16_t* Cb = (LAS bf16_t*)(L + CB);
  LAS float* segt = (LAS float*)(L + SEGT); LAS float* gab = (LAS float*)(L + GA);
  const float* GLb = (const float*)(p.ws + OFF_GL) + (size_t)(b * 4 + h) * 4096; const float* GLa = GLb + 64 * 4096; const float* GLm = GLa + 64 * 4096; const float* SEG = (const float*)(p.ws + OFF_GL) + 3 * 64 * 4096 + (b * 4 + h) * 16;
  const bf16_t* MQKC = (const bf16_t*)(p.ws + OFF_MQKC); const bf16_t* MV = (const bf16_t*)(p.ws + OFF_PROJ) + 1024 + h * 128; const bf16_t* MO = (const bf16_t*)(p.ws + OFF_PROJ) + 1536 + h * 128;
  bf16_t* A2 = (bf16_t*)(p.ws + OFF_ACTA) + h * 128;

  f32x4 Cacc[2][9];
#pragma unroll
  for (int i = 0; i < 2; ++i)
#pragma unroll
    for (int j = 0; j < 9; ++j) Cacc[i][j] = (f32x4){0.f, 0.f, 0.f, 0.f};
  for (int i = tid; i < 144 * QLD; i += NTHR) Cb[i] = 0;
  for (int i = tid; i < 64 * VLD; i += NTHR) { const int col = i % VLD; Vs[i] = (col == 128) ? (bf16_t)0x3F80 : (bf16_t)0; VWs[i] = 0; }
  if (tid == 0) { float bo = 0.f, mp = -1e30f; for (int k = 0; k < 8; ++k) { segt[2 * k] = bo; segt[2 * k + 1] = mp; mp = fmaxf(mp, SEG[2 * k + 1] - bo); bo += SEG[2 * k]; } }
  u32x4 q0, q1, k0, k1, v0, v1; float ga0 = 0.f, ga1 = 0.f, gb = 0.f, gm = 0.f, gme = 0.f, gmp = 0.f;
  const int srow = tid >> 4, scc = tid & 15;
  const int gs = tid & 63;
  auto gload = [&](int c) {
    const size_t t0 = tok0 + (size_t)c * 64;
    q0 = *(const u32x4*)(MQKC + (t0 + srow) * 1024 + h * 128 + scc * 8); q1 = *(const u32x4*)(MQKC + (t0 + srow + 32) * 1024 + h * 128 + scc * 8);
    k0 = *(const u32x4*)(MQKC + (t0 + srow) * 1024 + 512 + h * 128 + scc * 8); k1 = *(const u32x4*)(MQKC + (t0 + srow + 32) * 1024 + 512 + h * 128 + scc * 8);
    v0 = *(const u32x4*)(MV + (t0 + srow) * PLD + scc * 8); v1 = *(const u32x4*)(MV + (t0 + srow + 32) * PLD + scc * 8);
    ga0 = GLa[c * 64 + srow]; ga1 = GLa[c * 64 + srow + 32];
    const int ts = c * 64 + gs; gb = GLb[ts]; gm = GLm[ts]; gme = GLm[c * 64 + 63]; gmp = GLm[(c > 0) ? (c * 64 - 1) : 0];
  };
  auto sstore = [&](int cs) {
    *(LAS u32x4*)(Qs + srow * QLD + scc * 8) = q0; *(LAS u32x4*)(Qs + (srow + 32) * QLD + scc * 8) = q1;
    *(LAS u32x4*)(Ks + srow * QLD + scc * 8) = k0; *(LAS u32x4*)(Ks + (srow + 32) * QLD + scc * 8) = k1;
    *(LAS u32x4*)(Vs + srow * VLD + scc * 8) = v0; *(LAS u32x4*)(Vs + (srow + 32) * VLD + scc * 8) = v1;
    const float bo = segt[2 * (cs >> 3)], mpv = segt[2 * (cs >> 3) + 1];
    const float Mend = fmaxf(mpv, gme - bo);
    const float w0 = __expf(ga0 - bo - Mend), w1 = __expf(ga1 - bo - Mend);
    { float f[8]; unpack8(v0, f);
#pragma unroll
      for (int i = 0; i < 8; ++i) f[i] *= w0;
      *(LAS u32x4*)(VWs + srow * VLD + scc * 8) = packf8(f);
      unpack8(v1, f);
#pragma unroll
      for (int i = 0; i < 8; ++i) f[i] *= w1;
      *(LAS u32x4*)(VWs + (srow + 32) * VLD + scc * 8) = packf8(f); }
    if (scc == 0) { VWs[srow * VLD + 128] = (bf16_t)f2bf(w0); VWs[(srow + 32) * VLD + 128] = (bf16_t)f2bf(w1); }
    if (tid < 64) {
      LAS float* ga = gab + (cs & 1) * 336;
      const float gav = (gs < 32) ? ga0 : ga1;
      (void)gav;
      const float a = GLa[cs * 64 + gs] - bo, Bs = bo + gb, Mt = fmaxf(mpv, gm - bo);
      float Mp = -1e30f;
      if (cs > 0) { const int sp = (cs * 64 - 1) >> 9; Mp = fmaxf(segt[2 * sp + 1], gmp - segt[2 * sp]); }
      ga[gs] = a; ga[64 + gs] = Mt; ga[128 + gs] = __expf(Mp - Mt); ga[192 + gs] = __expf(-(Bs + Mt));
      if (gs == 0) ga[320] = __expf(Mp - Mend);
    }
  };
  __syncthreads();
  gload(0); sstore(0);
  __syncthreads();
  const int tt = w >> 1, st0 = (w & 1) * 2;
  const int trq = fr >> 2, trp = fr & 3;
#pragma unroll 1
  for (int c = 0; c < 64; ++c) {
    if (c < 63) gload(c + 1);
    LAS const float* ga = gab + (c & 1) * 336;
    {
      f32x4 S[2];
#pragma unroll
      for (int i = 0; i < 2; ++i) S[i] = (f32x4){0.f, 0.f, 0.f, 0.f};
#pragma unroll
      for (int kk = 0; kk < 4; ++kk) {
        const bf16x8 bq = *(LAS bf16x8*)(Qs + (tt * 16 + fr) * QLD + kk * 32 + fq * 8);
#pragma unroll
        for (int i = 0; i < 2; ++i) if (st0 + i <= tt) {
          const bf16x8 ak = *(LAS bf16x8*)(Ks + ((st0 + i) * 16 + fr) * QLD + kk * 32 + fq * 8);
          S[i] = __builtin_amdgcn_mfma_f32_16x16x32_bf16(ak, bq, S[i], 0, 0, 0);
        }
      }
      const int t = tt * 16 + fr; const float Mt = ga[64 + t];
#pragma unroll
      for (int i = 0; i < 2; ++i) {
        const int s0 = (st0 + i) * 16 + fq * 4;
        const f32x4 as = *(LAS const f32x4*)(ga + s0);
        float pv[4];
#pragma unroll
        for (int j = 0; j < 4; ++j) pv[j] = (s0 + j <= t) ? S[i][j] * __expf(as[j] - Mt) : 0.f;
        u32x2 pw; pw.x = pk2(pv[0], pv[1]); pw.y = pk2(pv[2], pv[3]);
        *(LAS u32x2*)(Ps + t * TLD + s0) = pw;
      }
    }
    __syncthreads();
    if (w < 4) {
      f32x4 N1[9];
#pragma unroll
      for (int j = 0; j < 9; ++j) N1[j] = (f32x4){0.f, 0.f, 0.f, 0.f};
#pragma unroll
      for (int kk = 0; kk < 4; ++kk) {
        const bf16x8 bq = *(LAS bf16x8*)(Qs + (w * 16 + fr) * QLD + kk * 32 + fq * 8);
#pragma unroll
        for (int j = 0; j < 9; ++j) { const bf16x8 ac = *(LAS bf16x8*)(Cb + (j * 16 + fr) * QLD + kk * 32 + fq * 8); N1[j] = __builtin_amdgcn_mfma_f32_16x16x32_bf16(ac, bq, N1[j], 0, 0, 0); }
      }
      const int t = w * 16 + fr; const float inter = ga[128 + t], low = ga[192 + t];
#pragma unroll
      for (int j = 0; j < 9; ++j) N1[j] = N1[j] * inter;
#pragma unroll
      for (int kk = 0; kk < 2; ++kk) {
        const bf16x8 bp = *(LAS bf16x8*)(Ps + (w * 16 + fr) * TLD + kk * 32 + fq * 8);
        LAS const bf16_t* vb = Vs + (kk * 32 + fq * 8 + trq) * VLD + trp * 4;
#pragma unroll
        for (int j = 0; j < 9; ++j) { const bf16x8 av = ml_tr(vb + j * 16, VLD); N1[j] = __builtin_amdgcn_mfma_f32_16x16x32_bf16(av, bp, N1[j], 0, 0, 0); }
      }
      const float dsrc = N1[8][0];
      const float dn = fmaxf(fabsf(__shfl(dsrc, fr)), low);
      const float inv = __builtin_amdgcn_rcpf(dn);
      float ss = 0.f;
#pragma unroll
      for (int j = 0; j < 8; ++j)
#pragma unroll
        for (int r = 0; r < 4; ++r) { const float hv = N1[j][r] * inv; N1[j][r] = hv; ss += hv * hv; }
      ss += __shfl_xor(ss, 16); ss += __shfl_xor(ss, 32);
      const float rs = rsqrtf(ss * (1.f / 128.f) + EPS);
      bf16_t* op = A2 + (tok0 + (size_t)c * 64 + t) * 1024 + fq * 4;
#pragma unroll
      for (int j = 0; j < 8; ++j) {
        const float4 gh = *(const float4*)(p.g_mlstm_head + h * 128 + j * 16 + fq * 4);
        const u32x2 mo = *(const u32x2*)(MO + (tok0 + (size_t)c * 64 + t) * PLD + j * 16 + fq * 4);
        const float o0 = N1[j][0] * rs * gh.x * sigmoidf_(bflo(mo.x)), o1 = N1[j][1] * rs * gh.y * sigmoidf_(bfhi(mo.x));
        const float o2 = N1[j][2] * rs * gh.z * sigmoidf_(bflo(mo.y)), o3 = N1[j][3] * rs * gh.w * sigmoidf_(bfhi(mo.y));
        u32x2 hw; hw.x = pk2(o0, o1); hw.y = pk2(o2, o3);
        *(u32x2*)(op + j * 16) = hw;
      }
    } else {
      const float dcy = ga[320];
#pragma unroll
      for (int i = 0; i < 2; ++i)
#pragma unroll
        for (int j = 0; j < 9; ++j) Cacc[i][j] = Cacc[i][j] * dcy;
#pragma unroll
      for (int kk = 0; kk < 2; ++kk) {
        LAS const bf16_t* kb0 = Ks + (kk * 32 + fq * 8 + trq) * QLD + trp * 4;
        LAS const bf16_t* vwb = VWs + (kk * 32 + fq * 8 + trq) * VLD + trp * 4;
        bf16x8 akt[2];
#pragma unroll
        for (int i = 0; i < 2; ++i) akt[i] = ml_tr(kb0 + ((w - 4) * 2 + i) * 16, QLD);
#pragma unroll
        for (int j = 0; j < 9; ++j) {
          const bf16x8 bv = ml_tr(vwb + j * 16, VLD);
#pragma unroll
          for (int i = 0; i < 2; ++i) Cacc[i][j] = __builtin_amdgcn_mfma_f32_16x16x32_bf16(akt[i], bv, Cacc[i][j], 0, 0, 0);
        }
      }
    }
    __syncthreads();
    if (w >= 4) {
#pragma unroll
      for (int i = 0; i < 2; ++i)
#pragma unroll
        for (int j = 0; j < 9; ++j) { u32x2 cw; cw.x = pk2(Cacc[i][j][0], Cacc[i][j][1]); cw.y = pk2(Cacc[i][j][2], Cacc[i][j][3]);
          *(LAS u32x2*)(Cb + (j * 16 + fr) * QLD + ((w - 4) * 2 + i) * 16 + fq * 4) = cw; }
    }
    if (c < 63) sstore(c + 1);
    __syncthreads();
  }
}
namespace ds {
constexpr int KEYS = 0, HIST = 131072;
constexpr int KT = 0, VT = 34816, PW = 71680, MSK = 108544;
constexpr int KLD = 136, VLD = 72;
}
__device__ __forceinline__ unsigned score_key16(float s4096) {
  const float t = __builtin_amdgcn_fmed3f(s4096, -32767.0f, 32767.0f);
  return (unsigned)(32768 + (int)floorf(t));
}
__device__ __forceinline__ void hist_find(LAS const unsigned* hist, int lane, unsigned target, unsigned& bin, unsigned& above) {
  const u32x4 h4 = *(LAS const u32x4*)(hist + 4 * lane);
  const unsigned lsum = h4.x + h4.y + h4.z + h4.w;
  unsigned suf = lsum;
#pragma unroll
  for (int off = 1; off < 64; off <<= 1) { const unsigned t = __shfl_down(suf, off); if (lane + off < 64) suf += t; }
  unsigned cum = suf - lsum; bool found = false; unsigned fb = 0, fa = 0;
  { const unsigned hv = h4.w; if (!found && cum < target && cum + hv >= target) { found = true; fb = 4 * lane + 3; fa = cum; } cum += hv; }
  { const unsigned hv = h4.z; if (!found && cum < target && cum + hv >= target) { found = true; fb = 4 * lane + 2; fa = cum; } cum += hv; }
  { const unsigned hv = h4.y; if (!found && cum < target && cum + hv >= target) { found = true; fb = 4 * lane + 1; fa = cum; } cum += hv; }
  { const unsigned hv = h4.x; if (!found && cum < target && cum + hv >= target) { found = true; fb = 4 * lane + 0; fa = cum; } cum += hv; }
  const unsigned long long m = __ballot(found);
  const int src = m ? (__ffsll((long long)m) - 1) : 0;
  bin = __shfl(fb, src); above = __shfl(fa, src);
}
typedef long long i64; typedef long long i64x2 __attribute__((ext_vector_type(2)));
__device__ __forceinline__ bf16x8 tr_pair(LAS const bf16_t* p0, LAS const bf16_t* p1) {
  const v4i16_t a = __builtin_amdgcn_ds_read_tr16_b64_v4i16((LAS v4i16_t*)p0), b = __builtin_amdgcn_ds_read_tr16_b64_v4i16((LAS v4i16_t*)p1);
  bf16x8 r; r[0] = a[0]; r[1] = a[1]; r[2] = a[2]; r[3] = a[3]; r[4] = b[0]; r[5] = b[1]; r[6] = b[2]; r[7] = b[3]; return r;
}
__device__ __forceinline__ void dsa_item(const Params& p, int b, int qc) {
  using namespace ds;
  const int tid = opaque_tid(), lane = tid & 63, w = tid >> 6, fr = lane & 15, fq = lane >> 4;
  LAS unsigned char* L = SMEM + LDS_MAIN;
  const size_t kb = (size_t)b * 4096;
  const size_t q0 = kb + (size_t)qc * 64;
  const int n = (qc + 1) * 64, ntile = qc + 1;
  unsigned long long* BITM = (unsigned long long*)(p.ws + OFF_BITM);
  unsigned char* BITB = (unsigned char*)(p.ws + OFF_BITM);
  const bf16_t* IQ = (const bf16_t*)(p.ws + OFF_PROJ) + 2816; const float* R128 = (const float*)(p.ws + OFF_ROPE); const float* R64 = R128 + 4096 * 32;
  const bf16_t* IK = (const bf16_t*)(p.ws + OFF_IK); const float* IW = (const float*)(p.ws + OFF_IW);
  for (int rep_s = 0; rep_s < ((PROBE_DBL == 33) ? 2 : 1); ++rep_s)
  if (n <= 256) {
    for (int i = tid; i < 64 * ntile; i += NTHR) { const int q = i / ntile, kt = i - q * ntile; BITM[(q0 + q) * 64 + kt] = ~0ull; }
  } else {
    LAS unsigned short* keys = (LAS unsigned short*)(L + KEYS);
    LAS unsigned* hist = (LAS unsigned*)(L + HIST) + w * 256;
    const int nk16 = n >> 4, nblk = (n + 511) >> 9;
#pragma unroll 1
    for (int g = 0; g < 4; ++g) {
      const size_t qg = q0 + g * 16;
      bf16x8 af[4][2]; f32x4 iw[4];
#pragma unroll
      for (int hh = 0; hh < 4; ++hh)
#pragma unroll
        for (int ks = 0; ks < 2; ++ks) {
          const bf16_t* src = IQ + (qg + fr) * PLD + hh * 64 + ks * 32 + fq * 8;
          u32x4 raw = *(const u32x4*)src;
          if (ks == 0 && fq < 2) { float own[8], oth[8]; unpack8(raw, own); unpack8(*(const u32x4*)(IQ + (qg + fr) * PLD + hh * 64 + (fq ^ 1) * 8), oth);
            rope8(own, oth, fq == 0, R64 + (size_t)((qg + fr) & 4095) * 16); raw = packf8(own); }
          af[hh][ks] = __builtin_bit_cast(bf16x8, raw);
        }
#pragma unroll
      for (int j = 0; j < 4; ++j) iw[j] = *(const f32x4*)(IW + (qg + fq * 4 + j) * 4) * 4096.0f;
      for (int rep_a = 0; rep_a < ((PROBE_DBL == 35) ? 2 : 1); ++rep_a)
      {
        const int nbat = n >> 6;
        bf16x8 bc[4][2], bn[4][2];
        {
          const int bt = (w < nbat) ? w : 0;
#pragma unroll
          for (int u = 0; u < 4; ++u) { const bf16_t* kp = IK + (kb + (size_t)(bt * 4 + u) * 16 + fr) * 64 + fq * 8; bc[u][0] = *(const bf16x8*)kp; bc[u][1] = *(const bf16x8*)(kp + 32); }
        }
        for (int bt = w; bt < nbat; bt += 8) {
          const int btn = (bt + 8 < nbat) ? bt + 8 : bt;
#pragma unroll
          for (int u = 0; u < 4; ++u) { const bf16_t* kp = IK + (kb + (size_t)(btn * 4 + u) * 16 + fr) * 64 + fq * 8; bn[u][0] = *(const bf16x8*)kp; bn[u][1] = *(const bf16x8*)(kp + 32); }
#pragma unroll
          for (int u = 0; u < 4; ++u) {
            float sc[4] = {0.f, 0.f, 0.f, 0.f};
#pragma unroll
            for (int hh = 0; hh < 4; ++hh) {
              f32x4 a = (f32x4){0.f, 0.f, 0.f, 0.f};
              a = __builtin_amdgcn_mfma_f32_16x16x32_bf16(af[hh][0], bc[u][0], a, 0, 0, 0);
              a = __builtin_amdgcn_mfma_f32_16x16x32_bf16(af[hh][1], bc[u][1], a, 0, 0, 0);
#pragma unroll
              for (int j = 0; j < 4; ++j) sc[j] += iw[j][hh] * fmaxf(a[j], 0.f);
            }
#pragma unroll
            for (int j = 0; j < 4; ++j) keys[(fq * 4 + j) * 4096 + (bt * 4 + u) * 16 + fr] = (unsigned short)score_key16(sc[j]);
          }
#pragma unroll
          for (int u = 0; u < 4; ++u) { bc[u][0] = bn[u][0]; bc[u][1] = bn[u][1]; }
        }
      }
      __syncthreads();
#pragma unroll 1
      for (int qq = 0; qq < ((PROBE_DBL == 36) ? 4 : 2); ++qq) {
        const int ql = w * 2 + (qq & 1);
        LAS const unsigned short* kq = keys + ql * 4096;
        *(LAS u32x4*)(hist + 4 * lane) = (u32x4){0u, 0u, 0u, 0u};
        for (int blk = 0; blk < nblk; ++blk) {
          const int k0i = blk * 512 + lane * 8;
          if (k0i < n) {
            const u32x4 kv = *(LAS const u32x4*)(kq + k0i);
            __hip_atomic_fetch_add(hist + ((kv.x >> 8) & 255u), 1u, __ATOMIC_RELAXED, __HIP_MEMORY_SCOPE_WORKGROUP); __hip_atomic_fetch_add(hist + (kv.x >> 24), 1u, __ATOMIC_RELAXED, __HIP_MEMORY_SCOPE_WORKGROUP);
            __hip_atomic_fetch_add(hist + ((kv.y >> 8) & 255u), 1u, __ATOMIC_RELAXED, __HIP_MEMORY_SCOPE_WORKGROUP); __hip_atomic_fetch_add(hist + (kv.y >> 24), 1u, __ATOMIC_RELAXED, __HIP_MEMORY_SCOPE_WORKGROUP);
            __hip_atomic_fetch_add(hist + ((kv.z >> 8) & 255u), 1u, __ATOMIC_RELAXED, __HIP_MEMORY_SCOPE_WORKGROUP); __hip_atomic_fetch_add(hist + (kv.z >> 24), 1u, __ATOMIC_RELAXED, __HIP_MEMORY_SCOPE_WORKGROUP);
            __hip_atomic_fetch_add(hist + ((kv.w >> 8) & 255u), 1u, __ATOMIC_RELAXED, __HIP_MEMORY_SCOPE_WORKGROUP); __hip_atomic_fetch_add(hist + (kv.w >> 24), 1u, __ATOMIC_RELAXED, __HIP_MEMORY_SCOPE_WORKGROUP);
          }
        }
        asm volatile("s_waitcnt lgkmcnt(0)" ::: "memory");
        unsigned bin1, above1; hist_find(hist, lane, 256u, bin1, above1);
        *(LAS u32x4*)(hist + 4 * lane) = (u32x4){0u, 0u, 0u, 0u};
        for (int blk = 0; blk < nblk; ++blk) {
          const int k0i = blk * 512 + lane * 8;
          if (k0i < n) {
            const u32x4 kv = *(LAS const u32x4*)(kq + k0i);
#define DS_P2(word) { const unsigned ka = (word) & 0xffffu, kb2 = (word) >> 16; \
              if ((ka >> 8) == bin1) __hip_atomic_fetch_add(hist + (ka & 255u), 1u, __ATOMIC_RELAXED, __HIP_MEMORY_SCOPE_WORKGROUP); \
              if ((kb2 >> 8) == bin1) __hip_atomic_fetch_add(hist + (kb2 & 255u), 1u, __ATOMIC_RELAXED, __HIP_MEMORY_SCOPE_WORKGROUP); }
            DS_P2(kv.x) DS_P2(kv.y) DS_P2(kv.z) DS_P2(kv.w)
#undef DS_P2
          }
        }
        asm volatile("s_waitcnt lgkmcnt(0)" ::: "memory");
        unsigned bin2, above2; hist_find(hist, lane, 256u - above1, bin2, above2);
        const unsigned tau = (bin1 << 8) | bin2, rties = 256u - above1 - above2;
        unsigned tbase = 0;
        for (int blk = 0; blk < nblk; ++blk) {
          const int k0i = blk * 512 + lane * 8;
          u32x4 kv = (u32x4){0u, 0u, 0u, 0u};
          if (k0i < n) kv = *(LAS const u32x4*)(kq + k0i);
          unsigned kk[8] = {kv.x & 0xffffu, kv.x >> 16, kv.y & 0xffffu, kv.y >> 16, kv.z & 0xffffu, kv.z >> 16, kv.w & 0xffffu, kv.w >> 16};
          unsigned ne = 0;
#pragma unroll
          for (int e = 0; e < 8; ++e) ne += (kk[e] == tau) ? 1u : 0u;
          if (k0i >= n) ne = 0;
          unsigned mbyte = 0;
          if (__ballot(ne != 0u) == 0ull) {
#pragma unroll
            for (int e = 0; e < 8; ++e) mbyte |= (kk[e] > tau) ? (1u << e) : 0u;
          } else {
            unsigned inc = ne;
#pragma unroll
            for (int off = 1; off < 64; off <<= 1) { const unsigned t = __shfl_up(inc, off); if (lane >= off) inc += t; }
            unsigned rank = tbase + inc - ne;
#pragma unroll
            for (int e = 0; e < 8; ++e) { const bool eq = kk[e] == tau; const bool sel = (kk[e] > tau) || (eq && rank < rties); mbyte |= sel ? (1u << e) : 0u; rank += eq ? 1u : 0u; }
            tbase += __shfl(inc, 63);
          }
          if (k0i < n) BITB[(qg + ql) * 512 + blk * 64 + lane] = (unsigned char)mbyte;
        }
      }
      __syncthreads();
    }
  }
  asm volatile("s_waitcnt vmcnt(0)" ::: "memory");
  __threadfence_block();
  __syncthreads();
  const bf16_t* AQ = (const bf16_t*)(p.ws + OFF_PROJ) + 2048; const bf16_t* AK = (const bf16_t*)(p.ws + OFF_AK); const bf16_t* AV = (const bf16_t*)(p.ws + OFF_PROJ) + 2688;
  bf16_t* A2 = (bf16_t*)(p.ws + OFF_ACTA);
  const float qscale = 0.08838834764831845f * 1.4426950408889634f;
  constexpr int RS = 36864;
  const int wv = __builtin_amdgcn_readfirstlane(w);
  const int prow0 = wv * 4 + (lane >> 4), prow1 = 32 + prow0;
  const int pch0 = (lane & 15) ^ (prow0 & 15), pch1 = (lane & 15) ^ (prow1 & 15);
  const unsigned koff0 = (unsigned)(prow0 * 128 + pch0 * 8) * 2u, koff1 = (unsigned)(prow1 * 128 + pch1 * 8) * 2u;
  const unsigned voff0 = (unsigned)(prow0 * PLD + pch0 * 8) * 2u, voff1 = (unsigned)(prow1 * PLD + pch1 * 8) * 2u;
  const unsigned moff = (unsigned)(((tid & 127) >> 1) * 512 + (tid & 1) * 4);
#define DS_GLDS(gp, ldsoff, sz) __builtin_amdgcn_global_load_lds((const unsigned*)(gp), (LAS unsigned*)(L + (ldsoff)), sz, 0, 0)
#define DS_ISSUE(kt_, stg_) do { const size_t t0_ = kb + (size_t)(kt_) * 64; const int so_ = (stg_) * RS; \
    DS_GLDS((const char*)(AK + t0_ * 128) + koff0, so_ + wv * 1024, 16); DS_GLDS((const char*)(AK + t0_ * 128) + koff1, so_ + 8192 + wv * 1024, 16); \
    DS_GLDS((const char*)(AV + t0_ * PLD) + voff0, so_ + 16384 + wv * 1024, 16); DS_GLDS((const char*)(AV + t0_ * PLD) + voff1, so_ + 16384 + 8192 + wv * 1024, 16); \
    DS_GLDS((const char*)(BITM + q0 * 64 + (kt_)) + moff, so_ + 32768 + wv * 256, 4); } while (0)
#pragma unroll 1
  for (int hp = 0; hp < ((PROBE_DBL == 34) ? 2 : 1); ++hp) {
    const int hd0 = (w >> 2) * 2, qh = (w & 3) * 16;
    bf16x8 qf[2][4];
#pragma unroll
    for (int hx = 0; hx < 2; ++hx)
#pragma unroll
      for (int kk = 0; kk < 4; ++kk) {
        const bf16_t* src = AQ + (q0 + qh + fr) * PLD + (hd0 + hx) * 128 + kk * 32 + fq * 8;
        float own[8]; unpack8(*(const u32x4*)src, own);
        if (kk == 0) { float oth[8]; unpack8(*(const u32x4*)(AQ + (q0 + qh + fr) * PLD + (hd0 + hx) * 128 + (fq ^ 2) * 8), oth);
          rope8(own, oth, fq < 2, R128 + (size_t)((q0 + qh + fr) & 4095) * 32 + (fq & 1) * 16); }
#pragma unroll
        for (int i = 0; i < 8; ++i) own[i] *= qscale;
        qf[hx][kk] = __builtin_bit_cast(bf16x8, packf8(own));
      }
    f32x4 O[2][8];
#pragma unroll
    for (int hx = 0; hx < 2; ++hx)
#pragma unroll
      for (int di = 0; di < 8; ++di) O[hx][di] = (f32x4){0.f, 0.f, 0.f, 0.f};
    float mrun[2] = {0.f, 0.f};
    f32x4 Lacc[2] = {(f32x4){0.f, 0.f, 0.f, 0.f}, (f32x4){0.f, 0.f, 0.f, 0.f}};
    const bf16x8 ones8 = __builtin_bit_cast(bf16x8, (u32x4){0x3F803F80u, 0x3F803F80u, 0x3F803F80u, 0x3F803F80u});
    const unsigned r15 = (unsigned)(fq * 4 + (fr >> 2));
    const unsigned vrb = r15 * 256u + (unsigned)(fr & 1) * 8u, vcx = (unsigned)((fr & 3) >> 1);
    const unsigned va0 = vrb + (((0u + vcx) ^ r15) << 4), va1 = vrb + (((2u + vcx) ^ r15) << 4), va2 = vrb + (((4u + vcx) ^ r15) << 4), va3 = vrb + (((6u + vcx) ^ r15) << 4);
    const unsigned va4 = vrb + (((8u + vcx) ^ r15) << 4), va5 = vrb + (((10u + vcx) ^ r15) << 4), va6 = vrb + (((12u + vcx) ^ r15) << 4), va7 = vrb + (((14u + vcx) ^ r15) << 4);
    asm volatile("s_waitcnt vmcnt(0)" ::: "memory");
    DS_ISSUE(0, 0);
    DS_ISSUE((ntile > 1) ? 1 : 0, 1);
#pragma unroll 1
    for (int kt = 0; kt < ntile; ++kt) {
      const int stg = kt % 3;
      asm volatile("s_waitcnt vmcnt(5)" ::: "memory");
      asm volatile("s_waitcnt lgkmcnt(0)" ::: "memory");
      __builtin_amdgcn_s_barrier();
      { const int ktn = (kt + 2 < ntile) ? kt + 2 : ntile - 1; DS_ISSUE(ktn, (kt + 2) % 3); }
      LAS const unsigned char* Kt = L + stg * RS;
      f32x4 S[2][4];
#pragma unroll
      for (int hx = 0; hx < 2; ++hx)
#pragma unroll
        for (int ni = 0; ni < 4; ++ni) { const float nb = -mrun[hx]; S[hx][ni] = (f32x4){nb, nb, nb, nb}; }
#pragma unroll
      for (int kk = 0; kk < 4; ++kk)
#pragma unroll
        for (int ni = 0; ni < 4; ++ni) {
          const bf16x8 ak = *(LAS const bf16x8*)(Kt + (ni * 16 + fr) * 256 + (((kk * 4 + fq) ^ fr) << 4));
          S[0][ni] = __builtin_amdgcn_mfma_f32_16x16x32_bf16(ak, qf[0][kk], S[0][ni], 0, 0, 0);
          S[1][ni] = __builtin_amdgcn_mfma_f32_16x16x32_bf16(ak, qf[1][kk], S[1][ni], 0, 0, 0);
        }
#define DS_TRI(o0, o1, aa, ab, ac, ad, r0, r1, r2, r3, r4, r5, r6, r7) asm volatile( \
        "ds_read_b64_tr_b16 %0, %8 offset:" #o0 "\n\tds_read_b64_tr_b16 %1, %8 offset:" #o1 "\n\tds_read_b64_tr_b16 %2, %9 offset:" #o0 "\n\tds_read_b64_tr_b16 %3, %9 offset:" #o1 "\n\t" \
        "ds_read_b64_tr_b16 %4, %10 offset:" #o0 "\n\tds_read_b64_tr_b16 %5, %10 offset:" #o1 "\n\tds_read_b64_tr_b16 %6, %11 offset:" #o0 "\n\tds_read_b64_tr_b16 %7, %11 offset:" #o1 \
        : "=&v"(r0), "=&v"(r1), "=&v"(r2), "=&v"(r3), "=&v"(r4), "=&v"(r5), "=&v"(r6), "=&v"(r7) : "v"((aa) + sb), "v"((ab) + sb), "v"((ac) + sb), "v"((ad) + sb) : "memory")
#define DS_TRW(r0, r1, r2, r3, r4, r5, r6, r7) asm volatile("s_waitcnt lgkmcnt(0)" : "+v"(r0), "+v"(r1), "+v"(r2), "+v"(r3), "+v"(r4), "+v"(r5), "+v"(r6), "+v"(r7) :: "memory")
      const unsigned sb = (unsigned)(LDS_MAIN + stg * RS + 16384);
      LAS const unsigned* wp = (LAS const unsigned*)(Kt + 32768 + (qh + fr) * 8);
      const unsigned mlo = wp[0] >> (fq * 4), mhi = wp[1] >> (fq * 4);
      unsigned pm[4][2];
#pragma unroll
      for (int ni = 0; ni < 4; ++ni)
#pragma unroll
        for (int jp = 0; jp < 2; ++jp) {
          const unsigned m = (ni < 2) ? mlo : mhi; const int sh = 16 * (ni & 1) + 2 * jp;
          const unsigned lo = (unsigned)__builtin_amdgcn_sbfe((int)m, sh, 1), hi = (unsigned)__builtin_amdgcn_sbfe((int)m, sh + 1, 1);
          pm[ni][jp] = __builtin_amdgcn_perm(hi, lo, 0x05040100u);
        }
      i64 t0, t1, t2, t3, t4, t5, t6, t7, u0, u1, u2, u3, u4, u5, u6, u7;
      __builtin_amdgcn_sched_barrier(0);
      DS_TRI(0, 4096, va0, va1, va2, va3, t0, t1, t2, t3, t4, t5, t6, t7);
      __builtin_amdgcn_sched_barrier(0);
      unsigned pk[2][4][2];
#pragma unroll
      for (int hx = 0; hx < 2; ++hx) {
        float mx = fmaxf(fmaxf(S[hx][0][0], S[hx][0][1]), fmaxf(S[hx][0][2], S[hx][0][3]));
#pragma unroll
        for (int ni = 1; ni < 4; ++ni) mx = fmaxf(mx, fmaxf(fmaxf(S[hx][ni][0], S[hx][ni][1]), fmaxf(S[hx][ni][2], S[hx][ni][3])));
        mx = rowmax4(mx);
        const bool up = (kt == 0) || (mx > 8.0f);
        if (__ballot(up) != 0ull) {
          const float d = up ? mx : 0.f;
          const float alpha = __builtin_amdgcn_exp2f(-d);
          mrun[hx] += d;
#pragma unroll
          for (int ni = 0; ni < 4; ++ni)
#pragma unroll
            for (int j = 0; j < 4; ++j) S[hx][ni][j] -= d;
#pragma unroll
          for (int di = 0; di < 8; ++di) O[hx][di] = O[hx][di] * alpha;
          Lacc[hx] = Lacc[hx] * alpha;
        }
#pragma unroll
        for (int ni = 0; ni < 4; ++ni)
#pragma unroll
          for (int jp = 0; jp < 2; ++jp)
            pk[hx][ni][jp] = pk2(__builtin_amdgcn_exp2f(S[hx][ni][2 * jp]), __builtin_amdgcn_exp2f(S[hx][ni][2 * jp + 1])) & pm[ni][jp];
      }
#define DS_PV(di, ta, tb) { const bf16x8 av = __builtin_bit_cast(bf16x8, (i64x2){ta, tb}); \
        O[0][di] = __builtin_amdgcn_mfma_f32_16x16x32_bf16(av, pb0, O[0][di], 0, 0, 0); O[1][di] = __builtin_amdgcn_mfma_f32_16x16x32_bf16(av, pb1, O[1][di], 0, 0, 0); }
      DS_TRW(t0, t1, t2, t3, t4, t5, t6, t7);
      {
        u32x4 pw;
        pw.x = pk[0][0][0]; pw.y = pk[0][0][1]; pw.z = pk[0][1][0]; pw.w = pk[0][1][1];
        const bf16x8 pb0 = __builtin_bit_cast(bf16x8, pw);
        pw.x = pk[1][0][0]; pw.y = pk[1][0][1]; pw.z = pk[1][1][0]; pw.w = pk[1][1][1];
        const bf16x8 pb1 = __builtin_bit_cast(bf16x8, pw);
        DS_TRI(0, 4096, va4, va5, va6, va7, u0, u1, u2, u3, u4, u5, u6, u7);
        __builtin_amdgcn_sched_barrier(0);
        Lacc[0] = __builtin_amdgcn_mfma_f32_16x16x32_bf16(ones8, pb0, Lacc[0], 0, 0, 0);
        Lacc[1] = __builtin_amdgcn_mfma_f32_16x16x32_bf16(ones8, pb1, Lacc[1], 0, 0, 0);
        DS_PV(0, t0, t1) DS_PV(1, t2, t3) DS_PV(2, t4, t5) DS_PV(3, t6, t7)
        __builtin_amdgcn_sched_barrier(0);
        DS_TRW(u0, u1, u2, u3, u4, u5, u6, u7);
        DS_TRI(8192, 12288, va0, va1, va2, va3, t0, t1, t2, t3, t4, t5, t6, t7);
        __builtin_amdgcn_sched_barrier(0);
        DS_PV(4, u0, u1) DS_PV(5, u2, u3) DS_PV(6, u4, u5) DS_PV(7, u6, u7)
        __builtin_amdgcn_sched_barrier(0);
      }
      {
        u32x4 pw;
        pw.x = pk[0][2][0]; pw.y = pk[0][2][1]; pw.z = pk[0][3][0]; pw.w = pk[0][3][1];
        const bf16x8 pb0 = __builtin_bit_cast(bf16x8, pw);
        pw.x = pk[1][2][0]; pw.y = pk[1][2][1]; pw.z = pk[1][3][0]; pw.w = pk[1][3][1];
        const bf16x8 pb1 = __builtin_bit_cast(bf16x8, pw);
        DS_TRW(t0, t1, t2, t3, t4, t5, t6, t7);
        DS_TRI(8192, 12288, va4, va5, va6, va7, u0, u1, u2, u3, u4, u5, u6, u7);
        __builtin_amdgcn_sched_barrier(0);
        Lacc[0] = __builtin_amdgcn_mfma_f32_16x16x32_bf16(ones8, pb0, Lacc[0], 0, 0, 0);
        Lacc[1] = __builtin_amdgcn_mfma_f32_16x16x32_bf16(ones8, pb1, Lacc[1], 0, 0, 0);
        DS_PV(0, t0, t1) DS_PV(1, t2, t3) DS_PV(2, t4, t5) DS_PV(3, t6, t7)
        __builtin_amdgcn_sched_barrier(0);
        DS_TRW(u0, u1, u2, u3, u4, u5, u6, u7);
        DS_PV(4, u0, u1) DS_PV(5, u2, u3) DS_PV(6, u4, u5) DS_PV(7, u6, u7)
      }
#undef DS_PV
#undef DS_TRI
#undef DS_TRW
    }
    asm volatile("s_waitcnt vmcnt(0)" ::: "memory");
#pragma unroll
    for (int hx = 0; hx < 2; ++hx) {
      const float inv = 1.0f / Lacc[hx][0];
      bf16_t* op = A2 + (q0 + qh + fr) * 1024 + 512 + (hd0 + hx) * 128 + fq * 4;
#pragma unroll
      for (int di = 0; di < 8; ++di) { u32x2 wv2; wv2.x = pk2(O[hx][di][0] * inv, O[hx][di][1] * inv); wv2.y = pk2(O[hx][di][2] * inv, O[hx][di][3] * inv); *(u32x2*)(op + di * 16) = wv2; }
    }
    __syncthreads();
  }
#undef DS_ISSUE
#undef DS_GLDS
}
__device__ __forceinline__ void phase3(const Params& p) {
  for (int rep = 0; rep < ((PROBE_DBL == 31) ? 2 : 1); ++rep)
  for (int id = blockIdx.x; id < 64; id += gridDim.x) { mlstm_item(p, id); __syncthreads(); }
  unsigned* qctr = (unsigned*)(p.ws + OFF_CTL) + CW_Q;
  LAS unsigned* qk = (LAS unsigned*)(SMEM + LDS_MISC);
  for (;;) {
    __syncthreads();
    if (threadIdx.x == 0) qk[0] = __hip_atomic_fetch_add(qctr, 1u, __ATOMIC_RELAXED, __HIP_MEMORY_SCOPE_AGENT);
    __syncthreads();
    const unsigned k = qk[0];
    if (k >= 1024u) break;
    dsa_item(p, (int)(k & 15u), 63 - (int)(k >> 4));
  }
}
struct EpiY { bf16_t* Y; int m0, n0;
  __device__ __forceinline__ void operator()(LAS const float* tile, int r, int c0) const { *(u32x4*)(Y + (size_t)(m0 + r) * 1024 + n0 + c0) = pack8(tile + r * TILE_LD + c0); } };
__device__ __forceinline__ void rows6(const Params& p, int row0) {
  const int tid_ = opaque_tid(); const int lane = tid_ & 63, wv = tid_ >> 6;
  const float* mb = (const float*)(p.ws + OFF_MOD) + (row0 >> 12) * 6144;
  const bf16_t* Y = (const bf16_t*)(p.ws + OFF_Y);
  bf16_t* H2 = (bf16_t*)(p.ws + OFF_ACTA); bf16_t* H2L = (bf16_t*)(p.ws + OFF_H2LO);
  float4 gpo[4], gt1[4], gpr[4], sh2[4], sc2[4];
#pragma unroll
  for (int i = 0; i < 4; ++i) { const int c = (lane + 64 * i) * 4; gpo[i] = *(const float4*)(p.g_mix_post + c); gt1[i] = *(const float4*)(mb + 2048 + c);
    gpr[i] = *(const float4*)(p.g_ffn_pre + c); sh2[i] = *(const float4*)(mb + 3072 + c); sc2[i] = *(const float4*)(mb + 4096 + c); }
  u32x2 yn[4]; float4 xn[4];
  const int rfirst = row0 + wv * 32;
#pragma unroll
  for (int i = 0; i < 4; ++i) { const int c = (lane + 64 * i) * 4; yn[i] = __builtin_nontemporal_load((const u32x2*)(Y + (size_t)rfirst * 1024 + c)); xn[i] = *(const float4*)(p.x + (size_t)rfirst * 1024 + c); }
#pragma unroll 1
  for (int r = 0; r < 32; ++r) {
    const int row = rfirst + r;
    u32x2 yc[4]; float4 xc[4];
#pragma unroll
    for (int i = 0; i < 4; ++i) { yc[i] = yn[i]; xc[i] = xn[i]; }
    if (r + 1 < 32) {
#pragma unroll
      for (int i = 0; i < 4; ++i) { const int c = (lane + 64 * i) * 4; yn[i] = __builtin_nontemporal_load((const u32x2*)(Y + (size_t)(row + 1) * 1024 + c)); xn[i] = *(const float4*)(p.x + (size_t)(row + 1) * 1024 + c); }
    }
    float y[16], xv[16]; float ssy = 0.f;
#pragma unroll
    for (int i = 0; i < 4; ++i) {
      y[4 * i] = bflo(yc[i].x); y[4 * i + 1] = bfhi(yc[i].x); y[4 * i + 2] = bflo(yc[i].y); y[4 * i + 3] = bfhi(yc[i].y);
      xv[4 * i] = xc[i].x; xv[4 * i + 1] = xc[i].y; xv[4 * i + 2] = xc[i].z; xv[4 * i + 3] = xc[i].w;
#pragma unroll
      for (int k = 0; k < 4; ++k) ssy += y[4 * i + k] * y[4 * i + k];
    }
    ssy = wave_sum(ssy);
    const float rsy = rsqrtf(ssy * (1.f / 1024.f) + EPS);
    float ss1 = 0.f;
#pragma unroll
    for (int i = 0; i < 4; ++i) {
      const int c = (lane + 64 * i) * 4;
      xv[4 * i] += gt1[i].x * (y[4 * i] * rsy * gpo[i].x); xv[4 * i + 1] += gt1[i].y * (y[4 * i + 1] * rsy * gpo[i].y);
      xv[4 * i + 2] += gt1[i].z * (y[4 * i + 2] * rsy * gpo[i].z); xv[4 * i + 3] += gt1[i].w * (y[4 * i + 3] * rsy * gpo[i].w);
      { u32x2 xb; xb.x = pk2(xv[4 * i], xv[4 * i + 1]); xb.y = pk2(xv[4 * i + 2], xv[4 * i + 3]); *(u32x2*)((bf16_t*)(p.out + (size_t)row * 1024) + c) = xb; }
#pragma unroll
      for (int k = 0; k < 4; ++k) ss1 += xv[4 * i + k] * xv[4 * i + k];
    }
    ss1 = wave_sum(ss1);
    const float rs1 = rsqrtf(ss1 * (1.f / 1024.f) + EPS);
#pragma unroll
    for (int i = 0; i < 4; ++i) {
      const int c = (lane + 64 * i) * 4;
      const float h0 = xv[4 * i] * rs1 * gpr[i].x * (1.f + sc2[i].x) + sh2[i].x, h1 = xv[4 * i + 1] * rs1 * gpr[i].y * (1.f + sc2[i].y) + sh2[i].y;
      const float h2 = xv[4 * i + 2] * rs1 * gpr[i].z * (1.f + sc2[i].z) + sh2[i].z, h3 = xv[4 * i + 3] * rs1 * gpr[i].w * (1.f + sc2[i].w) + sh2[i].w;
      const unsigned hw0 = pk2(h0, h1), hw1 = pk2(h2, h3);
      u32x2 hi; hi.x = hw0; hi.y = hw1;
      u32x2 lo; lo.x = pk2(h0 - bflo(hw0), h1 - bfhi(hw0)); lo.y = pk2(h2 - bflo(hw1), h3 - bfhi(hw1));
      *(u32x2*)(H2 + (size_t)row * 1024 + c) = hi; *(u32x2*)(H2L + (size_t)row * 1024 + c) = lo;
      { const int q8 = cvt4_fp8(__builtin_amdgcn_fmed3f(h0, -448.f, 448.f), __builtin_amdgcn_fmed3f(h1, -448.f, 448.f), __builtin_amdgcn_fmed3f(h2, -448.f, 448.f), __builtin_amdgcn_fmed3f(h3, -448.f, 448.f)); *(int*)(p.ws + OFF_H2Q + (size_t)row * 1024 + c) = q8; }
    }
  }
}
constexpr int LDS_RT = LDS_MAIN + 4 * GT_STAGE;
constexpr int LDS_RTX = LDS_RT + 512 + 320 + 1024;
__device__ __forceinline__ void route6g(const Params& p, int mt_begin, int mt_end) {
  const int tid = opaque_tid();
  GemmArgs<3> g{}; g.lda = 1024; g.ldb = 1024; g.K = 1024;
  const bf16_t* Hh = (const bf16_t*)(p.ws + OFF_ACTA); const bf16_t* Hl = (const bf16_t*)(p.ws + OFF_H2LO);
  const bf16_t* Wh = (const bf16_t*)(p.ws + OFF_WR); const bf16_t* Wl = Wh + 128 * 1024;
  g.A0 = Hh; g.B0 = Wh; g.A1 = Hl; g.B1 = Wh; g.A2 = Hh; g.B2 = Wl;
  unsigned* cnt = (unsigned*)(p.ws + OFF_CTL) + CW_CNT;
  int* SORTED = (int*)(p.ws + OFF_SORTED); float* GW = (float*)(p.ws + OFF_GW);
  LAS unsigned* cntl = (LAS unsigned*)(SMEM + LDS_RT); LAS unsigned* basel = cntl + 64;
  for (int rep6 = ((PROBE_DBL == 66) ? 0 : 1); rep6 < 2; ++rep6)
  for (int mt = mt_begin; mt < mt_end; ++mt) {
    const long ar = (long)mt * 128 + (tid >> 3);
    if (tid < 64) cntl[tid] = 0u;
    gemm_mainloop<3, true>(g, ar, ar + 64);
    LAS float* tile = (LAS float*)(SMEM + LDS_MAIN);
    const int tok = mt * 128 + tid;
    LAS int* rei = (LAS int*)(SMEM + LDS_RTX) + tid * 8; LAS float* rgw = (LAS float*)(SMEM + LDS_RTX + 4096) + tid * 8; LAS unsigned* rrk = (LAS unsigned*)(SMEM + LDS_RTX + 8192) + tid * 8;
    if (tid < 128) {
      LAS float* tr = tile + tid * TILE_LD;
      for (int e = 0; e < 64; ++e) { const float s = sigmoidf_(tr[e]); tr[64 + e] = s; tr[e] = s + p.b_router[e]; }
      float gs[8];
#pragma unroll
      for (int gi = 0; gi < 8; ++gi) {
        float m1 = -INFINITY, m2 = -INFINITY;
#pragma unroll
        for (int k = 0; k < 8; ++k) { const float v = tr[gi * 8 + k]; if (v > m1) { m2 = m1; m1 = v; } else if (v > m2) m2 = v; }
        gs[gi] = m1 + m2;
      }
#pragma unroll
      for (int gi = 0; gi < 8; ++gi) {
        int rank = 0;
#pragma unroll
        for (int gj = 0; gj < 8; ++gj) rank += (gs[gj] > gs[gi] || (gs[gj] == gs[gi] && gj < gi)) ? 1 : 0;
        if (rank >= 4) {
#pragma unroll
          for (int k = 0; k < 8; ++k) tr[gi * 8 + k] = -INFINITY; }
      }
      float gsum = 0.f;
#pragma unroll 1
      for (int it = 0; it < 8; ++it) {
        float best = -INFINITY; int bi = 0;
        for (int e = 0; e < 64; ++e) { const float v = tr[e]; if (v > best) { best = v; bi = e; } }
        const float sv = tr[64 + bi];
        rei[it] = bi; rgw[it] = sv; gsum += sv; tr[bi] = -INFINITY;
      }
      const float gn = 2.5f / gsum;
#pragma unroll 1
      for (int it = 0; it < 8; ++it) { rgw[it] *= gn; rrk[it] = __hip_atomic_fetch_add(cntl + rei[it], 1u, __ATOMIC_RELAXED, __HIP_MEMORY_SCOPE_WORKGROUP); }
    }
    __syncthreads();
    if (tid < 64) { const unsigned c = cntl[tid]; basel[tid] = (c && rep6 == 1) ? __hip_atomic_fetch_add(cnt + tid, c, __ATOMIC_RELAXED, __HIP_MEMORY_SCOPE_AGENT) : 0u; }
    __syncthreads();
    if (tid < 128 && rep6 == 1) {
#pragma unroll 1
      for (int it = 0; it < 8; ++it) {
        const int e = rei[it];
        const unsigned pos = basel[e] + rrk[it];
        u32x2 rec; rec.x = (unsigned)(tok * 8 + it); rec.y = __builtin_bit_cast(unsigned, rgw[it]);
        *(u32x2*)(SORTED + ((size_t)e * 65536 + pos) * 2) = rec;
      }
    }
    __syncthreads();
  }
}

struct PanelOrder {
  static constexpr bool REC = false, BSTAT = false; static constexpr int SCALE_A = 0, SCALE_B = 0;
  int pm; const char* Bt;
  __device__ __forceinline__ bool next(int i, pg8::Unit& u) const { if (i >= 4) return false; u.pm = pm; u.pn = i; u.e = 0; u.lt = 0; return true; }
  __device__ __forceinline__ const char* b_base(const pg8::Unit& u) const { return Bt + (size_t)u.pn * 256 * 1024 * 2; }
  __device__ __forceinline__ unsigned a_off(const pg8::Unit& u, int row) const { return (unsigned)(u.pm * 256 + row) * 2048u; }
  __device__ __forceinline__ const char* rec_ptr(const pg8::Unit&) const { return nullptr; }
  __device__ __forceinline__ bool has_rec(const pg8::Unit&) const { return false; }
  __device__ __forceinline__ bool row_valid(const pg8::Unit&, int) const { return true; }
  __device__ __forceinline__ int nvalid(const pg8::Unit&) const { return 256; }
  __device__ __forceinline__ unsigned a_off_idx(const pg8::Unit&, int, int) const { return 0u; }
};
__device__ __forceinline__ void phase56(const Params& p) {
#pragma unroll 1
  for (int pm = blockIdx.x; pm < 256; pm += gridDim.x) {
    PanelOrder S{pm, (const char*)(p.ws + OFF_WOUT)};
    pg8::EpiStoreBf16 E{(bf16_t*)(p.ws + OFF_Y), 1024};
    pg8::gemm_phase(SMEM + LDS_PG8, (const bf16_t*)(p.ws + OFF_ACTA), 1024, S, E);
    rows6(p, pm * 256);
    asm volatile("s_waitcnt vmcnt(0)" ::: "memory");
    __syncthreads();
    route6g(p, pm * 2, pm * 2 + 2);
  }
}
constexpr int LDS_PRE = LDS_PG8 + 131072 + 8192 + 256;
constexpr int LDS_TAB = LDS_PRE + 1024;
typedef float f32x2 __attribute__((ext_vector_type(2)));
__device__ __forceinline__ void moe_prefix(const Params& p) {
  LAS int* pre = (LAS int*)(SMEM + LDS_PRE); LAS unsigned char* tab = SMEM + LDS_TAB;
  const unsigned* cnt = (const unsigned*)(p.ws + OFF_CTL) + CW_CNT;
  __syncthreads();
  if (threadIdx.x < 64) {
    const int e = threadIdx.x; const int c = (int)cnt[e]; const int nt_ = (c + 255) >> 8; int inc = nt_;
#pragma unroll
    for (int d = 1; d < 64; d <<= 1) { const int o = __shfl_up(inc, d, 64); if (e >= d) inc += o; }
    const int beg = inc - nt_;
    pre[e] = beg; if (e == 63) pre[64] = inc; pre[128 + e] = c;
    for (int t = beg; t < inc; ++t) tab[t] = (unsigned char)e;
  }
  __syncthreads();
}
template <int SA, int SB, int NT, bool BS = false>
struct MoeOrder {
  static constexpr bool REC = true, BSTAT = BS;
  static constexpr int SCALE_A = SA * 0x01010101, SCALE_B = SB * 0x01010101;
  int R, nwg, G, c, hf, mode, rowbytes, routed; const unsigned* cnt; const int* list; const char* W; size_t estride, tstride;
  __device__ __forceinline__ bool next(int i, pg8::Unit& u) const {
    const int cc = (c & 7) * (G >> 3) + (c >> 3);
    if (BS) {
      const int nch = G / NT, j = cc / NT, q = R / nch, r = R - q * nch;
      const int start = j * q + (j < r ? j : r), len = q + (j < r ? 1 : 0);
      if (j >= nch || i >= len) return false;
      u.pm = start + i; u.pn = cc - j * NT;
    } else {
    const int L = i * G + cc; if (L >= nwg) return false;
    u.pm = L / NT; u.pn = L - u.pm * NT; }
    if (u.pm >= routed) { u.e = 64; u.lt = u.pm - routed; }
    else { u.e = (int)(SMEM + LDS_TAB)[u.pm]; u.lt = u.pm - ((LAS const int*)(SMEM + LDS_PRE))[u.e]; }
    return true;
  }
  __device__ __forceinline__ const char* b_base(const pg8::Unit& u) const { return W + (size_t)u.e * estride + (size_t)u.pn * tstride; }
  __device__ __forceinline__ const char* rec_ptr(const pg8::Unit& u) const { return (const char*)(list + ((size_t)(u.e < 64 ? u.e : 0) * 65536 + (u.e < 64 ? u.lt * 256 : 0)) * 2); }
  __device__ __forceinline__ bool has_rec(const pg8::Unit& u) const { return u.e < 64; }
  __device__ __forceinline__ bool row_valid(const pg8::Unit& u, int row) const { return (u.lt * 256 + row) < ((LAS const int*)(SMEM + LDS_PRE))[128 + (u.e < 64 ? u.e : 0)]; }
  __device__ __forceinline__ int nvalid(const pg8::Unit& u) const { return ((LAS const int*)(SMEM + LDS_PRE))[128 + (u.e < 64 ? u.e : 0)] - u.lt * 256; }
  __device__ __forceinline__ unsigned a_off_idx(const pg8::Unit& u, int row, int idx) const { const int arow = (mode == 0) ? (idx >> 3) : idx; return (unsigned)arow * (unsigned)rowbytes; }
  __device__ __forceinline__ unsigned a_off(const pg8::Unit& u, int row) const {
    const int tl = u.lt * 256 + row; const int arow = (mode == 0) ? tl : (524288 + tl);
    return (unsigned)arow * (unsigned)rowbytes;
  }
};
constexpr int LDS_EPI = LDS_TAB + 2560;
#define EPI_BAR() do { asm volatile("s_waitcnt lgkmcnt(0)" ::: "memory"); __builtin_amdgcn_s_barrier(); } while (0)
struct EpiU { unsigned char* U; const unsigned* cnt; const int* list; int hf;
  __device__ __forceinline__ void operator()(const f32x4 (&acc)[2][2][4][2], const pg8::Unit& u, int wr, int wc, int fr, int fq, LAS const unsigned char* rec) const {
    const bool rt = u.e < 64;
    const int nrow = rt ? ((LAS const int*)(SMEM + LDS_PRE))[128 + u.e] : 0x7fffffff;
    LAS unsigned char* st = SMEM + LDS_EPI;
    const int tid = (wr * 4 + wc) * 64 + fq * 16 + fr;
    const int c16 = tid & 7;
    int ridx[2][2];
#pragma unroll
    for (int ai = 0; ai < 2; ++ai)
#pragma unroll
      for (int i = 0; i < 2; ++i) ridx[ai][i] = *(LAS const int*)(rec + (ai * 128 + ((tid + 512 * i) >> 3)) * 8);
    unsigned char* dp[2][2]; bool ok[2][2];
#pragma unroll
    for (int ai = 0; ai < 2; ++ai)
#pragma unroll
      for (int i = 0; i < 2; ++i) {
        const int li = u.lt * 256 + ai * 128 + ((tid + 512 * i) >> 3);
        ok[ai][i] = li < nrow;
        const int ur = rt ? ridx[ai][i] : (524288 + li);
        dp[ai][i] = U + (size_t)ur * 256 + u.pn * 128 + c16 * 16;
      }
#pragma unroll
    for (int ai = 0; ai < 2; ++ai) {
#pragma unroll
      for (int m = 0; m < 4; ++m)
#pragma unroll
        for (int bj = 0; bj < 2; ++bj) {
          const f32x4 g = acc[ai][bj][m][0], up = acc[ai][bj][m][1];
          float uu[4];
#pragma unroll
          for (int i = 0; i < 4; ++i) uu[i] = __builtin_amdgcn_fmed3f(siluf_(g[i]) * up[i] * 4.0f, -448.f, 448.f);
          const int w8 = cvt4_fp8(uu[0], uu[1], uu[2], uu[3]);
          *(LAS int*)(st + (wr * 64 + m * 16 + fr) * 144 + bj * 64 + wc * 16 + 4 * fq) = w8;
        }
      EPI_BAR();
#pragma unroll
      for (int i = 0; i < 2; ++i) {
        const int row = (tid + 512 * i) >> 3;
        if (ok[ai][i]) { const u32x4 v = *(LAS const u32x4*)(st + row * 144 + c16 * 16); *(u32x4*)dp[ai][i] = v; }
      }
      EPI_BAR();
    }
  } };
__device__ __forceinline__ void phase7(const Params& p) {
  const int hf = 0; moe_prefix(p);
  const int routed = ((LAS const int*)(SMEM + LDS_PRE))[64];
  MoeOrder<127, 122, 2> S; S.R = routed + 256; S.nwg = S.R * 2; S.G = gridDim.x; S.c = blockIdx.x; S.hf = hf; S.mode = 0; S.rowbytes = 1024; S.routed = routed;
  S.cnt = (const unsigned*)(p.ws + OFF_CTL) + CW_CNT; S.list = (const int*)(p.ws + OFF_SORTED);
  S.W = (const char*)(p.ws + OFF_WGU); S.estride = (size_t)512 * 1024; S.tstride = (size_t)256 * 1024;
  EpiU E{p.ws + OFF_U, S.cnt, S.list, hf};
  pg8::gemm_phase<EpiU, MoeOrder<127, 122, 2>, true>(SMEM + LDS_PG8, (const bf16_t*)(p.ws + OFF_H2Q), 512, S, E);
}
#ifdef PROBE_WI
#define PWI PROBE_WI
#else
#define PWI 0
#endif
struct EpiYE { unsigned char* YE; const float* GW; const unsigned* cnt; const int* list; int hf; int pmode;
  __device__ __forceinline__ void operator()(const f32x4 (&acc)[2][2][4][2], const pg8::Unit& u, int wr, int wc, int fr, int fq, LAS const unsigned char* rec) const {
    const bool rt = u.e < 64;
    const int nrow = rt ? ((LAS const int*)(SMEM + LDS_PRE))[128 + u.e] : 0x7fffffff;
    LAS unsigned char* st = SMEM + LDS_EPI;
    const int tid = (wr * 4 + wc) * 64 + fq * 16 + fr;
    const int c16 = tid & 7;
    int gwb[2][4], ridx[2][2];
#pragma unroll
    for (int ai = 0; ai < 2; ++ai) {
#pragma unroll
      for (int m = 0; m < 4; ++m) gwb[ai][m] = ((LAS const int*)(rec + (ai * 128 + wr * 64 + m * 16 + fr) * 8))[1];
#pragma unroll
      for (int i = 0; i < 2; ++i) ridx[ai][i] = *(LAS const int*)(rec + (ai * 128 + ((tid + 512 * i) >> 3)) * 8);
    }
    unsigned char* dp[2][2]; bool ok[2][2];
#pragma unroll
    for (int ai = 0; ai < 2; ++ai)
#pragma unroll
      for (int i = 0; i < 2; ++i) {
        const int li = u.lt * 256 + ai * 128 + ((tid + 512 * i) >> 3);
        ok[ai][i] = li < nrow;
        const int idx = ridx[ai][i];
        const int dst = rt ? ((idx >> 3) * 9 + (idx & 7)) : (li * 9 + 8);
        dp[ai][i] = YE + (size_t)dst * 1024 + u.pn * 256 + c16 * 16;
      }
#pragma unroll
    for (int ai = 0; ai < 2; ++ai) {
      float sc[4];
#pragma unroll
      for (int m = 0; m < 4; ++m) { const int gb = gwb[ai][m]; sc[m] = rt ? YE_SCALE * __builtin_bit_cast(float, gb) : YE_SCALE; }
#pragma unroll
      for (int bj = 0; bj < 2; ++bj) {
#pragma unroll
        for (int m = 0; m < 4; ++m) {
          const f32x4 v0 = acc[ai][bj][m][0], v1 = acc[ai][bj][m][1];
          float o[8];
#pragma unroll
          for (int i = 0; i < 4; ++i) { o[i] = mul_s(v0[i], sc[m]); o[4 + i] = mul_s(v1[i], sc[m]); }
          int w0 = 0, w1 = 0;
          if ((PWI & 64) && pmode) { w0 = __builtin_bit_cast(int, v0[0]); w1 = __builtin_bit_cast(int, v1[1]); } else {
#pragma unroll
          for (int i = 0; i < 8; ++i) o[i] = __builtin_amdgcn_fmed3f(o[i], -448.f, 448.f);
          if ((PWI & 512) && pmode) { v2i16_t q0 = {0, 0}, q1 = {0, 0};
            q0 = __builtin_amdgcn_cvt_scalef32_pk_fp8_f32(q0, o[0], o[1], 1.0f, false); q0 = __builtin_amdgcn_cvt_scalef32_pk_fp8_f32(q0, o[2], o[3], 1.0f, true);
            q1 = __builtin_amdgcn_cvt_scalef32_pk_fp8_f32(q1, o[4], o[5], 1.0f, false); q1 = __builtin_amdgcn_cvt_scalef32_pk_fp8_f32(q1, o[6], o[7], 1.0f, true);
            w0 = __builtin_bit_cast(int, q0); w1 = __builtin_bit_cast(int, q1); }
          else if ((PWI & 1024) && pmode) { v2i16_t q0 = {0, 0}, q1 = {0, 0};
            const unsigned b0 = pk2(o[0], o[1]), b1 = pk2(o[2], o[3]), b2 = pk2(o[4], o[5]), b3 = pk2(o[6], o[7]);
            q0 = __builtin_amdgcn_cvt_scalef32_pk_fp8_bf16(q0, __builtin_bit_cast(bf16x2_t, b0), 1.0f, false); q0 = __builtin_amdgcn_cvt_scalef32_pk_fp8_bf16(q0, __builtin_bit_cast(bf16x2_t, b1), 1.0f, true);
            q1 = __builtin_amdgcn_cvt_scalef32_pk_fp8_bf16(q1, __builtin_bit_cast(bf16x2_t, b2), 1.0f, false); q1 = __builtin_amdgcn_cvt_scalef32_pk_fp8_bf16(q1, __builtin_bit_cast(bf16x2_t, b3), 1.0f, true);
            w0 = __builtin_bit_cast(int, q0); w1 = __builtin_bit_cast(int, q1); }
          else           if ((PWI & 256) && pmode) { w0 = (int)(pk2(o[0], o[1]) ^ pk2(o[2], o[3])); w1 = (int)(pk2(o[4], o[5]) ^ pk2(o[6], o[7])); } else {
          w0 = cvt4_fp8(o[0], o[1], o[2], o[3]); w1 = cvt4_fp8(o[4], o[5], o[6], o[7]); } }
          u32x2 w; w.x = (unsigned)w0; w.y = (unsigned)w1;
          *(LAS u32x2*)(st + (wr * 64 + m * 16 + fr) * 144 + wc * 32 + 8 * fq) = w;
        }
        if (!(PWI & 128) || pmode == 0) EPI_BAR();
#pragma unroll
        for (int i = 0; i < 2; ++i) {
          const int row = (tid + 512 * i) >> 3;
          if (ok[ai][i]) {
            const u32x4 v = *(LAS const u32x4*)(st + row * 144 + c16 * 16);
            if (PROBE_DBL != 83 || pmode == 0 || v.x == 0x7fc12345u) *(u32x4*)(dp[ai][i] + bj * 128) = v;
          }
        }
        if (!(PWI & 128) || pmode == 0) EPI_BAR();
      }
    }
  } };
__device__ __forceinline__ void phase8(const Params& p, const int pmode = 0) {
  const int hf = 0; moe_prefix(p);
  const int routed = ((LAS const int*)(SMEM + LDS_PRE))[64];
  MoeOrder<125, 123, 4, true> S; S.R = routed + 256; S.nwg = S.R * 4; S.G = gridDim.x; S.c = blockIdx.x; S.hf = hf; S.mode = 1; S.rowbytes = 256; S.routed = routed;
  S.cnt = (const unsigned*)(p.ws + OFF_CTL) + CW_CNT; S.list = (const int*)(p.ws + OFF_SORTED);
  S.W = (const char*)(p.ws + OFF_WDN); S.estride = (size_t)1024 * 256; S.tstride = (size_t)256 * 256;
  EpiYE E{p.ws + OFF_YE, (const float*)(p.ws + OFF_GW), S.cnt, S.list, hf, pmode};
#ifdef PROBE_WI
  if (pmode) pg8::gemm_phase<EpiYE, MoeOrder<125, 123, 4, true>, true, PROBE_WI>(SMEM + LDS_PG8, (const bf16_t*)(p.ws + OFF_U), 128, S, E); else
#endif
  pg8::gemm_phase<EpiYE, MoeOrder<125, 123, 4, true>, true>(SMEM + LDS_PG8, (const bf16_t*)(p.ws + OFF_U), 128, S, E);
}
__device__ __forceinline__ void phase9(const Params& p) {
  const int tid_ = opaque_tid(); const int lane = tid_ & 63, gw = blockIdx.x * 8 + (tid_ >> 6), nw = gridDim.x * 8;
  const float* mod = (const float*)(p.ws + OFF_MOD);
  const unsigned char* YE = p.ws + OFF_YE;
  const int c = lane * 16;
  float4 gp[4];
#pragma unroll
  for (int i = 0; i < 4; ++i) gp[i] = *(const float4*)(p.g_ffn_post + c + 4 * i);
  u32x4 vn[9]; u32x4 xn[2];
  if (gw < T_TOK) {
#pragma unroll
    for (int s = 0; s < 9; ++s) vn[s] = *(const u32x4*)(YE + ((size_t)gw * 9 + s) * 1024 + c);
    xn[0] = *(const u32x4*)((const bf16_t*)(p.out + (size_t)gw * 1024) + c); xn[1] = *(const u32x4*)((const bf16_t*)(p.out + (size_t)gw * 1024) + c + 8);
  }
  for (int rep9 = ((PROBE_DBL == 9) ? 0 : 1); rep9 < 2; ++rep9)
#pragma unroll 1
  for (int row = gw; row < T_TOK; row += nw) {
    const int b = row >> 12;
    u32x4 vc[9]; u32x4 xc[2];
#pragma unroll
    for (int s = 0; s < 9; ++s) vc[s] = vn[s];
    xc[0] = xn[0]; xc[1] = xn[1];
    { const int rn = (row + nw < T_TOK) ? row + nw : row;
#pragma unroll
      for (int s = 0; s < 9; ++s) vn[s] = *(const u32x4*)(YE + ((size_t)rn * 9 + s) * 1024 + c);
      xn[0] = *(const u32x4*)((const bf16_t*)(p.out + (size_t)rn * 1024) + c); xn[1] = *(const u32x4*)((const bf16_t*)(p.out + (size_t)rn * 1024) + c + 8); }
    float acc[16];
#pragma unroll
    for (int i = 0; i < 16; ++i) acc[i] = 0.f;
#pragma unroll
    for (int s = 0; s < 9; ++s) {
      const unsigned vw[4] = {vc[s].x, vc[s].y, vc[s].z, vc[s].w};
#pragma unroll
      for (int k = 0; k < 4; ++k) {
        const f32x2 lo = __builtin_amdgcn_cvt_pk_f32_fp8((int)vw[k], false), hi = __builtin_amdgcn_cvt_pk_f32_fp8((int)vw[k], true);
        acc[4 * k] += lo[0]; acc[4 * k + 1] += lo[1]; acc[4 * k + 2] += hi[0]; acc[4 * k + 3] += hi[1];
      }
    }
    float ss = 0.f;
#pragma unroll
    for (int i = 0; i < 16; ++i) { acc[i] *= (1.0f / YE_SCALE); ss += acc[i] * acc[i]; }
    ss = wave_sum(ss);
    const float rs = rsqrtf(ss * (1.f / 1024.f) + EPS);
    float* op = p.out + (size_t)row * 1024 + c;
#pragma unroll
    for (int i = 0; i < 4; ++i) {
      const unsigned xw0 = (i == 0) ? xc[0].x : (i == 1) ? xc[0].z : (i == 2) ? xc[1].x : xc[1].z, xw1 = (i == 0) ? xc[0].y : (i == 1) ? xc[0].w : (i == 2) ? xc[1].y : xc[1].w;
      float4 x1 = make_float4(bflo(xw0), bfhi(xw0), bflo(xw1), bfhi(xw1));
      const float4 gt = *(const float4*)(mod + b * 6144 + 5120 + c + 4 * i);
      x1.x += gt.x * (acc[4 * i] * rs * gp[i].x); x1.y += gt.y * (acc[4 * i + 1] * rs * gp[i].y); x1.z += gt.z * (acc[4 * i + 2] * rs * gp[i].z); x1.w += gt.w * (acc[4 * i + 3] * rs * gp[i].w);
      if (rep9 == 1) *(float4*)(op + 4 * i) = x1; else if (x1.x == 123456.789f) *(float4*)(op + 4 * i) = x1;
    }
  }
}

#define DBL(n, call) do { call; if (PROBE_DBL == (n)) { xcd_barrier(bar); call; } } while (0)
#ifndef STOP_AFTER
#define STOP_AFTER 99
#endif
__global__ void __launch_bounds__(NTHR) fwd_kernel(Params p) {
  volatile LAS unsigned* st = (volatile LAS unsigned*)(SMEM + LDS_ST);
  if (threadIdx.x < 4) st[threadIdx.x] = 0u;
  __syncthreads();
  XcdBarrier bar = xcd_barrier_post((unsigned*)(p.ws + OFF_CTL) + CW_BAR, st);
  __syncthreads();
  DBL(0, phase0(p));  xcd_barrier(bar);
  DBL(1, phase1(p));  xcd_barrier(bar);
  DBL(2, phase2(p));  xcd_barrier(bar);
  DBL(20, phase2b(p)); xcd_barrier(bar);
  DBL(3, phase3(p));  xcd_barrier(bar);
  phase56(p); xcd_barrier(bar);
#ifdef PROBE_CLK
  long long pc0 = 0, pw0 = 0, pc1 = 0, pw1 = 0;
  if (PROBE_CLK == 7) { pc0 = clock64(); pw0 = wall_clock64(); }
#endif
  DBL(7, phase7(p)); xcd_barrier(bar);
  DBL(8, phase8(p)); if (PROBE_DBL == 83) { xcd_barrier(bar); phase8(p, 1); } xcd_barrier(bar);
#ifdef PROBE_CLK
  if (PROBE_CLK == 7) { pc1 = clock64(); pw1 = wall_clock64(); }
#endif
  phase9(p);
#ifdef PROBE_CLK
  if (blockIdx.x == 0 && threadIdx.x == 0) {
    const long long mhz = (pc1 - pc0) * 100 / (pw1 - pw0 + 1);
    const long long ticks = mhz * 25;
    const long long ts = wall_clock64();
    while (wall_clock64() - ts < ticks) __builtin_amdgcn_s_sleep(20);
  }
#endif
}

extern "C" void kernel_launch(void* const* d_in, const int* in_sizes, int n_in, void* d_out, int out_size, void* d_ws, size_t ws_size, hipStream_t stream) {
  static int grid_blocks = 0;
  if (!grid_blocks) {
    int dev = 0, cus = 0, per_cu = 0;
    (void)hipGetDevice(&dev);
    (void)hipDeviceGetAttribute(&cus, hipDeviceAttributeMultiprocessorCount, dev);
    (void)hipFuncSetAttribute((const void*)fwd_kernel, hipFuncAttributeMaxDynamicSharedMemorySize, LDS_BYTES);
    (void)hipOccupancyMaxActiveBlocksPerMultiprocessor(&per_cu, (const void*)fwd_kernel, NTHR, LDS_BYTES);
    grid_blocks = cus;
    if (per_cu < 1 || ws_size < WS_NEED || n_in != 25) fprintf(stderr, "kernel_launch: per_cu=%d ws=%zu need=%zu n_in=%d\n", per_cu, ws_size, (size_t)WS_NEED, n_in);
  }
  (void)hipMemsetAsync((char*)d_ws + OFF_CTL, 0, CTL_ZERO_BYTES, stream);
  Params p{};
  const float** f = (const float**)&p;
  for (int i = 0; i < 25; ++i) f[i] = (const float*)d_in[i];
  p.out = (float*)d_out; p.ws = (unsigned char*)d_ws;
  void* args[] = {&p};
  hipError_t e = hipLaunchCooperativeKernel((void*)fwd_kernel, dim3(grid_blocks), dim3(NTHR), args, LDS_BYTES, stream);
  if (e != hipSuccess) fprintf(stderr, "cooperative launch failed: %s (grid %d)\n", hipGetErrorString(e), grid_blocks);
}
```

```cpp
#include <hip/hip_runtime.h>
#include <cstdio>
#include <cstdint>
#ifndef PROBE_DBL
#define PROBE_DBL -1
#endif
#define LAS __attribute__((address_space(3)))
typedef unsigned short bf16_t;
typedef short bf16x8 __attribute__((ext_vector_type(8)));
typedef float f32x4 __attribute__((ext_vector_type(4)));
typedef unsigned u32x4 __attribute__((ext_vector_type(4)));
typedef unsigned u32x2 __attribute__((ext_vector_type(2)));
typedef short v4i16_t __attribute__((ext_vector_type(4)));

constexpr int T_TOK = 65536, DM = 1024, SEQ = 4096, NB = 16;
constexpr int NPROJ = 3328; constexpr int PLD = 3072;
constexpr float EPS = 1e-6f;
constexpr int NTHR = 512;
constexpr size_t MB = 1u << 20;
constexpr size_t OFF_CTL = 0;
constexpr size_t OFF_MOD = 64 * 1024;
constexpr size_t CTL_ZERO_BYTES = 64 * 1024 + 512 * 1024;
constexpr size_t OFF_ROPE = 1 * MB;
constexpr size_t OFF_WR = 2 * MB;
constexpr size_t OFF_WIN = 3 * MB;
constexpr size_t OFF_WOUT = 10 * MB;
constexpr size_t OFF_WGU = 12 * MB;
constexpr size_t OFF_WDN = 80 * MB;
constexpr size_t OFF_ACTA = 116 * MB;
constexpr size_t OFF_P = 244 * MB;
constexpr size_t OFF_PROJ = OFF_P + 0;
constexpr size_t OFF_MQKC = OFF_P + 384 * MB;
constexpr size_t OFF_AK = OFF_P + 512 * MB;
constexpr size_t OFF_IK = OFF_P + 528 * MB;
constexpr size_t OFF_GATES = OFF_P + 536 * MB;
constexpr size_t OFF_IW = OFF_P + 538 * MB;
constexpr size_t OFF_PROJL = OFF_P + 540 * MB;
constexpr size_t OFF_HMRAW = OFF_P + 572 * MB;
constexpr size_t OFF_BITM = OFF_P + 636 * MB;
constexpr size_t OFF_GL = OFF_P + 668 * MB;
constexpr size_t OFF_Y = OFF_P + 0;
constexpr size_t OFF_H2LO = OFF_P + 128 * MB;
constexpr size_t OFF_SORTED = 932 * MB;
constexpr size_t OFF_GW = OFF_P + 272 * MB;
constexpr size_t OFF_H2Q = 868 * MB;
constexpr size_t OFF_U = 724 * MB;
constexpr size_t OFF_YE = 120 * MB;
constexpr size_t WS_NEED = 964 * MB;
constexpr int CW_BAR = 0;
constexpr int CW_CNT = 4096;
constexpr int CW_Q = 4352;
constexpr float YE_SCALE = 16.0f;
constexpr float U_SCALE = 16.0f;

struct Params {
  const float *x, *c, *w_ada, *b_ada, *g_mix_pre, *g_mix_post, *g_ffn_pre, *g_ffn_post, *w_in, *conv_w, *conv_b, *b_igate, *b_fgate,
      *g_mlstm_head, *g_idx_k, *b_idx_k, *w_out, *w_router, *b_router, *w_exp_gate, *w_exp_up, *w_exp_down, *w_sh_gate, *w_sh_up, *w_sh_down;
  float* out; unsigned char* ws;
};

__device__ __forceinline__ unsigned f2bf(float f) { unsigned u = __builtin_bit_cast(unsigned, f); return (u + 0x7fffu + ((u >> 16) & 1u)) >> 16; }
typedef float f32x2_t __attribute__((ext_vector_type(2)));
typedef __bf16 bf16x2_t __attribute__((ext_vector_type(2)));
__device__ __forceinline__ unsigned pk2(float lo, float hi) { const f32x2_t v = {lo, hi}; const bf16x2_t b = __builtin_convertvector(v, bf16x2_t); return __builtin_bit_cast(unsigned, b); }
__device__ __forceinline__ float bf2f(unsigned h) { return __builtin_bit_cast(float, h << 16); }
__device__ __forceinline__ float bflo(unsigned w) { return __builtin_bit_cast(float, w << 16); }
__device__ __forceinline__ float bfhi(unsigned w) { return __builtin_bit_cast(float, w & 0xffff0000u); }
typedef short v2i16_t __attribute__((ext_vector_type(2)));
__device__ __forceinline__ int cvt4_fp8(float a, float b, float c, float d) {
  v2i16_t q = {0, 0};
  q = __builtin_amdgcn_cvt_scalef32_pk_fp8_f32(q, a, b, 1.0f, false);
  q = __builtin_amdgcn_cvt_scalef32_pk_fp8_f32(q, c, d, 1.0f, true);
  return __builtin_bit_cast(int, q);
}
__device__ __forceinline__ float mul_s(float a, float b) { float r; asm("v_mul_f32 %0, %1, %2" : "=v"(r) : "v"(a), "v"(b)); return r; }
typedef unsigned u32x2s_t __attribute__((ext_vector_type(2)));
__device__ __forceinline__ float rowmax4(float v) {
  unsigned b = __builtin_bit_cast(unsigned, v);
  u32x2s_t r = __builtin_amdgcn_permlane16_swap(b, b, false, false);
  unsigned r0 = r.x, r1 = r.y;
  v = fmaxf(__builtin_bit_cast(float, r0), __builtin_bit_cast(float, r1));
  b = __builtin_bit_cast(unsigned, v);
  r = __builtin_amdgcn_permlane32_swap(b, b, false, false);
  r0 = r.x; r1 = r.y;
  return fmaxf(__builtin_bit_cast(float, r0), __builtin_bit_cast(float, r1));
}
__device__ __forceinline__ float rowsum4(float v) {
  unsigned b = __builtin_bit_cast(unsigned, v);
  u32x2s_t r = __builtin_amdgcn_permlane16_swap(b, b, false, false);
  unsigned r0 = r.x, r1 = r.y;
  v = __builtin_bit_cast(float, r0) + __builtin_bit_cast(float, r1);
  b = __builtin_bit_cast(unsigned, v);
  r = __builtin_amdgcn_permlane32_swap(b, b, false, false);
  r0 = r.x; r1 = r.y;
  return __builtin_bit_cast(float, r0) + __builtin_bit_cast(float, r1);
}
__device__ __forceinline__ float wave_sum(float v) {
#pragma unroll
  for (int m = 32; m >= 1; m >>= 1) v += __shfl_xor(v, m);
  return v;
}
__device__ __forceinline__ int opaque_tid() { int t = threadIdx.x; asm volatile("" : "+v"(t)); return t; }
__device__ __forceinline__ float sigmoidf_(float x) { return __builtin_amdgcn_rcpf(1.0f + __expf(-x)); }
__device__ __forceinline__ float siluf_(float x) { return x * __builtin_amdgcn_rcpf(1.0f + __expf(-x)); }

#define XB_TMO      128
#define XB_XCNT(j)  (256  + 64 * (j))
#define XB_XSUB(j)  (1280 + 64 * (j))
#define XB_XGEN(j)  (2304 + 64 * (j))
#define XB_TOP      3328
#define XB_TOPGEN   3392
#define XCD_BAR_WORDS 3456
#define XB_SPIN_CAP (1u << 24)
__device__ __forceinline__ unsigned xb_ld(unsigned* p)              { return __hip_atomic_load(p, __ATOMIC_RELAXED, __HIP_MEMORY_SCOPE_AGENT); }
__device__ __forceinline__ unsigned xb_add(unsigned* p, unsigned v) { return __hip_atomic_fetch_add(p, v, __ATOMIC_RELAXED, __HIP_MEMORY_SCOPE_AGENT); }
__device__ __forceinline__ unsigned xb_xcc_id() { return (unsigned)__builtin_amdgcn_s_getreg((3 << 11) | 20) & 0xFu; }
#define XB_SPIN(cond, bar) do { unsigned _sp = 0; while (cond) { __builtin_amdgcn_s_sleep(1); \
    if ((++_sp & 255u) == 0u) { if (xb_ld(&(bar)[XB_TMO])) break; if (_sp > XB_SPIN_CAP) { xb_add(&(bar)[XB_TMO], 1u); break; } } } } while (0)
struct XcdBarrier { unsigned* bar; volatile LAS unsigned* st; };
__device__ __forceinline__ XcdBarrier xcd_barrier_post(unsigned* bar, volatile LAS unsigned* st) {
    XcdBarrier b; b.bar = bar; b.st = st;
    if (threadIdx.x == 0) { const unsigned x = xb_xcc_id(); st[2] = x; (void)xb_add(&bar[XB_XCNT(x)], 1u); }
    return b;
}
__device__ __forceinline__ void xcd_barrier_complete(unsigned* bar, unsigned x, unsigned& nloc, unsigned& nx) {
    const unsigned G = gridDim.x * gridDim.y * gridDim.z;
    unsigned sum, cnt, mine, sp = 0u;
    for (;;) {
        sum = 0u; cnt = 0u; mine = 0u;
#pragma unroll
        for (unsigned j = 0; j < 16; ++j) { const unsigned c = xb_ld(&bar[XB_XCNT(j)]); sum += c; cnt += (c > 0u) ? 1u : 0u; mine = (j == x) ? c : mine; }
        if (sum == G) break;
        __builtin_amdgcn_s_sleep(1);
        if ((++sp & 255u) == 0u) { if (xb_ld(&bar[XB_TMO])) break; if (sp > XB_SPIN_CAP) { xb_add(&bar[XB_TMO], 1u); break; } }
    }
    nloc = mine > 0u ? mine : 1u; nx = cnt > 0u ? cnt : 1u;
}
__device__ __forceinline__ void xcd_barrier(const XcdBarrier& b) {
    asm volatile("s_waitcnt vmcnt(0)" ::: "memory");
    __syncthreads();
    if (threadIdx.x == 0) {
        unsigned* bar = b.bar;
        __builtin_amdgcn_s_waitcnt(0);
        unsigned nloc = b.st[0], nx = b.st[1]; const unsigned bx = b.st[2];
        if (nloc == 0u) { xcd_barrier_complete(bar, bx, nloc, nx); b.st[0] = nloc; b.st[1] = nx; }
        const unsigned old = xb_add(&bar[XB_XSUB(bx)], 1u);
        const unsigned gen = old / nloc;
        if (old + 1u == (gen + 1u) * nloc) {
            __builtin_amdgcn_fence(__ATOMIC_RELEASE, "agent");
            asm volatile("s_waitcnt vmcnt(0)" ::: "memory");
            const unsigned og = xb_add(&bar[XB_TOP], 1u);
            const unsigned tg = og / nx;
            if (og + 1u == (tg + 1u) * nx) xb_add(&bar[XB_TOPGEN], 1u);
            else XB_SPIN(xb_ld(&bar[XB_TOPGEN]) == tg, bar);
            __builtin_amdgcn_fence(__ATOMIC_ACQUIRE, "agent");
            xb_add(&bar[XB_XGEN(bx)], 1u);
            asm volatile("s_waitcnt vmcnt(0)" ::: "memory");
        } else {
            XB_SPIN(xb_ld(&bar[XB_XGEN(bx)]) == gen, bar);
            __builtin_amdgcn_fence(__ATOMIC_ACQUIRE, "agent");
            asm volatile("s_waitcnt vmcnt(0)" ::: "memory");
        }
    }
    __syncthreads();
}

extern __shared__ __attribute__((aligned(16))) unsigned char smem_raw[];
#define SMEM ((LAS unsigned char*)smem_raw)
constexpr int LDS_ST = 0;
constexpr int LDS_MISC = 16;
constexpr int LDS_MAIN = 1040;
constexpr int LDS_BYTES = 160 * 1024;
constexpr int GT_STAGE = 32768, TILE_LD = 132;
__device__ __forceinline__ int swz_off(int r, int c8) { return r * 128 + ((c8 ^ (r & 7)) << 4); }
template <int NSEG> struct GemmArgs { const bf16_t *A0, *A1, *A2, *B0, *B1, *B2; int lda, ldb, K; };

template <int NSEG, bool NTA = false>
__device__ __forceinline__ void gemm_mainloop(const GemmArgs<NSEG>& g, long arow0, long arow1) {
  const int tid = opaque_tid(), lane = tid & 63, wid = __builtin_amdgcn_readfirstlane(tid >> 6), wr = wid >> 2, wc = wid & 3, fr = lane & 15, fq = lane >> 4;
  const int r0 = tid >> 3, cs = ((tid & 7) ^ (r0 & 7)) * 8;
  const int nk = g.K >> 6, nsteps = NSEG * nk;
  f32x4 acc[4][2];
#pragma unroll
  for (int m = 0; m < 4; ++m)
#pragma unroll
    for (int n = 0; n < 2; ++n) acc[m][n] = (f32x4){0.f, 0.f, 0.f, 0.f};
  LAS unsigned char* ring = SMEM + LDS_MAIN;
#define GM_ISSUE(s_) do { int s1_ = (s_) < nsteps ? (s_) : nsteps - 1; int seg_ = 0, ks_ = s1_; if (NSEG > 1) { seg_ = s1_ / nk; ks_ = s1_ - seg_ * nk; } \
    const bf16_t* Ap_ = g.A0; const bf16_t* Bp_ = g.B0; if (NSEG > 1) { if (seg_ == 1) { Ap_ = g.A1; Bp_ = g.B1; } else if (seg_ == 2) { Ap_ = g.A2; Bp_ = g.B2; } } \
    LAS unsigned char* st_ = ring + ((s_) & 3) * GT_STAGE + wid * 1024; const int k0_ = ks_ * 64 + cs; \
    if (NTA) { __builtin_amdgcn_global_load_lds((const unsigned*)(Ap_ + arow0 * g.lda + k0_), (LAS unsigned*)st_, 16, 0, 2); __builtin_amdgcn_global_load_lds((const unsigned*)(Ap_ + arow1 * g.lda + k0_), (LAS unsigned*)(st_ + 8192), 16, 0, 2); } \
    else { __builtin_amdgcn_global_load_lds((const unsigned*)(Ap_ + arow0 * g.lda + k0_), (LAS unsigned*)st_, 16, 0, 0); __builtin_amdgcn_global_load_lds((const unsigned*)(Ap_ + arow1 * g.lda + k0_), (LAS unsigned*)(st_ + 8192), 16, 0, 0); } \
    __builtin_amdgcn_global_load_lds((const unsigned*)(Bp_ + (long)r0 * g.ldb + k0_), (LAS unsigned*)(st_ + 16384), 16, 0, 0); \
    __builtin_amdgcn_global_load_lds((const unsigned*)(Bp_ + (long)(r0 + 64) * g.ldb + k0_), (LAS unsigned*)(st_ + 16384 + 8192), 16, 0, 0); } while (0)
  asm volatile("s_waitcnt vmcnt(0)" ::: "memory");
  GM_ISSUE(0); GM_ISSUE(1); GM_ISSUE(2);
#pragma unroll 1
  for (int s = 0; s < nsteps; ++s) {
    asm volatile("s_waitcnt vmcnt(8)" ::: "memory");
    asm volatile("s_waitcnt lgkmcnt(0)" ::: "memory");
    __builtin_amdgcn_s_barrier();
    GM_ISSUE(s + 3);
    LAS unsigned char* sa = ring + (s & 3) * GT_STAGE;
    LAS unsigned char* sb = sa + 16384;
#pragma unroll
    for (int kk = 0; kk < 2; ++kk) {
      bf16x8 af[4], bfr[2];
#pragma unroll
      for (int m = 0; m < 4; ++m) af[m] = *(LAS bf16x8*)(sa + swz_off(wr * 64 + m * 16 + fr, kk * 4 + fq));
#pragma unroll
      for (int n = 0; n < 2; ++n) bfr[n] = *(LAS bf16x8*)(sb + swz_off(wc * 32 + n * 16 + fr, kk * 4 + fq));
#pragma unroll
      for (int m = 0; m < 4; ++m)
#pragma unroll
        for (int n = 0; n < 2; ++n) acc[m][n] = __builtin_amdgcn_mfma_f32_16x16x32_bf16(af[m], bfr[n], acc[m][n], 0, 0, 0);
    }
  }
#undef GM_ISSUE
  asm volatile("s_waitcnt vmcnt(0)" ::: "memory");
  asm volatile("s_waitcnt lgkmcnt(0)" ::: "memory");
  __builtin_amdgcn_s_barrier();
  LAS float* tile = (LAS float*)(SMEM + LDS_MAIN);
#pragma unroll
  for (int m = 0; m < 4; ++m)
#pragma unroll
    for (int n = 0; n < 2; ++n)
#pragma unroll
      for (int j = 0; j < 4; ++j) tile[(wr * 64 + m * 16 + fq * 4 + j) * TILE_LD + wc * 32 + n * 16 + fr] = acc[m][n][j];
  __syncthreads();
}
template <int NSEG, class Epi>
__device__ __forceinline__ void gemm_tile(const GemmArgs<NSEG>& g, long arow0, long arow1, Epi&& epi) {
  gemm_mainloop<NSEG>(g, arow0, arow1);
  LAS const float* tile = (LAS const float*)(SMEM + LDS_MAIN);
  const int tid = opaque_tid();
#pragma unroll 1
  for (int i = 0; i < 4; ++i) { const int id = tid + i * NTHR; epi(tile, id >> 4, (id & 15) * 8); }
  __syncthreads();
}
__device__ __forceinline__ u32x4 pack8(LAS const float* p) {
  const f32x4 v0 = *(LAS const f32x4*)p, v1 = *(LAS const f32x4*)(p + 4);
  u32x4 w; w.x = pk2(v0[0], v0[1]); w.y = pk2(v0[2], v0[3]); w.z = pk2(v1[0], v1[1]); w.w = pk2(v1[2], v1[3]); return w;
}

__device__ __forceinline__ int win_rowmap(int n) {
  if (n < 2048) return n;
  if (n < 2056) return 3136 + (n - 2048);
  if (n < 2568) return 2048 + (n - 2056);
  if (n < 2696) return 2560 + (n - 2568);
  if (n < 2824) return 2688 + (n - 2696);
  if (n < 3080) return 2816 + (n - 2824);
  if (n < 3144) return 3072 + (n - 3080);
  return n;
}
template <int KIND, int MODE>
__device__ __forceinline__ void cvt_tile(const float* src, int ld_src, int nvalid, int k0, int n0, bf16_t* dst, int ld_dst) {
  LAS bf16_t* tt = (LAS bf16_t*)(SMEM + LDS_MAIN);
  const int tid = opaque_tid();
  {
    const int n = tid & 63, kb = tid >> 6;
    const bool ok = (n0 + n) < nvalid;
#pragma unroll
    for (int i = 0; i < 8; ++i) {
      const int k = kb + 8 * i;
      float v = ok ? src[(long)(k0 + k) * ld_src + n0 + n] : 0.f;
      unsigned h = f2bf(v);
      if (MODE == 1) h = f2bf(v - bf2f(h));
      tt[n * 72 + k] = (bf16_t)h;
    }
  }
  __syncthreads();
  {
    const int n = tid >> 3, kc = tid & 7; const int nn = n0 + n;
    int r;
    if (KIND == 0) r = nn; else if (KIND == 1) r = win_rowmap(nn); else if (KIND == 2) r = (nn >> 2) * 8 + (nn & 3); else r = (nn >> 2) * 8 + 4 + (nn & 3);
    const u32x4 v = *(LAS const u32x4*)(tt + n * 72 + kc * 8);
    *(u32x4*)(dst + (long)r * ld_dst + k0 + kc * 8) = v;
  }
  __syncthreads();
}
template <int KIND>
__device__ __forceinline__ void cvt_tile8(const float* src, int ld_src, int k0, int n0, unsigned char* dst, int ld_dst, float scale) {
  LAS unsigned char* tt = SMEM + LDS_MAIN;
  const int tid = opaque_tid();
  {
    const int n = tid & 63, kb = tid >> 6;
#pragma unroll
    for (int i = 0; i < 4; ++i) {
      const int k = kb * 2 + 16 * i;
      const float v0 = __builtin_amdgcn_fmed3f(src[(long)(k0 + k) * ld_src + n0 + n] * scale, -448.f, 448.f), v1 = __builtin_amdgcn_fmed3f(src[(long)(k0 + k + 1) * ld_src + n0 + n] * scale, -448.f, 448.f);
      v2i16_t wq = {0, 0}; wq = __builtin_amdgcn_cvt_scalef32_pk_fp8_f32(wq, v0, v1, 1.0f, false); const int w = __builtin_bit_cast(int, wq);
      *(LAS unsigned short*)(tt + n * 80 + k) = (unsigned short)(w & 0xffff);
    }
  }
  __syncthreads();
  if (tid < 256) {
    const int n = tid >> 2, kc = tid & 3; const int nn = n0 + n;
    int r;
    if (KIND == 0) r = nn; else if (KIND == 2) r = (nn >> 2) * 8 + (nn & 3); else r = (nn >> 2) * 8 + 4 + (nn & 3);
    const u32x4 v = *(LAS const u32x4*)(tt + n * 80 + kc * 16);
    *(u32x4*)(dst + (long)r * ld_dst + k0 + kc * 16) = v;
  }
  __syncthreads();
}
__device__ __forceinline__ void sincos_d(double a, float& s, float& c) {
  const double twopi = 6.283185307179586476925286766559, inv = 0.15915494309189533576888376337251;
  const double k = __builtin_rint(a * inv);
  const double r = a - k * twopi;
  const double r2 = r * r;
  double ts = 1.0, tc = 1.0, ss = 1.0, cs = 1.0;
#pragma unroll
  for (int i = 1; i <= 13; ++i) { tc = -tc * r2 / (double)((2 * i - 1) * (2 * i)); cs += tc; ts = -ts * r2 / (double)((2 * i) * (2 * i + 1)); ss += ts; }
  s = (float)(r * ss); c = (float)cs;
}
__device__ __forceinline__ void phase0(const Params& p) {
  unsigned char* ws = p.ws;
  const int tid = opaque_tid();
  constexpr int U_WIN = 16 * 52, U_WOUT = 256, U_EG = 65 * 64, U_EU = 65 * 64, U_ED = 65 * 64, U_R = 64, U_ADA = 48, U_ROPE = 192;
  constexpr int B1 = U_WIN, B2 = B1 + U_WOUT, B3 = B2 + U_EG, B4 = B3 + U_EU, B5 = B4 + U_ED, B6 = B5 + U_R, B7 = B6 + U_ADA, B8 = B7 + U_ROPE;
  for (int u = blockIdx.x; u < B8; u += gridDim.x) {
    if (u < B1) { const int kt = u / 52, nt = u % 52; cvt_tile<1, 0>(p.w_in, 3148, 3148, kt * 64, nt * 64, (bf16_t*)(ws + OFF_WIN), 1024); }
    else if (u < B2) { const int v = u - B1, kt = v >> 4, nt = v & 15; cvt_tile<0, 0>(p.w_out, 1024, 1024, kt * 64, nt * 64, (bf16_t*)(ws + OFF_WOUT), 1024); }
    else if (u < B4) {
      const bool up = u >= B3; const int v = up ? u - B3 : u - B2; const int e = v >> 6, kt = (v >> 2) & 15, nt = v & 3;
      const float* src = (e < 64) ? ((up ? p.w_exp_up : p.w_exp_gate) + (size_t)e * 1024 * 256) : (up ? p.w_sh_up : p.w_sh_gate);
      unsigned char* dst = ws + OFF_WGU + (size_t)e * 512 * 1024;
      if (up) cvt_tile8<3>(src, 256, kt * 64, nt * 64, dst, 1024, 32.0f); else cvt_tile8<2>(src, 256, kt * 64, nt * 64, dst, 1024, 32.0f);
    }
    else if (u < B5) {
      const int v = u - B4; const int e = v >> 6, kt = (v >> 4) & 3, nt = v & 15;
      const float* src = (e < 64) ? (p.w_exp_down + (size_t)e * 256 * 1024) : p.w_sh_down;
      cvt_tile8<0>(src, 1024, kt * 64, nt * 64, ws + OFF_WDN + (size_t)e * 1024 * 256, 256, 16.0f);
    }
    else if (u < B6) {
      const int v = u - B5; const int lo = v >> 5, kt = (v >> 1) & 15, nt = v & 1;
      bf16_t* dst = (bf16_t*)(ws + OFF_WR) + (size_t)lo * 128 * 1024;
      if (lo) cvt_tile<0, 1>(p.w_router, 64, 64, kt * 64, nt * 64, dst, 1024); else cvt_tile<0, 0>(p.w_router, 64, 64, kt * 64, nt * 64, dst, 1024);
    }
    else if (u < B7) {
      const int v = u - B6;
      LAS float* sc = (LAS float*)(SMEM + LDS_MAIN);
      LAS float* part = sc + 16 * 1024;
      for (int i = tid; i < 16 * 1024; i += NTHR) sc[i] = siluf_(p.c[i]);
      __syncthreads();
      const int jl = tid & 127, dq = tid >> 7, j = v * 128 + jl;
      float acc[16];
#pragma unroll
      for (int b = 0; b < 16; ++b) acc[b] = 0.f;
      const float* wp = p.w_ada + (size_t)(dq * 256) * 6144 + j;
#pragma unroll 4
      for (int d = 0; d < 256; ++d) {
        const float w = wp[(size_t)d * 6144];
#pragma unroll
        for (int b = 0; b < 16; ++b) acc[b] += sc[b * 1024 + dq * 256 + d] * w;
      }
#pragma unroll
      for (int b = 0; b < 16; ++b) part[(dq * 16 + b) * 128 + jl] = acc[b];
      __syncthreads();
      float* mod = (float*)(ws + OFF_MOD);
      for (int i = tid; i < 16 * 128; i += NTHR) {
        const int b = i >> 7, jj = i & 127;
        mod[b * 6144 + v * 128 + jj] = ((part[(0 * 16 + b) * 128 + jj] + part[(1 * 16 + b) * 128 + jj]) + (part[(2 * 16 + b) * 128 + jj] + part[(3 * 16 + b) * 128 + jj])) + p.b_ada[v * 128 + jj];
      }
      __syncthreads();
    }
    else {
      const int v = u - B7; const int idx = v * NTHR + tid;
      const int pos = idx / 24, f = idx - pos * 24;
      const double lt = 13.122363377404328;
      float s, c;
      if (f < 16) { const double inv = exp(-lt * (double)f * (2.0 / 32.0)); sincos_d((double)pos * inv, s, c);
        float* R = (float*)(ws + OFF_ROPE); R[(pos * 16 + f) * 2] = c; R[(pos * 16 + f) * 2 + 1] = s; }
      else { const int g = f - 16; const double inv = exp(-lt * (double)g * (2.0 / 16.0)); sincos_d((double)pos * inv, s, c);
        float* R = (float*)(ws + OFF_ROPE) + 4096 * 32; R[(pos * 8 + g) * 2] = c; R[(pos * 8 + g) * 2 + 1] = s; }
    }
  }
}
namespace pg8 {
constexpr int BM = 256, BK = 64, HALF = 128, HTB = HALF * BK * 2, STAGE_BYTES = 8 * HTB;
__device__ __forceinline__ int lds_byte(int r, int c) { const int st = (r >> 4) * 2 + (c >> 5), rr = r & 15, cc = c & 31, ob = rr * 64 + cc * 2; return st * 1024 + (ob ^ (((ob >> 9) & 1) << 5)); }
__device__ __forceinline__ void stage_rc(int b, int& R, int& C) { const int st = b / 1024, sb = b % 1024, swz = sb ^ (((sb >> 9) & 1) << 5); R = (st >> 1) * 16 + swz / 64; C = (st & 1) * 32 + (swz % 64) / 2; }
__device__ __forceinline__ int perm32(int rho) { const int n = rho >> 4, i = rho & 15; return 8 * (i >> 2) + 4 * n + (i & 3); }
struct Unit { int pm, pn, e, lt; };
typedef int v8i_t __attribute__((ext_vector_type(8)));
typedef int v4i_t __attribute__((ext_vector_type(4)));
template <class Epi, class Sched, bool FP8 = false, int WI = 0>
__device__ __forceinline__ void gemm_phase(LAS unsigned char* lds, const bf16_t* Abase, const int K, const Sched& S, const Epi& E) {
    const int tid = opaque_tid(), wid = __builtin_amdgcn_readfirstlane(tid >> 6), lane = tid & 63, wr = wid >> 2, wc = wid & 3, fr = lane & 15, fq = lane >> 4;
    const int nt = K / BK;
    int Rr[2], Cc[2]; unsigned voffB[2];
#pragma unroll
    for (int i = 0; i < 2; ++i) { int R, C; stage_rc(tid * 16 + i * 8192, R, C); Rr[i] = R; Cc[i] = C * 2; const int Rb = (R & ~31) + perm32(R & 31); voffB[i] = (unsigned)(Rb * K + C) * 2u; }
    const size_t kstep = (size_t)(BK * 2);
    const size_t hstep = (size_t)HALF * K * 2;
    const unsigned ldsw = (unsigned)wid * 1024u;
    const int aoff = lds_byte(wr * 64 + fr, fq * 8), boff = lds_byte(wc * 32 + fr, fq * 8);
    const char* Ab = (const char*)Abase;
    LAS unsigned char* recb = lds + STAGE_BYTES;
#define PG8_RECISSUE(u_, slot_) do { if (Sched::REC) __builtin_amdgcn_global_load_lds((const unsigned*)(S.rec_ptr(u_) + tid * 4), (LAS unsigned*)(recb + (slot_) * 2048 + wid * 256), 4, 0, 0); } while (0)
#define PG8_AOFF(u_, slot_, row_) ((Sched::REC && S.has_rec(u_)) ? S.a_off_idx(u_, row_, *(const LAS int*)(recb + (slot_) * 2048 + (S.row_valid(u_, row_) ? (row_) : 0) * 8)) : S.a_off(u_, row_))
#define PG8_SA(b, h) (((b) * 2 + (h)) * HTB)
#define PG8_SB(b, h) ((4 + (b) * 2 + (h)) * HTB)
#define PG8_STAGEB(bufoff, gbase) do { if (!(WI & 2)) _Pragma("unroll") for (int _i = 0; _i < 2; ++_i) \
        __builtin_amdgcn_global_load_lds((const unsigned*)((const char*)(gbase) + voffB[_i]), (LAS unsigned*)(lds + (bufoff) + ldsw + _i * 8192), 16, 0, 0); } while (0)
#define PG8_STAGEA(bufoff, koff, o0, o1) do { if (!(WI & 1)) { \
        __builtin_amdgcn_global_load_lds((const unsigned*)(Ab + (koff) + (o0)), (LAS unsigned*)(lds + (bufoff) + ldsw), 16, 0, 0); \
        __builtin_amdgcn_global_load_lds((const unsigned*)(Ab + (koff) + (o1)), (LAS unsigned*)(lds + (bufoff) + ldsw + 8192), 16, 0, 0); } } while (0)
#define PG8_LDA(dst, b, h) do { if (!(WI & 8)) _Pragma("unroll") for (int m = 0; m < 4; ++m) { dst[m].lo = *(const LAS v4i_t*)(lds + PG8_SA(b, h) + aoff + m * 2048); dst[m].hi = *(const LAS v4i_t*)(lds + PG8_SA(b, h) + aoff + m * 2048 + 1024); } } while (0)
#define PG8_LDB(dst, b, h) do { if (!(WI & 8)) _Pragma("unroll") for (int n = 0; n < 2; ++n) { dst[n].lo = *(const LAS v4i_t*)(lds + PG8_SB(b, h) + boff + n * 2048); dst[n].hi = *(const LAS v4i_t*)(lds + PG8_SB(b, h) + boff + n * 2048 + 1024); } } while (0)
#define PG8_MMA(ai, bj, At, Bt) do { __builtin_amdgcn_s_setprio(1); if (!(WI & 16)) _Pragma("unroll") for (int m = 0; m < 4; ++m) _Pragma("unroll") for (int n = 0; n < 2; ++n) { \
        if (FP8) asm volatile("v_mfma_scale_f32_16x16x128_f8f6f4 %0, %1, %2, %0, %3, %4 op_sel_hi:[0,0,0]" : "+v"(acc[ai][bj][m][n]) : "v"(Bt[n]), "v"(At[m]), "v"(sclB), "v"(sclA)); \
        else { const v4i_t bl_ = Bt[n].lo, bh_ = Bt[n].hi, al_ = At[m].lo, ah_ = At[m].hi;     \
               acc[ai][bj][m][n] = __builtin_amdgcn_mfma_f32_16x16x32_bf16(__builtin_bit_cast(bf16x8, bl_), __builtin_bit_cast(bf16x8, al_), acc[ai][bj][m][n], 0, 0, 0); \
               acc[ai][bj][m][n] = __builtin_amdgcn_mfma_f32_16x16x32_bf16(__builtin_bit_cast(bf16x8, bh_), __builtin_bit_cast(bf16x8, ah_), acc[ai][bj][m][n], 0, 0, 0); } } \
        __builtin_amdgcn_s_setprio(0); } while (0)
#define PG8_WAIT_V(n) asm volatile("s_waitcnt vmcnt(" #n ")" ::: "memory")
#define PG8_WAIT_VF(f) do { if (Sched::BSTAT && (f)) asm volatile("s_waitcnt vmcnt(4)" ::: "memory"); else asm volatile("s_waitcnt vmcnt(8)" ::: "memory"); } while (0)
#define PG8_WAIT_VG(f) do { if (Sched::BSTAT && (f)) asm volatile("s_waitcnt vmcnt(5)" ::: "memory"); else asm volatile("s_waitcnt vmcnt(8)" ::: "memory"); } while (0)
#define PG8_WAIT_L(n) asm volatile("s_waitcnt lgkmcnt(" #n ")" ::: "memory")
#define PG8_BAR do { if (!(WI & 32)) __builtin_amdgcn_s_barrier(); } while (0)
#define PG8_SCHED __builtin_amdgcn_sched_barrier(0)
    Unit cur, nxt; int ui = 0;
    if (!S.next(0, cur)) return;
    f32x4 acc[2][2][4][2];
#pragma unroll
    for (int a = 0; a < 2; ++a)
#pragma unroll
        for (int b = 0; b < 2; ++b)
#pragma unroll
            for (int m = 0; m < 4; ++m)
#pragma unroll
                for (int n = 0; n < 2; ++n) acc[a][b][m][n] = (f32x4){0.f, 0.f, 0.f, 0.f};
    v8i_t At[4], B0[2], B1[2];
    if (WI & 8) { _Pragma("unroll") for (int m = 0; m < 4; ++m) At[m] = (v8i_t){tid, m, 3, 4, 5, 6, 7, 8}; B0[0] = B0[1] = B1[0] = B1[1] = (v8i_t){tid, 1, 2, 3, 4, 5, 6, 7}; }
    int sclA = Sched::SCALE_A, sclB = Sched::SCALE_B; asm volatile("" : "+v"(sclA), "+v"(sclB));
    const char* cB = S.b_base(cur);
    Unit nn; bool has_nn = false;
    if (Sched::REC) { has_nn = S.next(1, nn); PG8_RECISSUE(cur, 0); PG8_RECISSUE(has_nn ? nn : cur, 1); asm volatile("s_waitcnt vmcnt(0)" ::: "memory"); __syncthreads(); }
    unsigned vc00 = PG8_AOFF(cur, 0, Rr[0]) + Cc[0], vc01 = PG8_AOFF(cur, 0, Rr[1]) + Cc[1], vc10 = PG8_AOFF(cur, 0, HALF + Rr[0]) + Cc[0], vc11 = PG8_AOFF(cur, 0, HALF + Rr[1]) + Cc[1];
    int slot = 0; bool skp = false;
    PG8_STAGEB(PG8_SB(0, 0), cB); PG8_STAGEB(PG8_SB(0, 1), cB + hstep); PG8_STAGEA(PG8_SA(0, 0), 0, vc00, vc01); PG8_STAGEA(PG8_SA(0, 1), 0, vc10, vc11);
    if (wr == 1) PG8_BAR;
    PG8_WAIT_V(2); PG8_BAR;
    PG8_STAGEB(PG8_SB(1, 0), cB + kstep); PG8_STAGEA(PG8_SA(1, 0), kstep, vc00, vc01); PG8_STAGEB(PG8_SB(1, 1), cB + hstep + kstep);
    PG8_WAIT_V(6); PG8_BAR;
    for (;;) {
        bool has_next;
        if (Sched::REC) { has_next = has_nn; nxt = nn; has_nn = S.next(ui + 2, nn); } else has_next = S.next(ui + 1, nxt);
        const char* nB = has_next ? S.b_base(nxt) : cB;
        unsigned vn00 = vc00, vn01 = vc01, vn10 = vc10, vn11 = vc11;
        const int nslot = (slot + 1) & 3;
        if (Sched::REC) { PG8_RECISSUE(has_nn ? nn : cur, (slot + 2) & 3); }
        else if (has_next) { vn00 = S.a_off(nxt, Rr[0]) + Cc[0]; vn01 = S.a_off(nxt, Rr[1]) + Cc[1]; vn10 = S.a_off(nxt, HALF + Rr[0]) + Cc[0]; vn11 = S.a_off(nxt, HALF + Rr[1]) + Cc[1]; }
#pragma unroll 1
        for (int t = 0; t < nt; t += 2) {
            const bool last = (t == nt - 2);
            const bool skb = Sched::BSTAT && last && has_next && (nB == cB);
            const size_t ko1 = (size_t)(t + 1) * kstep;
            const size_t ko2 = last ? 0 : (size_t)(t + 2) * kstep, ko3 = ko2 + kstep;
            const char* b2 = last ? nB : cB + (size_t)(t + 2) * kstep; const char* b3 = b2 + kstep;
            if (Sched::REC && last && has_next) {
                if (S.has_rec(nxt)) {
                    const int nv = S.nvalid(nxt); LAS const unsigned char* rb = recb + nslot * 2048;
                    const int q00 = Rr[0] < nv ? Rr[0] : 0, q01 = Rr[1] < nv ? Rr[1] : 0, q10 = (HALF + Rr[0]) < nv ? (HALF + Rr[0]) : 0, q11 = (HALF + Rr[1]) < nv ? (HALF + Rr[1]) : 0;
                    const int i00 = *(LAS const int*)(rb + q00 * 8), i01 = *(LAS const int*)(rb + q01 * 8), i10 = *(LAS const int*)(rb + q10 * 8), i11 = *(LAS const int*)(rb + q11 * 8);
                    vn00 = S.a_off_idx(nxt, 0, i00) + Cc[0]; vn01 = S.a_off_idx(nxt, 0, i01) + Cc[1]; vn10 = S.a_off_idx(nxt, 0, i10) + Cc[0]; vn11 = S.a_off_idx(nxt, 0, i11) + Cc[1];
                } else { vn00 = S.a_off(nxt, Rr[0]) + Cc[0]; vn01 = S.a_off(nxt, Rr[1]) + Cc[1]; vn10 = S.a_off(nxt, HALF + Rr[0]) + Cc[0]; vn11 = S.a_off(nxt, HALF + Rr[1]) + Cc[1]; }
            }
            const unsigned o00 = last ? vn00 : vc00, o01 = last ? vn01 : vc01, o10 = last ? vn10 : vc10, o11 = last ? vn11 : vc11;
            PG8_LDB(B0, 0, 0); PG8_LDB(B1, 0, 1); PG8_SCHED; PG8_LDA(At, 0, 0); PG8_STAGEA(PG8_SA(1, 1), ko1, vc10, vc11);
            PG8_WAIT_VG(skp); PG8_WAIT_L(0); PG8_BAR; PG8_MMA(0, 0, At, B0); PG8_MMA(0, 1, At, B1); PG8_BAR; PG8_SCHED;
            PG8_LDA(At, 0, 1); if (!skb) { PG8_STAGEB(PG8_SB(0, 0), b2); PG8_STAGEB(PG8_SB(0, 1), b2 + hstep); } PG8_STAGEA(PG8_SA(0, 0), ko2, o00, o01);
            PG8_WAIT_VG(skb); PG8_WAIT_L(0); PG8_BAR; PG8_MMA(1, 0, At, B0); PG8_MMA(1, 1, At, B1); PG8_BAR; PG8_SCHED;
            PG8_LDB(B0, 1, 0); PG8_LDB(B1, 1, 1); PG8_SCHED; PG8_LDA(At, 1, 0); PG8_STAGEA(PG8_SA(0, 1), ko2, o10, o11);
            PG8_WAIT_VF(skb); PG8_WAIT_L(0); PG8_BAR; PG8_MMA(0, 0, At, B0); PG8_MMA(0, 1, At, B1); PG8_BAR; PG8_SCHED;
            PG8_LDA(At, 1, 1); if (!skb) { PG8_STAGEB(PG8_SB(1, 0), b3); PG8_STAGEB(PG8_SB(1, 1), b3 + hstep); } PG8_STAGEA(PG8_SA(1, 0), ko3, o00, o01);
            PG8_WAIT_VF(skb); PG8_WAIT_L(0);
            skp = skb; PG8_BAR; PG8_MMA(1, 0, At, B0); PG8_MMA(1, 1, At, B1); PG8_BAR; PG8_SCHED;
        }
        if (wr == 0) PG8_BAR;
        if (FP8) asm volatile("s_nop 15\n\ts_nop 15" ::: "memory");
        if (!(WI & 4)) E(acc, cur, wr, wc, fr, fq, (LAS const unsigned char*)(recb + slot * 2048));
        if (PROBE_DBL == 81 && FP8 && K == 128) E(acc, cur, wr, wc, fr, fq, (LAS const unsigned char*)(recb + slot * 2048));
        if (PROBE_DBL == 71 && FP8 && K == 512) E(acc, cur, wr, wc, fr, fq, (LAS const unsigned char*)(recb + slot * 2048));
        if (!has_next) break;
#pragma unroll
        for (int a = 0; a < 2; ++a)
#pragma unroll
            for (int b = 0; b < 2; ++b)
#pragma unroll
                for (int m = 0; m < 4; ++m)
#pragma unroll
                    for (int n = 0; n < 2; ++n) acc[a][b][m][n] = (f32x4){0.f, 0.f, 0.f, 0.f};
        cur = nxt; cB = nB; vc00 = vn00; vc01 = vn01; vc10 = vn10; vc11 = vn11; ++ui; slot = nslot;
        if (wr == 1) PG8_BAR;
    }
    PG8_WAIT_V(0);
    PG8_BAR;
#undef PG8_SA
#undef PG8_RECISSUE
#undef PG8_AOFF
#undef PG8_SB
#undef PG8_STAGEA
#undef PG8_STAGEB
#undef PG8_LDA
#undef PG8_LDB
#undef PG8_MMA
#undef PG8_WAIT_V
#undef PG8_WAIT_VF
#undef PG8_WAIT_VG
#undef PG8_WAIT_L
#undef PG8_BAR
#undef PG8_SCHED
}
struct DenseOrder {
    static constexpr bool REC = false, BSTAT = false; static constexpr int SCALE_A = 0, SCALE_B = 0;
    int nM, nN, nwg, G, c; const char* Bt; int K;
    __device__ __forceinline__ const char* rec_ptr(const Unit&) const { return nullptr; }
    __device__ __forceinline__ bool has_rec(const Unit&) const { return false; }
    __device__ __forceinline__ bool row_valid(const Unit&, int) const { return true; }
    __device__ __forceinline__ int nvalid(const Unit&) const { return 256; }
    __device__ __forceinline__ unsigned a_off_idx(const Unit&, int, int) const { return 0u; }
    __device__ void init(int M, int N, int K_, const bf16_t* Bt_, int G_, int c_) { nM = M / BM; nN = N / BM; nwg = nM * nN; G = G_; c = c_; Bt = (const char*)Bt_; K = K_; }
    __device__ __forceinline__ bool next(int i, Unit& u) const {
        const long L = (long)i * G + c; if (L >= nwg) return false;
        int wgid = (int)L; { const int q = nwg / 8, r = nwg % 8, xcd = wgid % 8, off = wgid / 8; wgid = (xcd < r ? xcd * (q + 1) : r * (q + 1) + (xcd - r) * q) + off; }
        const int nig = 8 * nN, gid = wgid / nig, fm = gid * 8, gsz = (nM - fm) < 8 ? (nM - fm) : 8;
        u.pm = fm + ((wgid % nig) % gsz); u.pn = (wgid % nig) / gsz; u.e = 0; u.lt = 0; return true;
    }
    __device__ __forceinline__ const char* b_base(const Unit& u) const { return Bt + (size_t)u.pn * BM * K * 2; }
    __device__ __forceinline__ unsigned a_off(const Unit& u, int row) const { return (unsigned)(u.pm * BM + row) * (unsigned)(K * 2); }
};
__device__ __forceinline__ unsigned cvt_pk_bf16(float lo, float hi) { return pk2(lo, hi); }
struct EpiStoreBf16 { bf16_t* O; int ldc;
    __device__ __forceinline__ void operator()(const f32x4 (&acc)[2][2][4][2], const Unit& u, int wr, int wc, int fr, int fq, LAS const unsigned char*) const {
        const int row0 = u.pm * BM + wr * 64 + fr, col0 = u.pn * BM + wc * 32 + 8 * fq;
#pragma unroll
        for (int ai = 0; ai < 2; ++ai)
#pragma unroll
            for (int m = 0; m < 4; ++m) { bf16_t* rowp = O + (size_t)(row0 + ai * HALF + m * 16) * ldc + col0;
#pragma unroll
                for (int bj = 0; bj < 2; ++bj) { const f32x4 v0 = acc[ai][bj][m][0], v1 = acc[ai][bj][m][1];
                    u32x4 w; w.x = pk2(v0[0], v0[1]); w.y = pk2(v0[2], v0[3]); w.z = pk2(v1[0], v1[1]); w.w = pk2(v1[2], v1[3]);
                    *(u32x4*)(rowp + bj * HALF) = w; } }
    } };
}
constexpr int LDS_PG8 = 2048;
__device__ __forceinline__ void phase1(const Params& p) {
  const int tid_ = opaque_tid(); const int lane = tid_ & 63, gw = blockIdx.x * 8 + (tid_ >> 6), nw = gridDim.x * 8;
  const float* mod = (const float*)(p.ws + OFF_MOD);
  bf16_t* H1 = (bf16_t*)(p.ws + OFF_ACTA);
  float4 g[4];
#pragma unroll
  for (int i = 0; i < 4; ++i) g[i] = *(const float4*)(p.g_mix_pre + (lane + 64 * i) * 4);
  float4 vn[4];
  if (gw < T_TOK) {
#pragma unroll
    for (int i = 0; i < 4; ++i) vn[i] = ((const float4*)(p.x + (size_t)gw * 1024))[lane + 64 * i];
  }
#pragma unroll 1
  for (int row = gw; row < T_TOK; row += nw) {
    float4 v[4]; float ss = 0.f;
#pragma unroll
    for (int i = 0; i < 4; ++i) { v[i] = vn[i]; ss += v[i].x * v[i].x + v[i].y * v[i].y + v[i].z * v[i].z + v[i].w * v[i].w; }
    { const int rn = (row + nw < T_TOK) ? row + nw : row;
#pragma unroll
      for (int i = 0; i < 4; ++i) vn[i] = ((const float4*)(p.x + (size_t)rn * 1024))[lane + 64 * i]; }
    ss = wave_sum(ss);
    const float rs = rsqrtf(ss * (1.0f / 1024.f) + EPS);
    const int b = row >> 12;
    const float* sh = mod + b * 6144; const float* sc = sh + 1024;
#pragma unroll
    for (int i = 0; i < 4; ++i) {
      const int c = (lane + 64 * i) * 4;
      const float4 s1 = *(const float4*)(sc + c), h1 = *(const float4*)(sh + c);
      u32x2 w;
      w.x = pk2(v[i].x * rs * g[i].x * (1.f + s1.x) + h1.x, v[i].y * rs * g[i].y * (1.f + s1.y) + h1.y);
      w.y = pk2(v[i].z * rs * g[i].z * (1.f + s1.z) + h1.z, v[i].w * rs * g[i].w * (1.f + s1.w) + h1.w);
      *(u32x2*)(H1 + (size_t)row * 1024 + c) = w;
    }
  }
}

struct EpiProj { bf16_t* O; float* OL;
  __device__ __forceinline__ void operator()(const f32x4 (&acc)[2][2][4][2], const pg8::Unit& u, int wr, int wc, int fr, int fq, LAS const unsigned char*) const {
    const int row0 = u.pm * 256 + wr * 64 + fr;
    if (u.pn < 12) {
      const int col0 = u.pn * 256 + wc * 32 + 8 * fq;
#pragma unroll
      for (int ai = 0; ai < 2; ++ai)
#pragma unroll
        for (int m = 0; m < 4; ++m) { bf16_t* rowp = O + (size_t)(row0 + ai * 128 + m * 16) * PLD + col0;
#pragma unroll
          for (int bj = 0; bj < 2; ++bj) { const f32x4 v0 = acc[ai][bj][m][0], v1 = acc[ai][bj][m][1];
            u32x4 w; w.x = pk2(v0[0], v0[1]); w.y = pk2(v0[2], v0[3]); w.z = pk2(v1[0], v1[1]); w.w = pk2(v1[2], v1[3]);
            *(u32x4*)(rowp + bj * 128) = w; } }
    } else {
      const int col0 = wc * 32 + 8 * fq;
#pragma unroll
      for (int ai = 0; ai < 2; ++ai)
#pragma unroll
        for (int m = 0; m < 4; ++m) { float* rowp = OL + (size_t)(row0 + ai * 128 + m * 16) * 128 + col0;
          *(f32x4*)rowp = acc[ai][0][m][0]; *(f32x4*)(rowp + 4) = acc[ai][0][m][1]; }
    }
  } };
__device__ __forceinline__ void phase2(const Params& p) {
  pg8::DenseOrder S; S.init(T_TOK, NPROJ, 1024, (const bf16_t*)(p.ws + OFF_WIN), gridDim.x, blockIdx.x);
  EpiProj E{(bf16_t*)(p.ws + OFF_PROJ), (float*)(p.ws + OFF_PROJL)};
  pg8::gemm_phase(SMEM + LDS_PG8, (const bf16_t*)(p.ws + OFF_ACTA), 1024, S, E);
}

__device__ __forceinline__ void unpack8(const u32x4 v, float (&o)[8]) { o[0] = bflo(v.x); o[1] = bfhi(v.x); o[2] = bflo(v.y); o[3] = bfhi(v.y); o[4] = bflo(v.z); o[5] = bfhi(v.z); o[6] = bflo(v.w); o[7] = bfhi(v.w); }
__device__ __forceinline__ u32x4 packf8(const float (&o)[8]) { u32x4 w; w.x = pk2(o[0], o[1]); w.y = pk2(o[2], o[3]); w.z = pk2(o[4], o[5]); w.w = pk2(o[6], o[7]); return w; }
__device__ __forceinline__ void rope8(float (&own)[8], const float (&oth)[8], bool first, const float* cs) {
#pragma unroll
  for (int i = 0; i < 8; ++i) { const float c = cs[2 * i], s = cs[2 * i + 1]; own[i] = first ? (own[i] * c - oth[i] * s) : (own[i] * c + oth[i] * s); }
}
__device__ __forceinline__ void phase2b(const Params& p) {
  const bf16_t* PROJ = (const bf16_t*)(p.ws + OFF_PROJ); const float* PL = (const float*)(p.ws + OFF_PROJL);
  bf16_t* dst = (bf16_t*)(p.ws + OFF_MQKC); bf16_t* AKR = (bf16_t*)(p.ws + OFF_AK); bf16_t* IK = (bf16_t*)(p.ws + OFF_IK);
  const float* R128 = (const float*)(p.ws + OFF_ROPE); const float* R64 = R128 + 4096 * 32;
  const unsigned gtid = blockIdx.x * NTHR + opaque_tid(), gstride = gridDim.x * NTHR;
  for (unsigned id = gtid; id < (unsigned)(T_TOK / 8) * 128u; id += gstride) {
    const size_t tok0 = (size_t)(id >> 7) * 8; const int c0 = (int)(id & 127u) * 8; const int pos0 = (int)(tok0 & 4095);
    u32x4 raw[11];
#pragma unroll
    for (int r = 0; r < 11; ++r) raw[r] = (pos0 + r - 3 >= 0) ? *(const u32x4*)(PROJ + (tok0 + r - 3) * PLD + c0) : (u32x4){0u, 0u, 0u, 0u};
    float w[4][8], bias[8];
#pragma unroll
    for (int j = 0; j < 4; ++j) { const float4 w0 = *(const float4*)(p.conv_w + j * 1024 + c0), w1 = *(const float4*)(p.conv_w + j * 1024 + c0 + 4);
      w[j][0] = w0.x; w[j][1] = w0.y; w[j][2] = w0.z; w[j][3] = w0.w; w[j][4] = w1.x; w[j][5] = w1.y; w[j][6] = w1.z; w[j][7] = w1.w; }
    { const float4 b0 = *(const float4*)(p.conv_b + c0), b1 = *(const float4*)(p.conv_b + c0 + 4);
      bias[0] = b0.x; bias[1] = b0.y; bias[2] = b0.z; bias[3] = b0.w; bias[4] = b1.x; bias[5] = b1.y; bias[6] = b1.z; bias[7] = b1.w; }
    const float sc = (c0 >= 512) ? 0.08838834764831845f : 1.0f;
#pragma unroll
    for (int t = 0; t < 8; ++t) {
      float acc[8];
#pragma unroll
      for (int i = 0; i < 8; ++i) acc[i] = bias[i];
#pragma unroll
      for (int j = 0; j < 4; ++j) { float v[8]; unpack8(raw[t + j], v);
#pragma unroll
        for (int i = 0; i < 8; ++i) acc[i] += v[i] * w[j][i]; }
#pragma unroll
      for (int i = 0; i < 8; ++i) acc[i] = acc[i] * __builtin_amdgcn_rcpf(1.0f + __expf(-acc[i])) * sc;
      *(u32x4*)(dst + (tok0 + t) * 1024 + c0) = packf8(acc);
    }
  }
  for (unsigned id = gtid; id < (unsigned)T_TOK * 16u; id += gstride) {
    const size_t tok = id >> 4; const int c0 = (int)(id & 15u) * 8; const int pos = (int)(tok & 4095);
    float own[8]; unpack8(*(const u32x4*)(PROJ + tok * PLD + 2560 + c0), own);
    if (c0 < 32) { float oth[8]; unpack8(*(const u32x4*)(PROJ + tok * PLD + 2560 + (c0 ^ 16)), oth); rope8(own, oth, c0 < 16, R128 + (size_t)pos * 32 + (c0 & 15) * 2); }
    *(u32x4*)(AKR + tok * 128 + c0) = packf8(own);
  }
  {
    const int tid_ = opaque_tid(); const int lane = tid_ & 63, gwv = blockIdx.x * 8 + (tid_ >> 6), nwv = gridDim.x * 8;
    const float gk = p.g_idx_k[lane], bk = p.b_idx_k[lane];
    for (int tok = gwv; tok < T_TOK; tok += nwv) {
      const int pos = tok & 4095;
      const float* tr = PL + (size_t)tok * 128;
      const float v = tr[lane];
      const float mu = wave_sum(v) * (1.f / 64.f);
      const float d = v - mu;
      const float var = wave_sum(d * d) * (1.f / 64.f);
      float y = d * rsqrtf(var + EPS) * gk + bk;
      const float yo = __shfl_xor(y, 8);
      if (lane < 16) { const float cs = R64[(size_t)pos * 16 + (lane & 7) * 2], sn = R64[(size_t)pos * 16 + (lane & 7) * 2 + 1]; y = (lane < 8) ? (y * cs - yo * sn) : (y * cs + yo * sn); }
      const float yn = __shfl_down(y, 1);
      if ((lane & 1) == 0) *(unsigned*)(IK + (size_t)tok * 64 + lane) = pk2(y, yn);
      if (lane < 8) ((float*)(p.ws + OFF_GATES))[(size_t)tok * 8 + lane] = tr[64 + lane] + ((lane < 4) ? p.b_igate[lane] : p.b_fgate[lane - 4]);
      else if (lane < 12) ((float*)(p.ws + OFF_IW))[(size_t)tok * 4 + (lane - 8)] = tr[72 + (lane - 8)] * 0.0625f;
    }
  }
  {
    const int tid_ = opaque_tid(); const int lane = tid_ & 63, gwv = blockIdx.x * 8 + (tid_ >> 6), nwv = gridDim.x * 8;
    float* GLb = (float*)(p.ws + OFF_GL); float* GLa = GLb + 64 * 4096; float* GLm = GLa + 64 * 4096; float* SEG = GLm + 64 * 4096;
    for (int item = gwv; item < 512; item += nwv) {
      const int bh = item >> 3, seg = item & 7, b = bh >> 2, h = bh & 3;
      const float bi = p.b_igate[h], bfg = p.b_fgate[h];
      float bl = 0.f, ml = -1e30f;
      for (int c = 0; c < 8; ++c) {
        const int ts = seg * 512 + c * 64 + lane; const size_t tok = (size_t)b * 4096 + ts;
        const float ig = PL[tok * 128 + 64 + h] + bi, fg = PL[tok * 128 + 68 + h] + bfg;
        const float lf = fminf(fg, 0.f) - log1pf(expf(-fabsf(fg)));
        float cs = lf;
#pragma unroll
        for (int off = 1; off < 64; off <<= 1) { const float t = __shfl_up(cs, off); if (lane >= off) cs += t; }
        const float bloc = bl + cs, aloc = ig - bloc;
        float mx = aloc;
#pragma unroll
        for (int off = 1; off < 64; off <<= 1) { const float t = __shfl_up(mx, off); if (lane >= off) mx = fmaxf(mx, t); }
        const float mloc = fmaxf(ml, mx);
        GLb[bh * 4096 + ts] = bloc; GLa[bh * 4096 + ts] = aloc; GLm[bh * 4096 + ts] = mloc;
        bl = __shfl(bloc, 63); ml = __shfl(mloc, 63);
      }
      if (lane == 0) { SEG[(bh * 8 + seg) * 2] = bl; SEG[(bh * 8 + seg) * 2 + 1] = ml; }
    }
  }
}
namespace ml {
constexpr int QS = 0, KS = 17408, VS = 34816, VWS = 54272, PS = 73728, CB = 82944, SEGT = 122112, GA = 122624;
constexpr int QLD = 136, VLD = 152, TLD = 72;
}
__device__ __forceinline__ bf16x8 ml_tr(LAS const bf16_t* p0, int rowstride) {
  const v4i16_t a = __builtin_amdgcn_ds_read_tr16_b64_v4i16((LAS v4i16_t*)p0), b = __builtin_amdgcn_ds_read_tr16_b64_v4i16((LAS v4i16_t*)(p0 + 4 * rowstride));
  bf16x8 r; r[0] = a[0]; r[1] = a[1]; r[2] = a[2]; r[3] = a[3]; r[4] = b[0]; r[5] = b[1]; r[6] = b[2]; r[7] = b[3]; return r;
}
__device__ __forceinline__ void mlstm_item(const Params& p, int id) {
  using namespace ml;
  const int tid = opaque_tid(), lane = tid & 63, w = tid >> 6, fr = lane & 15, fq = lane >> 4;
  const int b = id >> 2, h = id & 3;
  const size_t tok0 = (size_t)b * 4096;
  LAS unsigned char* L = SMEM + LDS_MAIN;
  LAS bf16_t* Qs = (LAS bf16_t*)(L + QS); LAS bf16_t* Ks = (LAS bf16_t*)(L + KS); LAS bf16_t* Vs = (LAS bf16_t*)(L + VS); LAS bf16_t* VWs = (LAS bf16_t*)(L + VWS);
  LAS bf16_t* Ps = (LAS bf16_t*)(L + PS); LAS bf16_t* Cb = (LAS bf16_t*)(L + CB);
  LAS float* segt = (LAS float*)(L + SEGT); LAS float* gab = (LAS float*)(L + GA);
  const float* GLb = (const float*)(p.ws + OFF_GL) + (size_t)(b * 4 + h) * 4096; const float* GLa = GLb + 64 * 4096; const float* GLm = GLa + 64 * 4096; const float* SEG = (const float*)(p.ws + OFF_GL) + 3 * 64 * 4096 + (b * 4 + h) * 16;
  const bf16_t* MQKC = (const bf16_t*)(p.ws + OFF_MQKC); const bf16_t* MV = (const bf16_t*)(p.ws + OFF_PROJ) + 1024 + h * 128; const bf16_t* MO = (const bf16_t*)(p.ws + OFF_PROJ) + 1536 + h * 128;
  bf16_t* A2 = (bf16_t*)(p.ws + OFF_ACTA) + h * 128;

  f32x4 Cacc[2][9];
#pragma unroll
  for (int i = 0; i < 2; ++i)
#pragma unroll
    for (int j = 0; j < 9; ++j) Cacc[i][j] = (f32x4){0.f, 0.f, 0.f, 0.f};
  for (int i = tid; i < 144 * QLD; i += NTHR) Cb[i] = 0;
  for (int i = tid; i < 64 * VLD; i += NTHR) { const int col = i % VLD; Vs[i] = (col == 128) ? (bf16_t)0x3F80 : (bf16_t)0; VWs[i] = 0; }
  if (tid == 0) { float bo = 0.f, mp = -1e30f; for (int k = 0; k < 8; ++k) { segt[2 * k] = bo; segt[2 * k + 1] = mp; mp = fmaxf(mp, SEG[2 * k + 1] - bo); bo += SEG[2 * k]; } }
  u32x4 q0, q1, k0, k1, v0, v1; float ga0 = 0.f, ga1 = 0.f, gb = 0.f, gm = 0.f, gme = 0.f, gmp = 0.f;
  const int srow = tid >> 4, scc = tid & 15;
  const int gs = tid & 63;
  auto gload = [&](int c) {
    const size_t t0 = tok0 + (size_t)c * 64;
    q0 = *(const u32x4*)(MQKC + (t0 + srow) * 1024 + h * 128 + scc * 8); q1 = *(const u32x4*)(MQKC + (t0 + srow + 32) * 1024 + h * 128 + scc * 8);
    k0 = *(const u32x4*)(MQKC + (t0 + srow) * 1024 + 512 + h * 128 + scc * 8); k1 = *(const u32x4*)(MQKC + (t0 + srow + 32) * 1024 + 512 + h * 128 + scc * 8);
    v0 = *(const u32x4*)(MV + (t0 + srow) * PLD + scc * 8); v1 = *(const u32x4*)(MV + (t0 + srow + 32) * PLD + scc * 8);
    ga0 = GLa[c * 64 + srow]; ga1 = GLa[c * 64 + srow + 32];
    const int ts = c * 64 + gs; gb = GLb[ts]; gm = GLm[ts]; gme = GLm[c * 64 + 63]; gmp = GLm[(c > 0) ? (c * 64 - 1) : 0];
  };
  auto sstore = [&](int cs) {
    *(LAS u32x4*)(Qs + srow * QLD + scc * 8) = q0; *(LAS u32x4*)(Qs + (srow + 32) * QLD + scc * 8) = q1;
    *(LAS u32x4*)(Ks + srow * QLD + scc * 8) = k0; *(LAS u32x4*)(Ks + (srow + 32) * QLD + scc * 8) = k1;
    *(LAS u32x4*)(Vs + srow * VLD + scc * 8) = v0; *(LAS u32x4*)(Vs + (srow + 32) * VLD + scc * 8) = v1;
    const float bo = segt[2 * (cs >> 3)], mpv = segt[2 * (cs >> 3) + 1];
    const float Mend = fmaxf(mpv, gme - bo);
    const float w0 = __expf(ga0 - bo - Mend), w1 = __expf(ga1 - bo - Mend);
    { float f[8]; unpack8(v0, f);
#pragma unroll
      for (int i = 0; i < 8; ++i) f[i] *= w0;
      *(LAS u32x4*)(VWs + srow * VLD + scc * 8) = packf8(f);
      unpack8(v1, f);
#pragma unroll
      for (int i = 0; i < 8; ++i) f[i] *= w1;
      *(LAS u32x4*)(VWs + (srow + 32) * VLD + scc * 8) = packf8(f); }
    if (scc == 0) { VWs[srow * VLD + 128] = (bf16_t)f2bf(w0); VWs[(srow + 32) * VLD + 128] = (bf16_t)f2bf(w1); }
    if (tid < 64) {
      LAS float* ga = gab + (cs & 1) * 336;
      const float gav = (gs < 32) ? ga0 : ga1;
      (void)gav;
      const float a = GLa[cs * 64 + gs] - bo, Bs = bo + gb, Mt = fmaxf(mpv, gm - bo);
      float Mp = -1e30f;
      if (cs > 0) { const int sp = (cs * 64 - 1) >> 9; Mp = fmaxf(segt[2 * sp + 1], gmp - segt[2 * sp]); }
      ga[gs] = a; ga[64 + gs] = Mt; ga[128 + gs] = __expf(Mp - Mt); ga[192 + gs] = __expf(-(Bs + Mt));
      if (gs == 0) ga[320] = __expf(Mp - Mend);
    }
  };
  __syncthreads();
  gload(0); sstore(0);
  __syncthreads();
  const int tt = w >> 1, st0 = (w & 1) * 2;
  const int trq = fr >> 2, trp = fr & 3;
#pragma unroll 1
  for (int c = 0; c < 64; ++c) {
    if (c < 63) gload(c + 1);
    LAS const float* ga = gab + (c & 1) * 336;
    {
      f32x4 S[2];
#pragma unroll
      for (int i = 0; i < 2; ++i) S[i] = (f32x4){0.f, 0.f, 0.f, 0.f};
#pragma unroll
      for (int kk = 0; kk < 4; ++kk) {
        const bf16x8 bq = *(LAS bf16x8*)(Qs + (tt * 16 + fr) * QLD + kk * 32 + fq * 8);
#pragma unroll
        for (int i = 0; i < 2; ++i) if (st0 + i <= tt) {
          const bf16x8 ak = *(LAS bf16x8*)(Ks + ((st0 + i) * 16 + fr) * QLD + kk * 32 + fq * 8);
          S[i] = __builtin_amdgcn_mfma_f32_16x16x32_bf16(ak, bq, S[i], 0, 0, 0);
        }
      }
      const int t = tt * 16 + fr; const float Mt = ga[64 + t];
#pragma unroll
      for (int i = 0; i < 2; ++i) {
        const int s0 = (st0 + i) * 16 + fq * 4;
        const f32x4 as = *(LAS const f32x4*)(ga + s0);
        float pv[4];
#pragma unroll
        for (int j = 0; j < 4; ++j) pv[j] = (s0 + j <= t) ? S[i][j] * __expf(as[j] - Mt) : 0.f;
        u32x2 pw; pw.x = pk2(pv[0], pv[1]); pw.y = pk2(pv[2], pv[3]);
        *(LAS u32x2*)(Ps + t * TLD + s0) = pw;
      }
    }
    __syncthreads();
    if (w < 4) {
      f32x4 N1[9];
#pragma unroll
      for (int j = 0; j < 9; ++j) N1[j] = (f32x4){0.f, 0.f, 0.f, 0.f};
#pragma unroll
      for (int kk = 0; kk < 4; ++kk) {
        const bf16x8 bq = *(LAS bf16x8*)(Qs + (w * 16 + fr) * QLD + kk * 32 + fq * 8);
#pragma unroll
        for (int j = 0; j < 9; ++j) { const bf16x8 ac = *(LAS bf16x8*)(Cb + (j * 16 + fr) * QLD + kk * 32 + fq * 8); N1[j] = __builtin_amdgcn_mfma_f32_16x16x32_bf16(ac, bq, N1[j], 0, 0, 0); }
      }
      const int t = w * 16 + fr; const float inter = ga[128 + t], low = ga[192 + t];
#pragma unroll
      for (int j = 0; j < 9; ++j) N1[j] = N1[j] * inter;
#pragma unroll
      for (int kk = 0; kk < 2; ++kk) {
        const bf16x8 bp = *(LAS bf16x8*)(Ps + (w * 16 + fr) * TLD + kk * 32 + fq * 8);
        LAS const bf16_t* vb = Vs + (kk * 32 + fq * 8 + trq) * VLD + trp * 4;
#pragma unroll
        for (int j = 0; j < 9; ++j) { const bf16x8 av = ml_tr(vb + j * 16, VLD); N1[j] = __builtin_amdgcn_mfma_f32_16x16x32_bf16(av, bp, N1[j], 0, 0, 0); }
      }
      const float dsrc = N1[8][0];
      const float dn = fmaxf(fabsf(__shfl(dsrc, fr)), low);
      const float inv = __builtin_amdgcn_rcpf(dn);
      float ss = 0.f;
#pragma unroll
      for (int j = 0; j < 8; ++j)
#pragma unroll
        for (int r = 0; r < 4; ++r) { const float hv = N1[j][r] * inv; N1[j][r] = hv; ss += hv * hv; }
      ss += __shfl_xor(ss, 16); ss += __shfl_xor(ss, 32);
      const float rs = rsqrtf(ss * (1.f / 128.f) + EPS);
      bf16_t* op = A2 + (tok0 + (size_t)c * 64 + t) * 1024 + fq * 4;
#pragma unroll
      for (int j = 0; j < 8; ++j) {
        const float4 gh = *(const float4*)(p.g_mlstm_head + h * 128 + j * 16 + fq * 4);
        const u32x2 mo = *(const u32x2*)(MO + (tok0 + (size_t)c * 64 + t) * PLD + j * 16 + fq * 4);
        const float o0 = N1[j][0] * rs * gh.x * sigmoidf_(bflo(mo.x)), o1 = N1[j][1] * rs * gh.y * sigmoidf_(bfhi(mo.x));
        const float o2 = N1[j][2] * rs * gh.z * sigmoidf_(bflo(mo.y)), o3 = N1[j][3] * rs * gh.w * sigmoidf_(bfhi(mo.y));
        u32x2 hw; hw.x = pk2(o0, o1); hw.y = pk2(o2, o3);
        *(u32x2*)(op + j * 16) = hw;
      }
    } else {
      const float dcy = ga[320];
#pragma unroll
      for (int i = 0; i < 2; ++i)
#pragma unroll
        for (int j = 0; j < 9; ++j) Cacc[i][j] = Cacc[i][j] * dcy;
#pragma unroll
      for (int kk = 0; kk < 2; ++kk) {
        LAS const bf16_t* kb0 = Ks + (kk * 32 + fq * 8 + trq) * QLD + trp * 4;
        LAS const bf16_t* vwb = VWs + (kk * 32 + fq * 8 + trq) * VLD + trp * 4;
        bf16x8 akt[2];
#pragma unroll
        for (int i = 0; i < 2; ++i) akt[i] = ml_tr(kb0 + ((w - 4) * 2 + i) * 16, QLD);
#pragma unroll
        for (int j = 0; j < 9; ++j) {
          const bf16x8 bv = ml_tr(vwb + j * 16, VLD);
#pragma unroll
          for (int i = 0; i < 2; ++i) Cacc[i][j] = __builtin_amdgcn_mfma_f32_16x16x32_bf16(akt[i], bv, Cacc[i][j], 0, 0, 0);
        }
      }
    }
    __syncthreads();
    if (w >= 4) {
#pragma unroll
      for (int i = 0; i < 2; ++i)
#pragma unroll
        for (int j = 0; j < 9; ++j) { u32x2 cw; cw.x = pk2(Cacc[i][j][0], Cacc[i][j][1]); cw.y = pk2(Cacc[i][j][2], Cacc[i][j][3]);
          *(LAS u32x2*)(Cb + (j * 16 + fr) * QLD + ((w - 4) * 2 + i) * 16 + fq * 4) = cw; }
    }
    if (c < 63) sstore(c + 1);
    __syncthreads();
  }
}
namespace ds {
constexpr int KEYS = 0, HIST = 131072;
constexpr int KT = 0, VT = 34816, PW = 71680, MSK = 108544;
constexpr int KLD = 136, VLD = 72;
}
__device__ __forceinline__ unsigned score_key16(float s4096) {
  const float t = __builtin_amdgcn_fmed3f(s4096, -32767.0f, 32767.0f);
  return (unsigned)(32768 + (int)floorf(t));
}
__device__ __forceinline__ void hist_find(LAS const unsigned* hist, int lane, unsigned target, unsigned& bin, unsigned& above) {
  const u32x4 h4 = *(LAS const u32x4*)(hist + 4 * lane);
  const unsigned lsum = h4.x + h4.y + h4.z + h4.w;
  unsigned suf = lsum;
#pragma unroll
  for (int off = 1; off < 64; off <<= 1) { const unsigned t = __shfl_down(suf, off); if (lane + off < 64) suf += t; }
  unsigned cum = suf - lsum; bool found = false; unsigned fb = 0, fa = 0;
  { const unsigned hv = h4.w; if (!found && cum < target && cum + hv >= target) { found = true; fb = 4 * lane + 3; fa = cum; } cum += hv; }
  { const unsigned hv = h4.z; if (!found && cum < target && cum + hv >= target) { found = true; fb = 4 * lane + 2; fa = cum; } cum += hv; }
  { const unsigned hv = h4.y; if (!found && cum < target && cum + hv >= target) { found = true; fb = 4 * lane + 1; fa = cum; } cum += hv; }
  { const unsigned hv = h4.x; if (!found && cum < target && cum + hv >= target) { found = true; fb = 4 * lane + 0; fa = cum; } cum += hv; }
  const unsigned long long m = __ballot(found);
  const int src = m ? (__ffsll((long long)m) - 1) : 0;
  bin = __shfl(fb, src); above = __shfl(fa, src);
}
typedef long long i64; typedef long long i64x2 __attribute__((ext_vector_type(2)));
__device__ __forceinline__ bf16x8 tr_pair(LAS const bf16_t* p0, LAS const bf16_t* p1) {
  const v4i16_t a = __builtin_amdgcn_ds_read_tr16_b64_v4i16((LAS v4i16_t*)p0), b = __builtin_amdgcn_ds_read_tr16_b64_v4i16((LAS v4i16_t*)p1);
  bf16x8 r; r[0] = a[0]; r[1] = a[1]; r[2] = a[2]; r[3] = a[3]; r[4] = b[0]; r[5] = b[1]; r[6] = b[2]; r[7] = b[3]; return r;
}
__device__ __forceinline__ void dsa_item(const Params& p, int b, int qc) {
  using namespace ds;
  const int tid = opaque_tid(), lane = tid & 63, w = tid >> 6, fr = lane & 15, fq = lane >> 4;
  LAS unsigned char* L = SMEM + LDS_MAIN;
  const size_t kb = (size_t)b * 4096;
  const size_t q0 = kb + (size_t)qc * 64;
  const int n = (qc + 1) * 64, ntile = qc + 1;
  unsigned long long* BITM = (unsigned long long*)(p.ws + OFF_BITM);
  unsigned char* BITB = (unsigned char*)(p.ws + OFF_BITM);
  const bf16_t* IQ = (const bf16_t*)(p.ws + OFF_PROJ) + 2816; const float* R128 = (const float*)(p.ws + OFF_ROPE); const float* R64 = R128 + 4096 * 32;
  const bf16_t* IK = (const bf16_t*)(p.ws + OFF_IK); const float* IW = (const float*)(p.ws + OFF_IW);
  for (int rep_s = 0; rep_s < ((PROBE_DBL == 33) ? 2 : 1); ++rep_s)
  if (n <= 256) {
    for (int i = tid; i < 64 * ntile; i += NTHR) { const int q = i / ntile, kt = i - q * ntile; BITM[(q0 + q) * 64 + kt] = ~0ull; }
  } else {
    LAS unsigned short* keys = (LAS unsigned short*)(L + KEYS);
    LAS unsigned* hist = (LAS unsigned*)(L + HIST) + w * 256;
    const int nk16 = n >> 4, nblk = (n + 511) >> 9;
#pragma unroll 1
    for (int g = 0; g < 4; ++g) {
      const size_t qg = q0 + g * 16;
      bf16x8 af[4][2]; f32x4 iw[4];
#pragma unroll
      for (int hh = 0; hh < 4; ++hh)
#pragma unroll
        for (int ks = 0; ks < 2; ++ks) {
          const bf16_t* src = IQ + (qg + fr) * PLD + hh * 64 + ks * 32 + fq * 8;
          u32x4 raw = *(const u32x4*)src;
          if (ks == 0 && fq < 2) { float own[8], oth[8]; unpack8(raw, own); unpack8(*(const u32x4*)(IQ + (qg + fr) * PLD + hh * 64 + (fq ^ 1) * 8), oth);
            rope8(own, oth, fq == 0, R64 + (size_t)((qg + fr) & 4095) * 16); raw = packf8(own); }
          af[hh][ks] = __builtin_bit_cast(bf16x8, raw);
        }
#pragma unroll
      for (int j = 0; j < 4; ++j) iw[j] = *(const f32x4*)(IW + (qg + fq * 4 + j) * 4) * 4096.0f;
      for (int rep_a = 0; rep_a < ((PROBE_DBL == 35) ? 2 : 1); ++rep_a)
      {
        const int nbat = n >> 6;
        bf16x8 bc[4][2], bn[4][2];
        {
          const int bt = (w < nbat) ? w : 0;
#pragma unroll
          for (int u = 0; u < 4; ++u) { const bf16_t* kp = IK + (kb + (size_t)(bt * 4 + u) * 16 + fr) * 64 + fq * 8; bc[u][0] = *(const bf16x8*)kp; bc[u][1] = *(const bf16x8*)(kp + 32); }
        }
        for (int bt = w; bt < nbat; bt += 8) {
          const int btn = (bt + 8 < nbat) ? bt + 8 : bt;
#pragma unroll
          for (int u = 0; u < 4; ++u) { const bf16_t* kp = IK + (kb + (size_t)(btn * 4 + u) * 16 + fr) * 64 + fq * 8; bn[u][0] = *(const bf16x8*)kp; bn[u][1] = *(const bf16x8*)(kp + 32); }
#pragma unroll
          for (int u = 0; u < 4; ++u) {
            float sc[4] = {0.f, 0.f, 0.f, 0.f};
#pragma unroll
            for (int hh = 0; hh < 4; ++hh) {
              f32x4 a = (f32x4){0.f, 0.f, 0.f, 0.f};
              a = __builtin_amdgcn_mfma_f32_16x16x32_bf16(af[hh][0], bc[u][0], a, 0, 0, 0);
              a = __builtin_amdgcn_mfma_f32_16x16x32_bf16(af[hh][1], bc[u][1], a, 0, 0, 0);
#pragma unroll
              for (int j = 0; j < 4; ++j) sc[j] += iw[j][hh] * fmaxf(a[j], 0.f);
            }
#pragma unroll
            for (int j = 0; j < 4; ++j) keys[(fq * 4 + j) * 4096 + (bt * 4 + u) * 16 + fr] = (unsigned short)score_key16(sc[j]);
          }
#pragma unroll
          for (int u = 0; u < 4; ++u) { bc[u][0] = bn[u][0]; bc[u][1] = bn[u][1]; }
        }
      }
      __syncthreads();
#pragma unroll 1
      for (int qq = 0; qq < ((PROBE_DBL == 36) ? 4 : 2); ++qq) {
        const int ql = w * 2 + (qq & 1);
        LAS const unsigned short* kq = keys + ql * 4096;
        *(LAS u32x4*)(hist + 4 * lane) = (u32x4){0u, 0u, 0u, 0u};
        for (int blk = 0; blk < nblk; ++blk) {
          const int k0i = blk * 512 + lane * 8;
          if (k0i < n) {
            const u32x4 kv = *(LAS const u32x4*)(kq + k0i);
            __hip_atomic_fetch_add(hist + ((kv.x >> 8) & 255u), 1u, __ATOMIC_RELAXED, __HIP_MEMORY_SCOPE_WORKGROUP); __hip_atomic_fetch_add(hist + (kv.x >> 24), 1u, __ATOMIC_RELAXED, __HIP_MEMORY_SCOPE_WORKGROUP);
            __hip_atomic_fetch_add(hist + ((kv.y >> 8) & 255u), 1u, __ATOMIC_RELAXED, __HIP_MEMORY_SCOPE_WORKGROUP); __hip_atomic_fetch_add(hist + (kv.y >> 24), 1u, __ATOMIC_RELAXED, __HIP_MEMORY_SCOPE_WORKGROUP);
            __hip_atomic_fetch_add(hist + ((kv.z >> 8) & 255u), 1u, __ATOMIC_RELAXED, __HIP_MEMORY_SCOPE_WORKGROUP); __hip_atomic_fetch_add(hist + (kv.z >> 24), 1u, __ATOMIC_RELAXED, __HIP_MEMORY_SCOPE_WORKGROUP);
            __hip_atomic_fetch_add(hist + ((kv.w >> 8) & 255u), 1u, __ATOMIC_RELAXED, __HIP_MEMORY_SCOPE_WORKGROUP); __hip_atomic_fetch_add(hist + (kv.w >> 24), 1u, __ATOMIC_RELAXED, __HIP_MEMORY_SCOPE_WORKGROUP);
          }
        }
        asm volatile("s_waitcnt lgkmcnt(0)" ::: "memory");
        unsigned bin1, above1; hist_find(hist, lane, 256u, bin1, above1);
        *(LAS u32x4*)(hist + 4 * lane) = (u32x4){0u, 0u, 0u, 0u};
        for (int blk = 0; blk < nblk; ++blk) {
          const int k0i = blk * 512 + lane * 8;
          if (k0i < n) {
            const u32x4 kv = *(LAS const u32x4*)(kq + k0i);
#define DS_P2(word) { const unsigned ka = (word) & 0xffffu, kb2 = (word) >> 16; \
              if ((ka >> 8) == bin1) __hip_atomic_fetch_add(hist + (ka & 255u), 1u, __ATOMIC_RELAXED, __HIP_MEMORY_SCOPE_WORKGROUP); \
              if ((kb2 >> 8) == bin1) __hip_atomic_fetch_add(hist + (kb2 & 255u), 1u, __ATOMIC_RELAXED, __HIP_MEMORY_SCOPE_WORKGROUP); }
            DS_P2(kv.x) DS_P2(kv.y) DS_P2(kv.z) DS_P2(kv.w)
#undef DS_P2
          }
        }
        asm volatile("s_waitcnt lgkmcnt(0)" ::: "memory");
        unsigned bin2, above2; hist_find(hist, lane, 256u - above1, bin2, above2);
        const unsigned tau = (bin1 << 8) | bin2, rties = 256u - above1 - above2;
        unsigned tbase = 0;
        for (int blk = 0; blk < nblk; ++blk) {
          const int k0i = blk * 512 + lane * 8;
          u32x4 kv = (u32x4){0u, 0u, 0u, 0u};
          if (k0i < n) kv = *(LAS const u32x4*)(kq + k0i);
          unsigned kk[8] = {kv.x & 0xffffu, kv.x >> 16, kv.y & 0xffffu, kv.y >> 16, kv.z & 0xffffu, kv.z >> 16, kv.w & 0xffffu, kv.w >> 16};
          unsigned ne = 0;
#pragma unroll
          for (int e = 0; e < 8; ++e) ne += (kk[e] == tau) ? 1u : 0u;
          if (k0i >= n) ne = 0;
          unsigned mbyte = 0;
          if (__ballot(ne != 0u) == 0ull) {
#pragma unroll
            for (int e = 0; e < 8; ++e) mbyte |= (kk[e] > tau) ? (1u << e) : 0u;
          } else {
            unsigned inc = ne;
#pragma unroll
            for (int off = 1; off < 64; off <<= 1) { const unsigned t = __shfl_up(inc, off); if (lane >= off) inc += t; }
            unsigned rank = tbase + inc - ne;
#pragma unroll
            for (int e = 0; e < 8; ++e) { const bool eq = kk[e] == tau; const bool sel = (kk[e] > tau) || (eq && rank < rties); mbyte |= sel ? (1u << e) : 0u; rank += eq ? 1u : 0u; }
            tbase += __shfl(inc, 63);
          }
          if (k0i < n) BITB[(qg + ql) * 512 + blk * 64 + lane] = (unsigned char)mbyte;
        }
      }
      __syncthreads();
    }
  }
  asm volatile("s_waitcnt vmcnt(0)" ::: "memory");
  __threadfence_block();
  __syncthreads();
  const bf16_t* AQ = (const bf16_t*)(p.ws + OFF_PROJ) + 2048; const bf16_t* AK = (const bf16_t*)(p.ws + OFF_AK); const bf16_t* AV = (const bf16_t*)(p.ws + OFF_PROJ) + 2688;
  bf16_t* A2 = (bf16_t*)(p.ws + OFF_ACTA);
  const float qscale = 0.08838834764831845f * 1.4426950408889634f;
  constexpr int RS = 36864;
  const int wv = __builtin_amdgcn_readfirstlane(w);
  const int prow0 = wv * 4 + (lane >> 4), prow1 = 32 + prow0;
  const int pch0 = (lane & 15) ^ (prow0 & 15), pch1 = (lane & 15) ^ (prow1 & 15);
  const unsigned koff0 = (unsigned)(prow0 * 128 + pch0 * 8) * 2u, koff1 = (unsigned)(prow1 * 128 + pch1 * 8) * 2u;
  const unsigned voff0 = (unsigned)(prow0 * PLD + pch0 * 8) * 2u, voff1 = (unsigned)(prow1 * PLD + pch1 * 8) * 2u;
  const unsigned moff = (unsigned)(((tid & 127) >> 1) * 512 + (tid & 1) * 4);
#define DS_GLDS(gp, ldsoff, sz) __builtin_amdgcn_global_load_lds((const unsigned*)(gp), (LAS unsigned*)(L + (ldsoff)), sz, 0, 0)
#define DS_ISSUE(kt_, stg_) do { const size_t t0_ = kb + (size_t)(kt_) * 64; const int so_ = (stg_) * RS; \
    DS_GLDS((const char*)(AK + t0_ * 128) + koff0, so_ + wv * 1024, 16); DS_GLDS((const char*)(AK + t0_ * 128) + koff1, so_ + 8192 + wv * 1024, 16); \
    DS_GLDS((const char*)(AV + t0_ * PLD) + voff0, so_ + 16384 + wv * 1024, 16); DS_GLDS((const char*)(AV + t0_ * PLD) + voff1, so_ + 16384 + 8192 + wv * 1024, 16); \
    DS_GLDS((const char*)(BITM + q0 * 64 + (kt_)) + moff, so_ + 32768 + wv * 256, 4); } while (0)
#pragma unroll 1
  for (int hp = 0; hp < ((PROBE_DBL == 34) ? 2 : 1); ++hp) {
    const int hd0 = (w >> 2) * 2, qh = (w & 3) * 16;
    bf16x8 qf[2][4];
#pragma unroll
    for (int hx = 0; hx < 2; ++hx)
#pragma unroll
      for (int kk = 0; kk < 4; ++kk) {
        const bf16_t* src = AQ + (q0 + qh + fr) * PLD + (hd0 + hx) * 128 + kk * 32 + fq * 8;
        float own[8]; unpack8(*(const u32x4*)src, own);
        if (kk == 0) { float oth[8]; unpack8(*(const u32x4*)(AQ + (q0 + qh + fr) * PLD + (hd0 + hx) * 128 + (fq ^ 2) * 8), oth);
          rope8(own, oth, fq < 2, R128 + (size_t)((q0 + qh + fr) & 4095) * 32 + (fq & 1) * 16); }
#pragma unroll
        for (int i = 0; i < 8; ++i) own[i] *= qscale;
        qf[hx][kk] = __builtin_bit_cast(bf16x8, packf8(own));
      }
    f32x4 O[2][8];
#pragma unroll
    for (int hx = 0; hx < 2; ++hx)
#pragma unroll
      for (int di = 0; di < 8; ++di) O[hx][di] = (f32x4){0.f, 0.f, 0.f, 0.f};
    float mrun[2] = {0.f, 0.f};
    f32x4 Lacc[2] = {(f32x4){0.f, 0.f, 0.f, 0.f}, (f32x4){0.f, 0.f, 0.f, 0.f}};
    const bf16x8 ones8 = __builtin_bit_cast(bf16x8, (u32x4){0x3F803F80u, 0x3F803F80u, 0x3F803F80u, 0x3F803F80u});
    const unsigned r15 = (unsigned)(fq * 4 + (fr >> 2));
    const unsigned vrb = r15 * 256u + (unsigned)(fr & 1) * 8u, vcx = (unsigned)((fr & 3) >> 1);
    const unsigned va0 = vrb + (((0u + vcx) ^ r15) << 4), va1 = vrb + (((2u + vcx) ^ r15) << 4), va2 = vrb + (((4u + vcx) ^ r15) << 4), va3 = vrb + (((6u + vcx) ^ r15) << 4);
    const unsigned va4 = vrb + (((8u + vcx) ^ r15) << 4), va5 = vrb + (((10u + vcx) ^ r15) << 4), va6 = vrb + (((12u + vcx) ^ r15) << 4), va7 = vrb + (((14u + vcx) ^ r15) << 4);
    asm volatile("s_waitcnt vmcnt(0)" ::: "memory");
    DS_ISSUE(0, 0);
    DS_ISSUE((ntile > 1) ? 1 : 0, 1);
#pragma unroll 1
    for (int kt = 0; kt < ntile; ++kt) {
      const int stg = kt % 3;
      asm volatile("s_waitcnt vmcnt(5)" ::: "memory");
      asm volatile("s_waitcnt lgkmcnt(0)" ::: "memory");
      __builtin_amdgcn_s_barrier();
      { const int ktn = (kt + 2 < ntile) ? kt + 2 : ntile - 1; DS_ISSUE(ktn, (kt + 2) % 3); }
      LAS const unsigned char* Kt = L + stg * RS;
      f32x4 S[2][4];
#pragma unroll
      for (int hx = 0; hx < 2; ++hx)
#pragma unroll
        for (int ni = 0; ni < 4; ++ni) { const float nb = -mrun[hx]; S[hx][ni] = (f32x4){nb, nb, nb, nb}; }
#pragma unroll
      for (int kk = 0; kk < 4; ++kk)
#pragma unroll
        for (int ni = 0; ni < 4; ++ni) {
          const bf16x8 ak = *(LAS const bf16x8*)(Kt + (ni * 16 + fr) * 256 + (((kk * 4 + fq) ^ fr) << 4));
          S[0][ni] = __builtin_amdgcn_mfma_f32_16x16x32_bf16(ak, qf[0][kk], S[0][ni], 0, 0, 0);
          S[1][ni] = __builtin_amdgcn_mfma_f32_16x16x32_bf16(ak, qf[1][kk], S[1][ni], 0, 0, 0);
        }
#define DS_TRI(o0, o1, aa, ab, ac, ad, r0, r1, r2, r3, r4, r5, r6, r7) asm volatile( \
        "ds_read_b64_tr_b16 %0, %8 offset:" #o0 "\n\tds_read_b64_tr_b16 %1, %8 offset:" #o1 "\n\tds_read_b64_tr_b16 %2, %9 offset:" #o0 "\n\tds_read_b64_tr_b16 %3, %9 offset:" #o1 "\n\t" \
        "ds_read_b64_tr_b16 %4, %10 offset:" #o0 "\n\tds_read_b64_tr_b16 %5, %10 offset:" #o1 "\n\tds_read_b64_tr_b16 %6, %11 offset:" #o0 "\n\tds_read_b64_tr_b16 %7, %11 offset:" #o1 \
        : "=&v"(r0), "=&v"(r1), "=&v"(r2), "=&v"(r3), "=&v"(r4), "=&v"(r5), "=&v"(r6), "=&v"(r7) : "v"((aa) + sb), "v"((ab) + sb), "v"((ac) + sb), "v"((ad) + sb) : "memory")
#define DS_TRW(r0, r1, r2, r3, r4, r5, r6, r7) asm volatile("s_waitcnt lgkmcnt(0)" : "+v"(r0), "+v"(r1), "+v"(r2), "+v"(r3), "+v"(r4), "+v"(r5), "+v"(r6), "+v"(r7) :: "memory")
      const unsigned sb = (unsigned)(LDS_MAIN + stg * RS + 16384);
      LAS const unsigned* wp = (LAS const unsigned*)(Kt + 32768 + (qh + fr) * 8);
      const unsigned mlo = wp[0] >> (fq * 4), mhi = wp[1] >> (fq * 4);
      unsigned pm[4][2];
#pragma unroll
      for (int ni = 0; ni < 4; ++ni)
#pragma unroll
        for (int jp = 0; jp < 2; ++jp) {
          const unsigned m = (ni < 2) ? mlo : mhi; const int sh = 16 * (ni & 1) + 2 * jp;
          const unsigned lo = (unsigned)__builtin_amdgcn_sbfe((int)m, sh, 1), hi = (unsigned)__builtin_amdgcn_sbfe((int)m, sh + 1, 1);
          pm[ni][jp] = __builtin_amdgcn_perm(hi, lo, 0x05040100u);
        }
      i64 t0, t1, t2, t3, t4, t5, t6, t7, u0, u1, u2, u3, u4, u5, u6, u7;
      __builtin_amdgcn_sched_barrier(0);
      DS_TRI(0, 4096, va0, va1, va2, va3, t0, t1, t2, t3, t4, t5, t6, t7);
      __builtin_amdgcn_sched_barrier(0);
      unsigned pk[2][4][2];
#pragma unroll
      for (int hx = 0; hx < 2; ++hx) {
        float mx = fmaxf(fmaxf(S[hx][0][0], S[hx][0][1]), fmaxf(S[hx][0][2], S[hx][0][3]));
#pragma unroll
        for (int ni = 1; ni < 4; ++ni) mx = fmaxf(mx, fmaxf(fmaxf(S[hx][ni][0], S[hx][ni][1]), fmaxf(S[hx][ni][2], S[hx][ni][3])));
        mx = rowmax4(mx);
        const bool up = (kt == 0) || (mx > 8.0f);
        if (__ballot(up) != 0ull) {
          const float d = up ? mx : 0.f;
          const float alpha = __builtin_amdgcn_exp2f(-d);
          mrun[hx] += d;
#pragma unroll
          for (int ni = 0; ni < 4; ++ni)
#pragma unroll
            for (int j = 0; j < 4; ++j) S[hx][ni][j] -= d;
#pragma unroll
          for (int di = 0; di < 8; ++di) O[hx][di] = O[hx][di] * alpha;
          Lacc[hx] = Lacc[hx] * alpha;
        }
#pragma unroll
        for (int ni = 0; ni < 4; ++ni)
#pragma unroll
          for (int jp = 0; jp < 2; ++jp)
            pk[hx][ni][jp] = pk2(__builtin_amdgcn_exp2f(S[hx][ni][2 * jp]), __builtin_amdgcn_exp2f(S[hx][ni][2 * jp + 1])) & pm[ni][jp];
      }
#define DS_PV(di, ta, tb) { const bf16x8 av = __builtin_bit_cast(bf16x8, (i64x2){ta, tb}); \
        O[0][di] = __builtin_amdgcn_mfma_f32_16x16x32_bf16(av, pb0, O[0][di], 0, 0, 0); O[1][di] = __builtin_amdgcn_mfma_f32_16x16x32_bf16(av, pb1, O[1][di], 0, 0, 0); }
      DS_TRW(t0, t1, t2, t3, t4, t5, t6, t7);
      {
        u32x4 pw;
        pw.x = pk[0][0][0]; pw.y = pk[0][0][1]; pw.z = pk[0][1][0]; pw.w = pk[0][1][1];
        const bf16x8 pb0 = __builtin_bit_cast(bf16x8, pw);
        pw.x = pk[1][0][0]; pw.y = pk[1][0][1]; pw.z = pk[1][1][0]; pw.w = pk[1][1][1];
        const bf16x8 pb1 = __builtin_bit_cast(bf16x8, pw);
        DS_TRI(0, 4096, va4, va5, va6, va7, u0, u1, u2, u3, u4, u5, u6, u7);
        __builtin_amdgcn_sched_barrier(0);
        Lacc[0] = __builtin_amdgcn_mfma_f32_16x16x32_bf16(ones8, pb0, Lacc[0], 0, 0, 0);
        Lacc[1] = __builtin_amdgcn_mfma_f32_16x16x32_bf16(ones8, pb1, Lacc[1], 0, 0, 0);
        DS_PV(0, t0, t1) DS_PV(1, t2, t3) DS_PV(2, t4, t5) DS_PV(3, t6, t7)
        __builtin_amdgcn_sched_barrier(0);
        DS_TRW(u0, u1, u2, u3, u4, u5, u6, u7);
        DS_TRI(8192, 12288, va0, va1, va2, va3, t0, t1, t2, t3, t4, t5, t6, t7);
        __builtin_amdgcn_sched_barrier(0);
        DS_PV(4, u0, u1) DS_PV(5, u2, u3) DS_PV(6, u4, u5) DS_PV(7, u6, u7)
        __builtin_amdgcn_sched_barrier(0);
      }
      {
        u32x4 pw;
        pw.x = pk[0][2][0]; pw.y = pk[0][2][1]; pw.z = pk[0][3][0]; pw.w = pk[0][3][1];
        const bf16x8 pb0 = __builtin_bit_cast(bf16x8, pw);
        pw.x = pk[1][2][0]; pw.y = pk[1][2][1]; pw.z = pk[1][3][0]; pw.w = pk[1][3][1];
        const bf16x8 pb1 = __builtin_bit_cast(bf16x8, pw);
        DS_TRW(t0, t1, t2, t3, t4, t5, t6, t7);
        DS_TRI(8192, 12288, va4, va5, va6, va7, u0, u1, u2, u3, u4, u5, u6, u7);
        __builtin_amdgcn_sched_barrier(0);
        Lacc[0] = __builtin_amdgcn_mfma_f32_16x16x32_bf16(ones8, pb0, Lacc[0], 0, 0, 0);
        Lacc[1] = __builtin_amdgcn_mfma_f32_16x16x32_bf16(ones8, pb1, Lacc[1], 0, 0, 0);
        DS_PV(0, t0, t1) DS_PV(1, t2, t3) DS_PV(2, t4, t5) DS_PV(3, t6, t7)
        __builtin_amdgcn_sched_barrier(0);
        DS_TRW(u0, u1, u2, u3, u4, u5, u6, u7);
        DS_PV(4, u0, u1) DS_PV(5, u2, u3) DS_PV(6, u4, u5) DS_PV(7, u6, u7)
      }
#undef DS_PV
#undef DS_TRI
#undef DS_TRW
    }
    asm volatile("s_waitcnt vmcnt(0)" ::: "memory");
#pragma unroll
    for (int hx = 0; hx < 2; ++hx) {
      const float inv = 1.0f / Lacc[hx][0];
      bf16_t* op = A2 + (q0 + qh + fr) * 1024 + 512 + (hd0 + hx) * 128 + fq * 4;
#pragma unroll
      for (int di = 0; di < 8; ++di) { u32x2 wv2; wv2.x = pk2(O[hx][di][0] * inv, O[hx][di][1] * inv); wv2.y = pk2(O[hx][di][2] * inv, O[hx][di][3] * inv); *(u32x2*)(op + di * 16) = wv2; }
    }
    __syncthreads();
  }
#undef DS_ISSUE
#undef DS_GLDS
}
__device__ __forceinline__ void phase3(const Params& p) {
  for (int rep = 0; rep < ((PROBE_DBL == 31) ? 2 : 1); ++rep)
  for (int id = blockIdx.x; id < 64; id += gridDim.x) { mlstm_item(p, id); __syncthreads(); }
  unsigned* qctr = (unsigned*)(p.ws + OFF_CTL) + CW_Q;
  LAS unsigned* qk = (LAS unsigned*)(SMEM + LDS_MISC);
  for (;;) {
    __syncthreads();
    if (threadIdx.x == 0) qk[0] = __hip_atomic_fetch_add(qctr, 1u, __ATOMIC_RELAXED, __HIP_MEMORY_SCOPE_AGENT);
    __syncthreads();
    const unsigned k = qk[0];
    if (k >= 1024u) break;
    dsa_item(p, (int)(k & 15u), 63 - (int)(k >> 4));
  }
}
struct EpiY { bf16_t* Y; int m0, n0;
  __device__ __forceinline__ void operator()(LAS const float* tile, int r, int c0) const { *(u32x4*)(Y + (size_t)(m0 + r) * 1024 + n0 + c0) = pack8(tile + r * TILE_LD + c0); } };
__device__ __forceinline__ void rows6(const Params& p, int row0) {
  const int tid_ = opaque_tid(); const int lane = tid_ & 63, wv = tid_ >> 6;
  const float* mb = (const float*)(p.ws + OFF_MOD) + (row0 >> 12) * 6144;
  const bf16_t* Y = (const bf16_t*)(p.ws + OFF_Y);
  bf16_t* H2 = (bf16_t*)(p.ws + OFF_ACTA); bf16_t* H2L = (bf16_t*)(p.ws + OFF_H2LO);
  float4 gpo[4], gt1[4], gpr[4], sh2[4], sc2[4];
#pragma unroll
  for (int i = 0; i < 4; ++i) { const int c = (lane + 64 * i) * 4; gpo[i] = *(const float4*)(p.g_mix_post + c); gt1[i] = *(const float4*)(mb + 2048 + c);
    gpr[i] = *(const float4*)(p.g_ffn_pre + c); sh2[i] = *(const float4*)(mb + 3072 + c); sc2[i] = *(const float4*)(mb + 4096 + c); }
  u32x2 yn[4]; float4 xn[4];
  const int rfirst = row0 + wv * 32;
#pragma unroll
  for (int i = 0; i < 4; ++i) { const int c = (lane + 64 * i) * 4; yn[i] = __builtin_nontemporal_load((const u32x2*)(Y + (size_t)rfirst * 1024 + c)); xn[i] = *(const float4*)(p.x + (size_t)rfirst * 1024 + c); }
#pragma unroll 1
  for (int r = 0; r < 32; ++r) {
    const int row = rfirst + r;
    u32x2 yc[4]; float4 xc[4];
#pragma unroll
    for (int i = 0; i < 4; ++i) { yc[i] = yn[i]; xc[i] = xn[i]; }
    if (r + 1 < 32) {
#pragma unroll
      for (int i = 0; i < 4; ++i) { const int c = (lane + 64 * i) * 4; yn[i] = __builtin_nontemporal_load((const u32x2*)(Y + (size_t)(row + 1) * 1024 + c)); xn[i] = *(const float4*)(p.x + (size_t)(row + 1) * 1024 + c); }
    }
    float y[16], xv[16]; float ssy = 0.f;
#pragma unroll
    for (int i = 0; i < 4; ++i) {
      y[4 * i] = bflo(yc[i].x); y[4 * i + 1] = bfhi(yc[i].x); y[4 * i + 2] = bflo(yc[i].y); y[4 * i + 3] = bfhi(yc[i].y);
      xv[4 * i] = xc[i].x; xv[4 * i + 1] = xc[i].y; xv[4 * i + 2] = xc[i].z; xv[4 * i + 3] = xc[i].w;
#pragma unroll
      for (int k = 0; k < 4; ++k) ssy += y[4 * i + k] * y[4 * i + k];
    }
    ssy = wave_sum(ssy);
    const float rsy = rsqrtf(ssy * (1.f / 1024.f) + EPS);
    float ss1 = 0.f;
#pragma unroll
    for (int i = 0; i < 4; ++i) {
      const int c = (lane + 64 * i) * 4;
      xv[4 * i] += gt1[i].x * (y[4 * i] * rsy * gpo[i].x); xv[4 * i + 1] += gt1[i].y * (y[4 * i + 1] * rsy * gpo[i].y);
      xv[4 * i + 2] += gt1[i].z * (y[4 * i + 2] * rsy * gpo[i].z); xv[4 * i + 3] += gt1[i].w * (y[4 * i + 3] * rsy * gpo[i].w);
      { u32x2 xb; xb.x = pk2(xv[4 * i], xv[4 * i + 1]); xb.y = pk2(xv[4 * i + 2], xv[4 * i + 3]); *(u32x2*)((bf16_t*)(p.out + (size_t)row * 1024) + c) = xb; }
#pragma unroll
      for (int k = 0; k < 4; ++k) ss1 += xv[4 * i + k] * xv[4 * i + k];
    }
    ss1 = wave_sum(ss1);
    const float rs1 = rsqrtf(ss1 * (1.f / 1024.f) + EPS);
#pragma unroll
    for (int i = 0; i < 4; ++i) {
      const int c = (lane + 64 * i) * 4;
      const float h0 = xv[4 * i] * rs1 * gpr[i].x * (1.f + sc2[i].x) + sh2[i].x, h1 = xv[4 * i + 1] * rs1 * gpr[i].y * (1.f + sc2[i].y) + sh2[i].y;
      const float h2 = xv[4 * i + 2] * rs1 * gpr[i].z * (1.f + sc2[i].z) + sh2[i].z, h3 = xv[4 * i + 3] * rs1 * gpr[i].w * (1.f + sc2[i].w) + sh2[i].w;
      const unsigned hw0 = pk2(h0, h1), hw1 = pk2(h2, h3);
      u32x2 hi; hi.x = hw0; hi.y = hw1;
      u32x2 lo; lo.x = pk2(h0 - bflo(hw0), h1 - bfhi(hw0)); lo.y = pk2(h2 - bflo(hw1), h3 - bfhi(hw1));
      *(u32x2*)(H2 + (size_t)row * 1024 + c) = hi; *(u32x2*)(H2L + (size_t)row * 1024 + c) = lo;
      { const int q8 = cvt4_fp8(__builtin_amdgcn_fmed3f(h0, -448.f, 448.f), __builtin_amdgcn_fmed3f(h1, -448.f, 448.f), __builtin_amdgcn_fmed3f(h2, -448.f, 448.f), __builtin_amdgcn_fmed3f(h3, -448.f, 448.f)); *(int*)(p.ws + OFF_H2Q + (size_t)row * 1024 + c) = q8; }
    }
  }
}
constexpr int LDS_RT = LDS_MAIN + 4 * GT_STAGE;
constexpr int LDS_RTX = LDS_RT + 512 + 320 + 1024;
__device__ __forceinline__ void route6g(const Params& p, int mt_begin, int mt_end) {
  const int tid = opaque_tid();
  GemmArgs<3> g{}; g.lda = 1024; g.ldb = 1024; g.K = 1024;
  const bf16_t* Hh = (const bf16_t*)(p.ws + OFF_ACTA); const bf16_t* Hl = (const bf16_t*)(p.ws + OFF_H2LO);
  const bf16_t* Wh = (const bf16_t*)(p.ws + OFF_WR); const bf16_t* Wl = Wh + 128 * 1024;
  g.A0 = Hh; g.B0 = Wh; g.A1 = Hl; g.B1 = Wh; g.A2 = Hh; g.B2 = Wl;
  unsigned* cnt = (unsigned*)(p.ws + OFF_CTL) + CW_CNT;
  int* SORTED = (int*)(p.ws + OFF_SORTED); float* GW = (float*)(p.ws + OFF_GW);
  LAS unsigned* cntl = (LAS unsigned*)(SMEM + LDS_RT); LAS unsigned* basel = cntl + 64;
  for (int rep6 = ((PROBE_DBL == 66) ? 0 : 1); rep6 < 2; ++rep6)
  for (int mt = mt_begin; mt < mt_end; ++mt) {
    const long ar = (long)mt * 128 + (tid >> 3);
    if (tid < 64) cntl[tid] = 0u;
    gemm_mainloop<3, true>(g, ar, ar + 64);
    LAS float* tile = (LAS float*)(SMEM + LDS_MAIN);
    const int tok = mt * 128 + tid;
    LAS int* rei = (LAS int*)(SMEM + LDS_RTX) + tid * 8; LAS float* rgw = (LAS float*)(SMEM + LDS_RTX + 4096) + tid * 8; LAS unsigned* rrk = (LAS unsigned*)(SMEM + LDS_RTX + 8192) + tid * 8;
    if (tid < 128) {
      LAS float* tr = tile + tid * TILE_LD;
      for (int e = 0; e < 64; ++e) { const float s = sigmoidf_(tr[e]); tr[64 + e] = s; tr[e] = s + p.b_router[e]; }
      float gs[8];
#pragma unroll
      for (int gi = 0; gi < 8; ++gi) {
        float m1 = -INFINITY, m2 = -INFINITY;
#pragma unroll
        for (int k = 0; k < 8; ++k) { const float v = tr[gi * 8 + k]; if (v > m1) { m2 = m1; m1 = v; } else if (v > m2) m2 = v; }
        gs[gi] = m1 + m2;
      }
#pragma unroll
      for (int gi = 0; gi < 8; ++gi) {
        int rank = 0;
#pragma unroll
        for (int gj = 0; gj < 8; ++gj) rank += (gs[gj] > gs[gi] || (gs[gj] == gs[gi] && gj < gi)) ? 1 : 0;
        if (rank >= 4) {
#pragma unroll
          for (int k = 0; k < 8; ++k) tr[gi * 8 + k] = -INFINITY; }
      }
      float gsum = 0.f;
#pragma unroll 1
      for (int it = 0; it < 8; ++it) {
        float best = -INFINITY; int bi = 0;
        for (int e = 0; e < 64; ++e) { const float v = tr[e]; if (v > best) { best = v; bi = e; } }
        const float sv = tr[64 + bi];
        rei[it] = bi; rgw[it] = sv; gsum += sv; tr[bi] = -INFINITY;
      }
      const float gn = 2.5f / gsum;
#pragma unroll 1
      for (int it = 0; it < 8; ++it) { rgw[it] *= gn; rrk[it] = __hip_atomic_fetch_add(cntl + rei[it], 1u, __ATOMIC_RELAXED, __HIP_MEMORY_SCOPE_WORKGROUP); }
    }
    __syncthreads();
    if (tid < 64) { const unsigned c = cntl[tid]; basel[tid] = (c && rep6 == 1) ? __hip_atomic_fetch_add(cnt + tid, c, __ATOMIC_RELAXED, __HIP_MEMORY_SCOPE_AGENT) : 0u; }
    __syncthreads();
    if (tid < 128 && rep6 == 1) {
#pragma unroll 1
      for (int it = 0; it < 8; ++it) {
        const int e = rei[it];
        const unsigned pos = basel[e] + rrk[it];
        u32x2 rec; rec.x = (unsigned)(tok * 8 + it); rec.y = __builtin_bit_cast(unsigned, rgw[it]);
        *(u32x2*)(SORTED + ((size_t)e * 65536 + pos) * 2) = rec;
      }
    }
    __syncthreads();
  }
}

struct PanelOrder {
  static constexpr bool REC = false, BSTAT = false; static constexpr int SCALE_A = 0, SCALE_B = 0;
  int pm; const char* Bt;
  __device__ __forceinline__ bool next(int i, pg8::Unit& u) const { if (i >= 4) return false; u.pm = pm; u.pn = i; u.e = 0; u.lt = 0; return true; }
  __device__ __forceinline__ const char* b_base(const pg8::Unit& u) const { return Bt + (size_t)u.pn * 256 * 1024 * 2; }
  __device__ __forceinline__ unsigned a_off(const pg8::Unit& u, int row) const { return (unsigned)(u.pm * 256 + row) * 2048u; }
  __device__ __forceinline__ const char* rec_ptr(const pg8::Unit&) const { return nullptr; }
  __device__ __forceinline__ bool has_rec(const pg8::Unit&) const { return false; }
  __device__ __forceinline__ bool row_valid(const pg8::Unit&, int) const { return true; }
  __device__ __forceinline__ int nvalid(const pg8::Unit&) const { return 256; }
  __device__ __forceinline__ unsigned a_off_idx(const pg8::Unit&, int, int) const { return 0u; }
};
__device__ __forceinline__ void phase56(const Params& p) {
#pragma unroll 1
  for (int pm = blockIdx.x; pm < 256; pm += gridDim.x) {
    PanelOrder S{pm, (const char*)(p.ws + OFF_WOUT)};
    pg8::EpiStoreBf16 E{(bf16_t*)(p.ws + OFF_Y), 1024};
    pg8::gemm_phase(SMEM + LDS_PG8, (const bf16_t*)(p.ws + OFF_ACTA), 1024, S, E);
    rows6(p, pm * 256);
    asm volatile("s_waitcnt vmcnt(0)" ::: "memory");
    __syncthreads();
    route6g(p, pm * 2, pm * 2 + 2);
  }
}
constexpr int LDS_PRE = LDS_PG8 + 131072 + 8192 + 256;
constexpr int LDS_TAB = LDS_PRE + 1024;
typedef float f32x2 __attribute__((ext_vector_type(2)));
__device__ __forceinline__ void moe_prefix(const Params& p) {
  LAS int* pre = (LAS int*)(SMEM + LDS_PRE); LAS unsigned char* tab = SMEM + LDS_TAB;
  const unsigned* cnt = (const unsigned*)(p.ws + OFF_CTL) + CW_CNT;
  __syncthreads();
  if (threadIdx.x < 64) {
    const int e = threadIdx.x; const int c = (int)cnt[e]; const int nt_ = (c + 255) >> 8; int inc = nt_;
#pragma unroll
    for (int d = 1; d < 64; d <<= 1) { const int o = __shfl_up(inc, d, 64); if (e >= d) inc += o; }
    const int beg = inc - nt_;
    pre[e] = beg; if (e == 63) pre[64] = inc; pre[128 + e] = c;
    for (int t = beg; t < inc; ++t) tab[t] = (unsigned char)e;
  }
  __syncthreads();
}
template <int SA, int SB, int NT, bool BS = false>
struct MoeOrder {
  static constexpr bool REC = true, BSTAT = BS;
  static constexpr int SCALE_A = SA * 0x01010101, SCALE_B = SB * 0x01010101;
  int R, nwg, G, c, hf, mode, rowbytes, routed; const unsigned* cnt; const int* list; const char* W; size_t estride, tstride;
  __device__ __forceinline__ bool next(int i, pg8::Unit& u) const {
    const int cc = (c & 7) * (G >> 3) + (c >> 3);
    if (BS) {
      const int nch = G / NT, j = cc / NT, q = R / nch, r = R - q * nch;
      const int start = j * q + (j < r ? j : r), len = q + (j < r ? 1 : 0);
      if (j >= nch || i >= len) return false;
      u.pm = start + i; u.pn = cc - j * NT;
    } else {
    const int L = i * G + cc; if (L >= nwg) return false;
    u.pm = L / NT; u.pn = L - u.pm * NT; }
    if (u.pm >= routed) { u.e = 64; u.lt = u.pm - routed; }
    else { u.e = (int)(SMEM + LDS_TAB)[u.pm]; u.lt = u.pm - ((LAS const int*)(SMEM + LDS_PRE))[u.e]; }
    return true;
  }
  __device__ __forceinline__ const char* b_base(const pg8::Unit& u) const { return W + (size_t)u.e * estride + (size_t)u.pn * tstride; }
  __device__ __forceinline__ const char* rec_ptr(const pg8::Unit& u) const { return (const char*)(list + ((size_t)(u.e < 64 ? u.e : 0) * 65536 + (u.e < 64 ? u.lt * 256 : 0)) * 2); }
  __device__ __forceinline__ bool has_rec(const pg8::Unit& u) const { return u.e < 64; }
  __device__ __forceinline__ bool row_valid(const pg8::Unit& u, int row) const { return (u.lt * 256 + row) < ((LAS const int*)(SMEM + LDS_PRE))[128 + (u.e < 64 ? u.e : 0)]; }
  __device__ __forceinline__ int nvalid(const pg8::Unit& u) const { return ((LAS const int*)(SMEM + LDS_PRE))[128 + (u.e < 64 ? u.e : 0)] - u.lt * 256; }
  __device__ __forceinline__ unsigned a_off_idx(const pg8::Unit& u, int row, int idx) const { const int arow = (mode == 0) ? (idx >> 3) : idx; return (unsigned)arow * (unsigned)rowbytes; }
  __device__ __forceinline__ unsigned a_off(const pg8::Unit& u, int row) const {
    const int tl = u.lt * 256 + row; const int arow = (mode == 0) ? tl : (524288 + tl);
    return (unsigned)arow * (unsigned)rowbytes;
  }
};
constexpr int LDS_EPI = LDS_TAB + 2560;
#define EPI_BAR() do { asm volatile("s_waitcnt lgkmcnt(0)" ::: "memory"); __builtin_amdgcn_s_barrier(); } while (0)
struct EpiU { unsigned char* U; const unsigned* cnt; const int* list; int hf;
  __device__ __forceinline__ void operator()(const f32x4 (&acc)[2][2][4][2], const pg8::Unit& u, int wr, int wc, int fr, int fq, LAS const unsigned char* rec) const {
    const bool rt = u.e < 64;
    const int nrow = rt ? ((LAS const int*)(SMEM + LDS_PRE))[128 + u.e] : 0x7fffffff;
    LAS unsigned char* st = SMEM + LDS_EPI;
    const int tid = (wr * 4 + wc) * 64 + fq * 16 + fr;
    const int c16 = tid & 7;
    int ridx[2][2];
#pragma unroll
    for (int ai = 0; ai < 2; ++ai)
#pragma unroll
      for (int i = 0; i < 2; ++i) ridx[ai][i] = *(LAS const int*)(rec + (ai * 128 + ((tid + 512 * i) >> 3)) * 8);
    unsigned dp[2][2]; bool ok[2][2];
#pragma unroll
    for (int ai = 0; ai < 2; ++ai)
#pragma unroll
      for (int i = 0; i < 2; ++i) {
        const int li = u.lt * 256 + ai * 128 + ((tid + 512 * i) >> 3);
        ok[ai][i] = li < nrow;
        const int ur = rt ? ridx[ai][i] : (524288 + li);
        dp[ai][i] = (unsigned)ur * 256u + (unsigned)(u.pn * 128 + c16 * 16);
      }
#pragma unroll
    for (int ai = 0; ai < 2; ++ai) {
      int gwu[4];
#pragma unroll
      for (int m = 0; m < 4; ++m) gwu[m] = ((LAS const int*)(rec + (ai * 128 + wr * 64 + m * 16 + fr) * 8))[1];
#pragma unroll
      for (int m = 0; m < 4; ++m) {
        const int gb = gwu[m]; const float us = rt ? U_SCALE * __builtin_bit_cast(float, gb) : U_SCALE;
#pragma unroll
        for (int bj = 0; bj < 2; ++bj) {
          const f32x4 g = acc[ai][bj][m][0], up = acc[ai][bj][m][1];
          float uu[4];
#pragma unroll
          for (int i = 0; i < 4; ++i) uu[i] = __builtin_amdgcn_fmed3f(siluf_(g[i]) * up[i] * us, -448.f, 448.f);
          const int w8 = cvt4_fp8(uu[0], uu[1], uu[2], uu[3]);
          *(LAS int*)(st + (wr * 64 + m * 16 + fr) * 144 + bj * 64 + wc * 16 + 4 * fq) = w8;
        }
      }
      EPI_BAR();
#pragma unroll
      for (int i = 0; i < 2; ++i) {
        const int row = (tid + 512 * i) >> 3;
        if (ok[ai][i]) { const u32x4 v = *(LAS const u32x4*)(st + row * 144 + c16 * 16); *(u32x4*)(U + dp[ai][i]) = v; }
      }
      EPI_BAR();
    }
  } };
__device__ __forceinline__ void phase7(const Params& p) {
  const int hf = 0; moe_prefix(p);
  const int routed = ((LAS const int*)(SMEM + LDS_PRE))[64];
  MoeOrder<127, 122, 2> S; S.R = routed + 256; S.nwg = S.R * 2; S.G = gridDim.x; S.c = blockIdx.x; S.hf = hf; S.mode = 0; S.rowbytes = 1024; S.routed = routed;
  S.cnt = (const unsigned*)(p.ws + OFF_CTL) + CW_CNT; S.list = (const int*)(p.ws + OFF_SORTED);
  S.W = (const char*)(p.ws + OFF_WGU); S.estride = (size_t)512 * 1024; S.tstride = (size_t)256 * 1024;
  EpiU E{p.ws + OFF_U, S.cnt, S.list, hf};
  pg8::gemm_phase<EpiU, MoeOrder<127, 122, 2>, true>(SMEM + LDS_PG8, (const bf16_t*)(p.ws + OFF_H2Q), 512, S, E);
}
#ifdef PROBE_WI
#define PWI PROBE_WI
#else
#define PWI 0
#endif
struct EpiYE { unsigned char* YE; const float* GW; const unsigned* cnt; const int* list; int hf; int pmode;
  __device__ __forceinline__ void operator()(const f32x4 (&acc)[2][2][4][2], const pg8::Unit& u, int wr, int wc, int fr, int fq, LAS const unsigned char* rec) const {
    const bool rt = u.e < 64;
    const int nrow = rt ? ((LAS const int*)(SMEM + LDS_PRE))[128 + u.e] : 0x7fffffff;
    LAS unsigned char* st = SMEM + LDS_EPI;
    const int tid = (wr * 4 + wc) * 64 + fq * 16 + fr;
    const int c16 = tid & 7;
    int ridx[2][2];
#pragma unroll
    for (int ai = 0; ai < 2; ++ai) {
#pragma unroll
      for (int i = 0; i < 2; ++i) ridx[ai][i] = *(LAS const int*)(rec + (ai * 128 + ((tid + 512 * i) >> 3)) * 8);
    }
    unsigned dp[2][2]; bool ok[2][2];
#pragma unroll
    for (int ai = 0; ai < 2; ++ai)
#pragma unroll
      for (int i = 0; i < 2; ++i) {
        const int li = u.lt * 256 + ai * 128 + ((tid + 512 * i) >> 3);
        ok[ai][i] = li < nrow;
        const int idx = ridx[ai][i];
        const int dst = rt ? ((idx >> 3) * 9 + (idx & 7)) : (li * 9 + 8);
        dp[ai][i] = (unsigned)dst * 1024u + (unsigned)(u.pn * 256 + c16 * 16);
      }
#pragma unroll
    for (int ai = 0; ai < 2; ++ai) {
#pragma unroll
      for (int bj = 0; bj < 2; ++bj) {
#pragma unroll
        for (int m = 0; m < 4; ++m) {
          const f32x4 v0 = acc[ai][bj][m][0], v1 = acc[ai][bj][m][1];
          float o[8];
#pragma unroll
          for (int i = 0; i < 4; ++i) { o[i] = v0[i]; o[4 + i] = v1[i]; }
          int w0 = 0, w1 = 0;
          if ((PWI & 64) && pmode) { w0 = __builtin_bit_cast(int, v0[0]); w1 = __builtin_bit_cast(int, v1[1]); } else {
#pragma unroll
          for (int i = 0; i < 8; ++i) o[i] = __builtin_amdgcn_fmed3f(o[i], -448.f, 448.f);
          if ((PWI & 512) && pmode) { v2i16_t q0 = {0, 0}, q1 = {0, 0};
            q0 = __builtin_amdgcn_cvt_scalef32_pk_fp8_f32(q0, o[0], o[1], 1.0f, false); q0 = __builtin_amdgcn_cvt_scalef32_pk_fp8_f32(q0, o[2], o[3], 1.0f, true);
            q1 = __builtin_amdgcn_cvt_scalef32_pk_fp8_f32(q1, o[4], o[5], 1.0f, false); q1 = __builtin_amdgcn_cvt_scalef32_pk_fp8_f32(q1, o[6], o[7], 1.0f, true);
            w0 = __builtin_bit_cast(int, q0); w1 = __builtin_bit_cast(int, q1); }
          else if ((PWI & 1024) && pmode) { v2i16_t q0 = {0, 0}, q1 = {0, 0};
            const unsigned b0 = pk2(o[0], o[1]), b1 = pk2(o[2], o[3]), b2 = pk2(o[4], o[5]), b3 = pk2(o[6], o[7]);
            q0 = __builtin_amdgcn_cvt_scalef32_pk_fp8_bf16(q0, __builtin_bit_cast(bf16x2_t, b0), 1.0f, false); q0 = __builtin_amdgcn_cvt_scalef32_pk_fp8_bf16(q0, __builtin_bit_cast(bf16x2_t, b1), 1.0f, true);
            q1 = __builtin_amdgcn_cvt_scalef32_pk_fp8_bf16(q1, __builtin_bit_cast(bf16x2_t, b2), 1.0f, false); q1 = __builtin_amdgcn_cvt_scalef32_pk_fp8_bf16(q1, __builtin_bit_cast(bf16x2_t, b3), 1.0f, true);
            w0 = __builtin_bit_cast(int, q0); w1 = __builtin_bit_cast(int, q1); }
          else           if ((PWI & 256) && pmode) { w0 = (int)(pk2(o[0], o[1]) ^ pk2(o[2], o[3])); w1 = (int)(pk2(o[4], o[5]) ^ pk2(o[6], o[7])); } else {
          w0 = cvt4_fp8(o[0], o[1], o[2], o[3]); w1 = cvt4_fp8(o[4], o[5], o[6], o[7]); } }
          u32x2 w; w.x = (unsigned)w0; w.y = (unsigned)w1;
          *(LAS u32x2*)(st + (wr * 64 + m * 16 + fr) * 144 + wc * 32 + 8 * fq) = w;
        }
        if (!(PWI & 128) || pmode == 0) EPI_BAR();
#pragma unroll
        for (int i = 0; i < 2; ++i) {
          const int row = (tid + 512 * i) >> 3;
          if (ok[ai][i]) {
            const u32x4 v = *(LAS const u32x4*)(st + row * 144 + c16 * 16);
            if (PROBE_DBL != 83 || pmode == 0 || v.x == 0x7fc12345u) *(u32x4*)(YE + (dp[ai][i] + (unsigned)(bj * 128))) = v;
          }
        }
        if (!(PWI & 128) || pmode == 0) EPI_BAR();
      }
    }
  } };
__device__ __forceinline__ void phase8(const Params& p, const int pmode = 0) {
  const int hf = 0; moe_prefix(p);
  const int routed = ((LAS const int*)(SMEM + LDS_PRE))[64];
  MoeOrder<125, 125, 4, true> S; S.R = routed + 256; S.nwg = S.R * 4; S.G = gridDim.x; S.c = blockIdx.x; S.hf = hf; S.mode = 1; S.rowbytes = 256; S.routed = routed;
  S.cnt = (const unsigned*)(p.ws + OFF_CTL) + CW_CNT; S.list = (const int*)(p.ws + OFF_SORTED);
  S.W = (const char*)(p.ws + OFF_WDN); S.estride = (size_t)1024 * 256; S.tstride = (size_t)256 * 256;
  EpiYE E{p.ws + OFF_YE, (const float*)(p.ws + OFF_GW), S.cnt, S.list, hf, pmode};
#ifdef PROBE_WI
  if (pmode) pg8::gemm_phase<EpiYE, MoeOrder<125, 125, 4, true>, true, PROBE_WI>(SMEM + LDS_PG8, (const bf16_t*)(p.ws + OFF_U), 128, S, E); else
#endif
  pg8::gemm_phase<EpiYE, MoeOrder<125, 125, 4, true>, true>(SMEM + LDS_PG8, (const bf16_t*)(p.ws + OFF_U), 128, S, E);
}
__device__ __forceinline__ void phase9(const Params& p) {
  const int tid_ = opaque_tid(); const int lane = tid_ & 63, gw = blockIdx.x * 8 + (tid_ >> 6), nw = gridDim.x * 8;
  const float* mod = (const float*)(p.ws + OFF_MOD);
  const unsigned char* YE = p.ws + OFF_YE;
  const int c = lane * 16;
  float4 gp[4];
#pragma unroll
  for (int i = 0; i < 4; ++i) gp[i] = *(const float4*)(p.g_ffn_post + c + 4 * i);
  u32x4 vn[9]; u32x4 xn[2];
  if (gw < T_TOK) {
#pragma unroll
    for (int s = 0; s < 9; ++s) vn[s] = *(const u32x4*)(YE + ((size_t)gw * 9 + s) * 1024 + c);
    xn[0] = *(const u32x4*)((const bf16_t*)(p.out + (size_t)gw * 1024) + c); xn[1] = *(const u32x4*)((const bf16_t*)(p.out + (size_t)gw * 1024) + c + 8);
  }
  for (int rep9 = ((PROBE_DBL == 9) ? 0 : 1); rep9 < 2; ++rep9)
#pragma unroll 1
  for (int row = gw; row < T_TOK; row += nw) {
    const int b = row >> 12;
    u32x4 vc[9]; u32x4 xc[2];
#pragma unroll
    for (int s = 0; s < 9; ++s) vc[s] = vn[s];
    xc[0] = xn[0]; xc[1] = xn[1];
    { const int rn = (row + nw < T_TOK) ? row + nw : row;
#pragma unroll
      for (int s = 0; s < 9; ++s) vn[s] = *(const u32x4*)(YE + ((size_t)rn * 9 + s) * 1024 + c);
      xn[0] = *(const u32x4*)((const bf16_t*)(p.out + (size_t)rn * 1024) + c); xn[1] = *(const u32x4*)((const bf16_t*)(p.out + (size_t)rn * 1024) + c + 8); }
    float acc[16];
#pragma unroll
    for (int i = 0; i < 16; ++i) acc[i] = 0.f;
#pragma unroll
    for (int s = 0; s < 9; ++s) {
      const unsigned vw[4] = {vc[s].x, vc[s].y, vc[s].z, vc[s].w};
#pragma unroll
      for (int k = 0; k < 4; ++k) {
        const f32x2 lo = __builtin_amdgcn_cvt_pk_f32_fp8((int)vw[k], false), hi = __builtin_amdgcn_cvt_pk_f32_fp8((int)vw[k], true);
        acc[4 * k] += lo[0]; acc[4 * k + 1] += lo[1]; acc[4 * k + 2] += hi[0]; acc[4 * k + 3] += hi[1];
      }
    }
    float ss = 0.f;
#pragma unroll
    for (int i = 0; i < 16; ++i) { acc[i] *= (1.0f / YE_SCALE); ss += acc[i] * acc[i]; }
    ss = wave_sum(ss);
    const float rs = rsqrtf(ss * (1.f / 1024.f) + EPS);
    float* op = p.out + (size_t)row * 1024 + c;
#pragma unroll
    for (int i = 0; i < 4; ++i) {
      const unsigned xw0 = (i == 0) ? xc[0].x : (i == 1) ? xc[0].z : (i == 2) ? xc[1].x : xc[1].z, xw1 = (i == 0) ? xc[0].y : (i == 1) ? xc[0].w : (i == 2) ? xc[1].y : xc[1].w;
      float4 x1 = make_float4(bflo(xw0), bfhi(xw0), bflo(xw1), bfhi(xw1));
      const float4 gt = *(const float4*)(mod + b * 6144 + 5120 + c + 4 * i);
      x1.x += gt.x * (acc[4 * i] * rs * gp[i].x); x1.y += gt.y * (acc[4 * i + 1] * rs * gp[i].y); x1.z += gt.z * (acc[4 * i + 2] * rs * gp[i].z); x1.w += gt.w * (acc[4 * i + 3] * rs * gp[i].w);
      if (rep9 == 1) *(float4*)(op + 4 * i) = x1; else if (x1.x == 123456.789f) *(float4*)(op + 4 * i) = x1;
    }
  }
}

#define DBL(n, call) do { call; if (PROBE_DBL == (n)) { xcd_barrier(bar); call; } } while (0)
#ifndef STOP_AFTER
#define STOP_AFTER 99
#endif
__global__ void __launch_bounds__(NTHR) fwd_kernel(Params p) {
  volatile LAS unsigned* st = (volatile LAS unsigned*)(SMEM + LDS_ST);
  if (threadIdx.x < 4) st[threadIdx.x] = 0u;
  __syncthreads();
  XcdBarrier bar = xcd_barrier_post((unsigned*)(p.ws + OFF_CTL) + CW_BAR, st);
  __syncthreads();
  DBL(0, phase0(p));  xcd_barrier(bar);
  DBL(1, phase1(p));  xcd_barrier(bar);
  DBL(2, phase2(p));  xcd_barrier(bar);
  DBL(20, phase2b(p)); xcd_barrier(bar);
  DBL(3, phase3(p));  xcd_barrier(bar);
  phase56(p); xcd_barrier(bar);
#ifdef PROBE_CLK
  long long pc0 = 0, pw0 = 0, pc1 = 0, pw1 = 0;
  if (PROBE_CLK == 7) { pc0 = clock64(); pw0 = wall_clock64(); }
#endif
  DBL(7, phase7(p)); xcd_barrier(bar);
  DBL(8, phase8(p)); if (PROBE_DBL == 83) { xcd_barrier(bar); phase8(p, 1); } xcd_barrier(bar);
#ifdef PROBE_CLK
  if (PROBE_CLK == 7) { pc1 = clock64(); pw1 = wall_clock64(); }
#endif
  phase9(p);
#ifdef PROBE_SAT
  {
    float a = 1000.f, b = 3.0e38f, c = 500.f, d = 448.f; asm volatile("" : "+v"(a), "+v"(b), "+v"(c), "+v"(d));
    const int r1 = cvt4_fp8(a, -a, c, d), r2 = cvt4_fp8(b, -b, 449.f + (a - 1000.f), -c);
    xcd_barrier(bar);
    if (blockIdx.x == 0 && threadIdx.x == 0 && (r1 != 0x7E7EFE7E || r2 != (int)0xFE7EFE7Eu)) p.out[0] = __builtin_nanf("");
  }
#endif
#ifdef PROBE_CLK
  if (blockIdx.x == 0 && threadIdx.x == 0) {
    const long long mhz = (pc1 - pc0) * 100 / (pw1 - pw0 + 1);
    const long long ticks = mhz * 25;
    const long long ts = wall_clock64();
    while (wall_clock64() - ts < ticks) __builtin_amdgcn_s_sleep(20);
  }
#endif
}

extern "C" void kernel_launch(void* const* d_in, const int* in_sizes, int n_in, void* d_out, int out_size, void* d_ws, size_t ws_size, hipStream_t stream) {
  static int grid_blocks = 0;
  if (!grid_blocks) {
    int dev = 0, cus = 0, per_cu = 0;
    (void)hipGetDevice(&dev);
    (void)hipDeviceGetAttribute(&cus, hipDeviceAttributeMultiprocessorCount, dev);
    (void)hipFuncSetAttribute((const void*)fwd_kernel, hipFuncAttributeMaxDynamicSharedMemorySize, LDS_BYTES);
    (void)hipOccupancyMaxActiveBlocksPerMultiprocessor(&per_cu, (const void*)fwd_kernel, NTHR, LDS_BYTES);
    grid_blocks = cus;
    if (per_cu < 1 || ws_size < WS_NEED || n_in != 25) fprintf(stderr, "kernel_launch: per_cu=%d ws=%zu need=%zu n_in=%d\n", per_cu, ws_size, (size_t)WS_NEED, n_in);
  }
  (void)hipMemsetAsync((char*)d_ws + OFF_CTL, 0, CTL_ZERO_BYTES, stream);
  Params p{};
  const float** f = (const float**)&p;
  for (int i = 0; i < 25; ++i) f[i] = (const float*)d_in[i];
  p.out = (float*)d_out; p.ws = (unsigned char*)d_ws;
  void* args[] = {&p};
  hipError_t e = hipLaunchCooperativeKernel((void*)fwd_kernel, dim3(grid_blocks), dim3(NTHR), args, LDS_BYTES, stream);
  if (e != hipSuccess) fprintf(stderr, "cooperative launch failed: %s (grid %d)\n", hipGetErrorString(e), grid_blocks);
}
```

```cpp
#include <hip/hip_runtime.h>
#include <cstdio>
#include <cstdint>
#ifndef PROBE_DBL
#define PROBE_DBL -1
#endif
#define LAS __attribute__((address_space(3)))
typedef unsigned short bf16_t;
typedef short bf16x8 __attribute__((ext_vector_type(8)));
typedef float f32x4 __attribute__((ext_vector_type(4)));
typedef unsigned u32x4 __attribute__((ext_vector_type(4)));
typedef unsigned u32x2 __attribute__((ext_vector_type(2)));
typedef short v4i16_t __attribute__((ext_vector_type(4)));

constexpr int T_TOK = 65536, DM = 1024, SEQ = 4096, NB = 16;
constexpr int NPROJ = 3328; constexpr int PLD = 3072;
constexpr float EPS = 1e-6f;
constexpr int NTHR = 512;
constexpr size_t MB = 1u << 20;
constexpr size_t OFF_CTL = 0;
constexpr size_t OFF_MOD = 64 * 1024;
constexpr size_t CTL_ZERO_BYTES = 64 * 1024 + 512 * 1024;
constexpr size_t OFF_ROPE = 1 * MB;
constexpr size_t OFF_WR = 2 * MB;
constexpr size_t OFF_WIN = 3 * MB;
constexpr size_t OFF_WOUT = 10 * MB;
constexpr size_t OFF_WGU = 12 * MB;
constexpr size_t OFF_WDN = 80 * MB;
constexpr size_t OFF_ACTA = 116 * MB;
constexpr size_t OFF_P = 244 * MB;
constexpr size_t OFF_PROJ = OFF_P + 0;
constexpr size_t OFF_MQKC = OFF_P + 384 * MB;
constexpr size_t OFF_AK = OFF_P + 512 * MB;
constexpr size_t OFF_IK = OFF_P + 528 * MB;
constexpr size_t OFF_GATES = OFF_P + 536 * MB;
constexpr size_t OFF_IW = OFF_P + 538 * MB;
constexpr size_t OFF_PROJL = OFF_P + 540 * MB;
constexpr size_t OFF_HMRAW = OFF_P + 572 * MB;
constexpr size_t OFF_BITM = OFF_P + 636 * MB;
constexpr size_t OFF_GL = OFF_P + 668 * MB;
constexpr size_t OFF_Y = OFF_P + 0;
constexpr size_t OFF_H2LO = OFF_P + 128 * MB;
constexpr size_t OFF_SORTED = 932 * MB;
constexpr size_t OFF_GW = OFF_P + 272 * MB;
constexpr size_t OFF_H2Q = 868 * MB;
constexpr size_t OFF_U = 724 * MB;
constexpr size_t OFF_YE = 120 * MB;
constexpr size_t WS_NEED = 964 * MB;
constexpr int CW_BAR = 0;
constexpr int CW_CNT = 4096;
constexpr int CW_Q = 4352;
constexpr float YE_SCALE = 16.0f;
constexpr float U_SCALE = 16.0f;

struct Params {
  const float *x, *c, *w_ada, *b_ada, *g_mix_pre, *g_mix_post, *g_ffn_pre, *g_ffn_post, *w_in, *conv_w, *conv_b, *b_igate, *b_fgate,
      *g_mlstm_head, *g_idx_k, *b_idx_k, *w_out, *w_router, *b_router, *w_exp_gate, *w_exp_up, *w_exp_down, *w_sh_gate, *w_sh_up, *w_sh_down;
  float* out; unsigned char* ws;
};

__device__ __forceinline__ unsigned f2bf(float f) { unsigned u = __builtin_bit_cast(unsigned, f); return (u + 0x7fffu + ((u >> 16) & 1u)) >> 16; }
typedef float f32x2_t __attribute__((ext_vector_type(2)));
typedef __bf16 bf16x2_t __attribute__((ext_vector_type(2)));
__device__ __forceinline__ unsigned pk2(float lo, float hi) { const f32x2_t v = {lo, hi}; const bf16x2_t b = __builtin_convertvector(v, bf16x2_t); return __builtin_bit_cast(unsigned, b); }
__device__ __forceinline__ float bf2f(unsigned h) { return __builtin_bit_cast(float, h << 16); }
__device__ __forceinline__ float bflo(unsigned w) { return __builtin_bit_cast(float, w << 16); }
__device__ __forceinline__ float bfhi(unsigned w) { return __builtin_bit_cast(float, w & 0xffff0000u); }
typedef short v2i16_t __attribute__((ext_vector_type(2)));
__device__ __forceinline__ int cvt4_fp8(float a, float b, float c, float d) {
  v2i16_t q = {0, 0};
  q = __builtin_amdgcn_cvt_scalef32_pk_fp8_f32(q, a, b, 1.0f, false);
  q = __builtin_amdgcn_cvt_scalef32_pk_fp8_f32(q, c, d, 1.0f, true);
  return __builtin_bit_cast(int, q);
}
__device__ __forceinline__ float mul_s(float a, float b) { float r; asm("v_mul_f32 %0, %1, %2" : "=v"(r) : "v"(a), "v"(b)); return r; }
__device__ __forceinline__ unsigned wave_incl_scan(unsigned x) {
  x += (unsigned)__builtin_amdgcn_update_dpp(0, (int)x, 0x111, 0xf, 0xf, false);
  x += (unsigned)__builtin_amdgcn_update_dpp(0, (int)x, 0x112, 0xf, 0xf, false);
  x += (unsigned)__builtin_amdgcn_update_dpp(0, (int)x, 0x114, 0xf, 0xf, false);
  x += (unsigned)__builtin_amdgcn_update_dpp(0, (int)x, 0x118, 0xf, 0xf, false);
  x += (unsigned)__builtin_amdgcn_update_dpp(0, (int)x, 0x142, 0xa, 0xf, false);
  x += (unsigned)__builtin_amdgcn_update_dpp(0, (int)x, 0x143, 0xc, 0xf, false);
  return x;
}
typedef unsigned u32x2s_t __attribute__((ext_vector_type(2)));
__device__ __forceinline__ float rowmax4(float v) {
  unsigned b = __builtin_bit_cast(unsigned, v);
  u32x2s_t r = __builtin_amdgcn_permlane16_swap(b, b, false, false);
  unsigned r0 = r.x, r1 = r.y;
  v = fmaxf(__builtin_bit_cast(float, r0), __builtin_bit_cast(float, r1));
  b = __builtin_bit_cast(unsigned, v);
  r = __builtin_amdgcn_permlane32_swap(b, b, false, false);
  r0 = r.x; r1 = r.y;
  return fmaxf(__builtin_bit_cast(float, r0), __builtin_bit_cast(float, r1));
}
__device__ __forceinline__ float rowsum4(float v) {
  unsigned b = __builtin_bit_cast(unsigned, v);
  u32x2s_t r = __builtin_amdgcn_permlane16_swap(b, b, false, false);
  unsigned r0 = r.x, r1 = r.y;
  v = __builtin_bit_cast(float, r0) + __builtin_bit_cast(float, r1);
  b = __builtin_bit_cast(unsigned, v);
  r = __builtin_amdgcn_permlane32_swap(b, b, false, false);
  r0 = r.x; r1 = r.y;
  return __builtin_bit_cast(float, r0) + __builtin_bit_cast(float, r1);
}
__device__ __forceinline__ float wave_sum(float v) {
#pragma unroll
  for (int m = 32; m >= 1; m >>= 1) v += __shfl_xor(v, m);
  return v;
}
__device__ __forceinline__ int opaque_tid() { int t = threadIdx.x; asm volatile("" : "+v"(t)); return t; }
__device__ __forceinline__ float sigmoidf_(float x) { return __builtin_amdgcn_rcpf(1.0f + __expf(-x)); }
__device__ __forceinline__ float siluf_(float x) { return x * __builtin_amdgcn_rcpf(1.0f + __expf(-x)); }

#define XB_TMO      128
#define XB_XCNT(j)  (256  + 64 * (j))
#define XB_XSUB(j)  (1280 + 64 * (j))
#define XB_XGEN(j)  (2304 + 64 * (j))
#define XB_TOP      3328
#define XB_TOPGEN   3392
#define XCD_BAR_WORDS 3456
#define XB_SPIN_CAP (1u << 24)
__device__ __forceinline__ unsigned xb_ld(unsigned* p)              { return __hip_atomic_load(p, __ATOMIC_RELAXED, __HIP_MEMORY_SCOPE_AGENT); }
__device__ __forceinline__ unsigned xb_add(unsigned* p, unsigned v) { return __hip_atomic_fetch_add(p, v, __ATOMIC_RELAXED, __HIP_MEMORY_SCOPE_AGENT); }
__device__ __forceinline__ unsigned xb_xcc_id() { return (unsigned)__builtin_amdgcn_s_getreg((3 << 11) | 20) & 0xFu; }
#define XB_SPIN(cond, bar) do { unsigned _sp = 0; while (cond) { __builtin_amdgcn_s_sleep(1); \
    if ((++_sp & 255u) == 0u) { if (xb_ld(&(bar)[XB_TMO])) break; if (_sp > XB_SPIN_CAP) { xb_add(&(bar)[XB_TMO], 1u); break; } } } } while (0)
struct XcdBarrier { unsigned* bar; volatile LAS unsigned* st; };
__device__ __forceinline__ XcdBarrier xcd_barrier_post(unsigned* bar, volatile LAS unsigned* st) {
    XcdBarrier b; b.bar = bar; b.st = st;
    if (threadIdx.x == 0) { const unsigned x = xb_xcc_id(); st[2] = x; (void)xb_add(&bar[XB_XCNT(x)], 1u); }
    return b;
}
__device__ __forceinline__ void xcd_barrier_complete(unsigned* bar, unsigned x, unsigned& nloc, unsigned& nx) {
    const unsigned G = gridDim.x * gridDim.y * gridDim.z;
    unsigned sum, cnt, mine, sp = 0u;
    for (;;) {
        sum = 0u; cnt = 0u; mine = 0u;
#pragma unroll
        for (unsigned j = 0; j < 16; ++j) { const unsigned c = xb_ld(&bar[XB_XCNT(j)]); sum += c; cnt += (c > 0u) ? 1u : 0u; mine = (j == x) ? c : mine; }
        if (sum == G) break;
        __builtin_amdgcn_s_sleep(1);
        if ((++sp & 255u) == 0u) { if (xb_ld(&bar[XB_TMO])) break; if (sp > XB_SPIN_CAP) { xb_add(&bar[XB_TMO], 1u); break; } }
    }
    nloc = mine > 0u ? mine : 1u; nx = cnt > 0u ? cnt : 1u;
}
__device__ __forceinline__ void xcd_barrier(const XcdBarrier& b) {
    asm volatile("s_waitcnt vmcnt(0)" ::: "memory");
    __syncthreads();
    if (threadIdx.x == 0) {
        unsigned* bar = b.bar;
        __builtin_amdgcn_s_waitcnt(0);
        unsigned nloc = b.st[0], nx = b.st[1]; const unsigned bx = b.st[2];
        if (nloc == 0u) { xcd_barrier_complete(bar, bx, nloc, nx); b.st[0] = nloc; b.st[1] = nx; }
        const unsigned old = xb_add(&bar[XB_XSUB(bx)], 1u);
        const unsigned gen = old / nloc;
        if (old + 1u == (gen + 1u) * nloc) {
            __builtin_amdgcn_fence(__ATOMIC_RELEASE, "agent");
            asm volatile("s_waitcnt vmcnt(0)" ::: "memory");
            const unsigned og = xb_add(&bar[XB_TOP], 1u);
            const unsigned tg = og / nx;
            if (og + 1u == (tg + 1u) * nx) xb_add(&bar[XB_TOPGEN], 1u);
            else XB_SPIN(xb_ld(&bar[XB_TOPGEN]) == tg, bar);
            __builtin_amdgcn_fence(__ATOMIC_ACQUIRE, "agent");
            xb_add(&bar[XB_XGEN(bx)], 1u);
            asm volatile("s_waitcnt vmcnt(0)" ::: "memory");
        } else {
            XB_SPIN(xb_ld(&bar[XB_XGEN(bx)]) == gen, bar);
            __builtin_amdgcn_fence(__ATOMIC_ACQUIRE, "agent");
            asm volatile("s_waitcnt vmcnt(0)" ::: "memory");
        }
    }
    __syncthreads();
}

extern __shared__ __attribute__((aligned(16))) unsigned char smem_raw[];
#define SMEM ((LAS unsigned char*)smem_raw)
constexpr int LDS_ST = 0;
constexpr int LDS_MISC = 16;
constexpr int LDS_MAIN = 1040;
constexpr int LDS_BYTES = 160 * 1024;
constexpr int GT_STAGE = 32768, TILE_LD = 132;
__device__ __forceinline__ int swz_off(int r, int c8) { return r * 128 + ((c8 ^ (r & 7)) << 4); }
template <int NSEG> struct GemmArgs { const bf16_t *A0, *A1, *A2, *B0, *B1, *B2; int lda, ldb, K; };

template <int NSEG, bool NTA = false>
__device__ __forceinline__ void gemm_mainloop(const GemmArgs<NSEG>& g, long arow0, long arow1) {
  const int tid = opaque_tid(), lane = tid & 63, wid = __builtin_amdgcn_readfirstlane(tid >> 6), wr = wid >> 2, wc = wid & 3, fr = lane & 15, fq = lane >> 4;
  const int r0 = tid >> 3, cs = ((tid & 7) ^ (r0 & 7)) * 8;
  const int nk = g.K >> 6, nsteps = NSEG * nk;
  f32x4 acc[4][2];
#pragma unroll
  for (int m = 0; m < 4; ++m)
#pragma unroll
    for (int n = 0; n < 2; ++n) acc[m][n] = (f32x4){0.f, 0.f, 0.f, 0.f};
  LAS unsigned char* ring = SMEM + LDS_MAIN;
#define GM_ISSUE(s_) do { int s1_ = (s_) < nsteps ? (s_) : nsteps - 1; int seg_ = 0, ks_ = s1_; if (NSEG > 1) { seg_ = s1_ / nk; ks_ = s1_ - seg_ * nk; } \
    const bf16_t* Ap_ = g.A0; const bf16_t* Bp_ = g.B0; if (NSEG > 1) { if (seg_ == 1) { Ap_ = g.A1; Bp_ = g.B1; } else if (seg_ == 2) { Ap_ = g.A2; Bp_ = g.B2; } } \
    LAS unsigned char* st_ = ring + ((s_) & 3) * GT_STAGE + wid * 1024; const int k0_ = ks_ * 64 + cs; \
    if (NTA) { __builtin_amdgcn_global_load_lds((const unsigned*)(Ap_ + arow0 * g.lda + k0_), (LAS unsigned*)st_, 16, 0, 2); __builtin_amdgcn_global_load_lds((const unsigned*)(Ap_ + arow1 * g.lda + k0_), (LAS unsigned*)(st_ + 8192), 16, 0, 2); } \
    else { __builtin_amdgcn_global_load_lds((const unsigned*)(Ap_ + arow0 * g.lda + k0_), (LAS unsigned*)st_, 16, 0, 0); __builtin_amdgcn_global_load_lds((const unsigned*)(Ap_ + arow1 * g.lda + k0_), (LAS unsigned*)(st_ + 8192), 16, 0, 0); } \
    __builtin_amdgcn_global_load_lds((const unsigned*)(Bp_ + (long)r0 * g.ldb + k0_), (LAS unsigned*)(st_ + 16384), 16, 0, 0); \
    __builtin_amdgcn_global_load_lds((const unsigned*)(Bp_ + (long)(r0 + 64) * g.ldb + k0_), (LAS unsigned*)(st_ + 16384 + 8192), 16, 0, 0); } while (0)
  asm volatile("s_waitcnt vmcnt(0)" ::: "memory");
  GM_ISSUE(0); GM_ISSUE(1); GM_ISSUE(2);
#pragma unroll 1
  for (int s = 0; s < nsteps; ++s) {
    asm volatile("s_waitcnt vmcnt(8)" ::: "memory");
    asm volatile("s_waitcnt lgkmcnt(0)" ::: "memory");
    __builtin_amdgcn_s_barrier();
    GM_ISSUE(s + 3);
    LAS unsigned char* sa = ring + (s & 3) * GT_STAGE;
    LAS unsigned char* sb = sa + 16384;
#pragma unroll
    for (int kk = 0; kk < 2; ++kk) {
      bf16x8 af[4], bfr[2];
#pragma unroll
      for (int m = 0; m < 4; ++m) af[m] = *(LAS bf16x8*)(sa + swz_off(wr * 64 + m * 16 + fr, kk * 4 + fq));
#pragma unroll
      for (int n = 0; n < 2; ++n) bfr[n] = *(LAS bf16x8*)(sb + swz_off(wc * 32 + n * 16 + fr, kk * 4 + fq));
#pragma unroll
      for (int m = 0; m < 4; ++m)
#pragma unroll
        for (int n = 0; n < 2; ++n) acc[m][n] = __builtin_amdgcn_mfma_f32_16x16x32_bf16(af[m], bfr[n], acc[m][n], 0, 0, 0);
    }
  }
#undef GM_ISSUE
  asm volatile("s_waitcnt vmcnt(0)" ::: "memory");
  asm volatile("s_waitcnt lgkmcnt(0)" ::: "memory");
  __builtin_amdgcn_s_barrier();
  LAS float* tile = (LAS float*)(SMEM + LDS_MAIN);
#pragma unroll
  for (int m = 0; m < 4; ++m)
#pragma unroll
    for (int n = 0; n < 2; ++n)
#pragma unroll
      for (int j = 0; j < 4; ++j) tile[(wr * 64 + m * 16 + fq * 4 + j) * TILE_LD + wc * 32 + n * 16 + fr] = acc[m][n][j];
  __syncthreads();
}
template <int NSEG, class Epi>
__device__ __forceinline__ void gemm_tile(const GemmArgs<NSEG>& g, long arow0, long arow1, Epi&& epi) {
  gemm_mainloop<NSEG>(g, arow0, arow1);
  LAS const float* tile = (LAS const float*)(SMEM + LDS_MAIN);
  const int tid = opaque_tid();
#pragma unroll 1
  for (int i = 0; i < 4; ++i) { const int id = tid + i * NTHR; epi(tile, id >> 4, (id & 15) * 8); }
  __syncthreads();
}
__device__ __forceinline__ u32x4 pack8(LAS const float* p) {
  const f32x4 v0 = *(LAS const f32x4*)p, v1 = *(LAS const f32x4*)(p + 4);
  u32x4 w; w.x = pk2(v0[0], v0[1]); w.y = pk2(v0[2], v0[3]); w.z = pk2(v1[0], v1[1]); w.w = pk2(v1[2], v1[3]); return w;
}

__device__ __forceinline__ int win_rowmap(int n) {
  if (n < 2048) return n;
  if (n < 2056) return 3136 + (n - 2048);
  if (n < 2568) return 2048 + (n - 2056);
  if (n < 2696) return 2560 + (n - 2568);
  if (n < 2824) return 2688 + (n - 2696);
  if (n < 3080) return 2816 + (n - 2824);
  if (n < 3144) return 3072 + (n - 3080);
  return n;
}
template <int KIND, int MODE>
__device__ __forceinline__ void cvt_tile(const float* src, int ld_src, int nvalid, int k0, int n0, bf16_t* dst, int ld_dst) {
  LAS bf16_t* tt = (LAS bf16_t*)(SMEM + LDS_MAIN);
  const int tid = opaque_tid();
  {
    const int n = tid & 63, kb = tid >> 6;
    const bool ok = (n0 + n) < nvalid;
#pragma unroll
    for (int i = 0; i < 8; ++i) {
      const int k = kb + 8 * i;
      float v = ok ? src[(long)(k0 + k) * ld_src + n0 + n] : 0.f;
      unsigned h = f2bf(v);
      if (MODE == 1) h = f2bf(v - bf2f(h));
      tt[n * 72 + k] = (bf16_t)h;
    }
  }
  __syncthreads();
  {
    const int n = tid >> 3, kc = tid & 7; const int nn = n0 + n;
    int r;
    if (KIND == 0) r = nn; else if (KIND == 1) r = win_rowmap(nn); else if (KIND == 2) r = (nn >> 2) * 8 + (nn & 3); else r = (nn >> 2) * 8 + 4 + (nn & 3);
    const u32x4 v = *(LAS const u32x4*)(tt + n * 72 + kc * 8);
    *(u32x4*)(dst + (long)r * ld_dst + k0 + kc * 8) = v;
  }
  __syncthreads();
}
template <int KIND>
__device__ __forceinline__ void cvt_tile8(const float* src, int ld_src, int k0, int n0, unsigned char* dst, int ld_dst, float scale) {
  LAS unsigned char* tt = SMEM + LDS_MAIN;
  const int tid = opaque_tid();
  {
    const int n = tid & 63, kb = tid >> 6;
#pragma unroll
    for (int i = 0; i < 4; ++i) {
      const int k = kb * 2 + 16 * i;
      const float v0 = __builtin_amdgcn_fmed3f(src[(long)(k0 + k) * ld_src + n0 + n] * scale, -448.f, 448.f), v1 = __builtin_amdgcn_fmed3f(src[(long)(k0 + k + 1) * ld_src + n0 + n] * scale, -448.f, 448.f);
      v2i16_t wq = {0, 0}; wq = __builtin_amdgcn_cvt_scalef32_pk_fp8_f32(wq, v0, v1, 1.0f, false); const int w = __builtin_bit_cast(int, wq);
      *(LAS unsigned short*)(tt + n * 80 + k) = (unsigned short)(w & 0xffff);
    }
  }
  __syncthreads();
  if (tid < 256) {
    const int n = tid >> 2, kc = tid & 3; const int nn = n0 + n;
    int r;
    if (KIND == 0) r = nn; else if (KIND == 2) r = (nn >> 2) * 8 + (nn & 3); else r = (nn >> 2) * 8 + 4 + (nn & 3);
    const u32x4 v = *(LAS const u32x4*)(tt + n * 80 + kc * 16);
    *(u32x4*)(dst + (long)r * ld_dst + k0 + kc * 16) = v;
  }
  __syncthreads();
}
__device__ __forceinline__ void sincos_d(double a, float& s, float& c) {
  const double twopi = 6.283185307179586476925286766559, inv = 0.15915494309189533576888376337251;
  const double k = __builtin_rint(a * inv);
  const double r = a - k * twopi;
  const double r2 = r * r;
  double ts = 1.0, tc = 1.0, ss = 1.0, cs = 1.0;
#pragma unroll
  for (int i = 1; i <= 13; ++i) { tc = -tc * r2 / (double)((2 * i - 1) * (2 * i)); cs += tc; ts = -ts * r2 / (double)((2 * i) * (2 * i + 1)); ss += ts; }
  s = (float)(r * ss); c = (float)cs;
}
__device__ __forceinline__ void phase0(const Params& p) {
  unsigned char* ws = p.ws;
  const int tid = opaque_tid();
  constexpr int U_WIN = 16 * 52, U_WOUT = 256, U_EG = 65 * 64, U_EU = 65 * 64, U_ED = 65 * 64, U_R = 64, U_ADA = 48, U_ROPE = 192;
  constexpr int B1 = U_WIN, B2 = B1 + U_WOUT, B3 = B2 + U_EG, B4 = B3 + U_EU, B5 = B4 + U_ED, B6 = B5 + U_R, B7 = B6 + U_ADA, B8 = B7 + U_ROPE;
  for (int u = blockIdx.x; u < B8; u += gridDim.x) {
    if (u < B1) { const int kt = u / 52, nt = u % 52; cvt_tile<1, 0>(p.w_in, 3148, 3148, kt * 64, nt * 64, (bf16_t*)(ws + OFF_WIN), 1024); }
    else if (u < B2) { const int v = u - B1, kt = v >> 4, nt = v & 15; cvt_tile<0, 0>(p.w_out, 1024, 1024, kt * 64, nt * 64, (bf16_t*)(ws + OFF_WOUT), 1024); }
    else if (u < B4) {
      const bool up = u >= B3; const int v = up ? u - B3 : u - B2; const int e = v >> 6, kt = (v >> 2) & 15, nt = v & 3;
      const float* src = (e < 64) ? ((up ? p.w_exp_up : p.w_exp_gate) + (size_t)e * 1024 * 256) : (up ? p.w_sh_up : p.w_sh_gate);
      unsigned char* dst = ws + OFF_WGU + (size_t)e * 512 * 1024;
      if (up) cvt_tile8<3>(src, 256, kt * 64, nt * 64, dst, 1024, 32.0f); else cvt_tile8<2>(src, 256, kt * 64, nt * 64, dst, 1024, 32.0f);
    }
    else if (u < B5) {
      const int v = u - B4; const int e = v >> 6, kt = (v >> 4) & 3, nt = v & 15;
      const float* src = (e < 64) ? (p.w_exp_down + (size_t)e * 256 * 1024) : p.w_sh_down;
      cvt_tile8<0>(src, 1024, kt * 64, nt * 64, ws + OFF_WDN + (size_t)e * 1024 * 256, 256, 16.0f);
    }
    else if (u < B6) {
      const int v = u - B5; const int lo = v >> 5, kt = (v >> 1) & 15, nt = v & 1;
      bf16_t* dst = (bf16_t*)(ws + OFF_WR) + (size_t)lo * 128 * 1024;
      if (lo) cvt_tile<0, 1>(p.w_router, 64, 64, kt * 64, nt * 64, dst, 1024); else cvt_tile<0, 0>(p.w_router, 64, 64, kt * 64, nt * 64, dst, 1024);
    }
    else if (u < B7) {
      const int v = u - B6;
      LAS float* sc = (LAS float*)(SMEM + LDS_MAIN);
      LAS float* part = sc + 16 * 1024;
      for (int i = tid; i < 16 * 1024; i += NTHR) sc[i] = siluf_(p.c[i]);
      __syncthreads();
      const int jl = tid & 127, dq = tid >> 7, j = v * 128 + jl;
      float acc[16];
#pragma unroll
      for (int b = 0; b < 16; ++b) acc[b] = 0.f;
      const float* wp = p.w_ada + (size_t)(dq * 256) * 6144 + j;
#pragma unroll 4
      for (int d = 0; d < 256; ++d) {
        const float w = wp[(size_t)d * 6144];
#pragma unroll
        for (int b = 0; b < 16; ++b) acc[b] += sc[b * 1024 + dq * 256 + d] * w;
      }
#pragma unroll
      for (int b = 0; b < 16; ++b) part[(dq * 16 + b) * 128 + jl] = acc[b];
      __syncthreads();
      float* mod = (float*)(ws + OFF_MOD);
      for (int i = tid; i < 16 * 128; i += NTHR) {
        const int b = i >> 7, jj = i & 127;
        mod[b * 6144 + v * 128 + jj] = ((part[(0 * 16 + b) * 128 + jj] + part[(1 * 16 + b) * 128 + jj]) + (part[(2 * 16 + b) * 128 + jj] + part[(3 * 16 + b) * 128 + jj])) + p.b_ada[v * 128 + jj];
      }
      __syncthreads();
    }
    else {
      const int v = u - B7; const int idx = v * NTHR + tid;
      const int pos = idx / 24, f = idx - pos * 24;
      const double lt = 13.122363377404328;
      float s, c;
      if (f < 16) { const double inv = exp(-lt * (double)f * (2.0 / 32.0)); sincos_d((double)pos * inv, s, c);
        float* R = (float*)(ws + OFF_ROPE); R[(pos * 16 + f) * 2] = c; R[(pos * 16 + f) * 2 + 1] = s; }
      else { const int g = f - 16; const double inv = exp(-lt * (double)g * (2.0 / 16.0)); sincos_d((double)pos * inv, s, c);
        float* R = (float*)(ws + OFF_ROPE) + 4096 * 32; R[(pos * 8 + g) * 2] = c; R[(pos * 8 + g) * 2 + 1] = s; }
    }
  }
}
namespace pg8 {
constexpr int BM = 256, BK = 64, HALF = 128, HTB = HALF * BK * 2, STAGE_BYTES = 8 * HTB;
__device__ __forceinline__ int lds_byte(int r, int c) { const int st = (r >> 4) * 2 + (c >> 5), rr = r & 15, cc = c & 31, ob = rr * 64 + cc * 2; return st * 1024 + (ob ^ (((ob >> 9) & 1) << 5)); }
__device__ __forceinline__ void stage_rc(int b, int& R, int& C) { const int st = b / 1024, sb = b % 1024, swz = sb ^ (((sb >> 9) & 1) << 5); R = (st >> 1) * 16 + swz / 64; C = (st & 1) * 32 + (swz % 64) / 2; }
__device__ __forceinline__ int perm32(int rho) { const int n = rho >> 4, i = rho & 15; return 8 * (i >> 2) + 4 * n + (i & 3); }
struct Unit { int pm, pn, e, lt; };
typedef int v8i_t __attribute__((ext_vector_type(8)));
typedef int v4i_t __attribute__((ext_vector_type(4)));
template <class Epi, class Sched, bool FP8 = false, int WI = 0>
__device__ __forceinline__ void gemm_phase(LAS unsigned char* lds, const bf16_t* Abase, const int K, const Sched& S, const Epi& E) {
    const int tid = opaque_tid(), wid = __builtin_amdgcn_readfirstlane(tid >> 6), lane = tid & 63, wr = wid >> 2, wc = wid & 3, fr = lane & 15, fq = lane >> 4;
    const int nt = K / BK;
    int Rr[2], Cc[2]; unsigned voffB[2];
#pragma unroll
    for (int i = 0; i < 2; ++i) { int R, C; stage_rc(tid * 16 + i * 8192, R, C); Rr[i] = R; Cc[i] = C * 2; const int Rb = (R & ~31) + perm32(R & 31); voffB[i] = (unsigned)(Rb * K + C) * 2u; }
    const size_t kstep = (size_t)(BK * 2);
    const size_t hstep = (size_t)HALF * K * 2;
    const unsigned ldsw = (unsigned)wid * 1024u;
    const int aoff = lds_byte(wr * 64 + fr, fq * 8), boff = lds_byte(wc * 32 + fr, fq * 8);
    const char* Ab = (const char*)Abase;
    LAS unsigned char* recb = lds + STAGE_BYTES;
#define PG8_RECISSUE(u_, slot_) do { if (Sched::REC) __builtin_amdgcn_global_load_lds((const unsigned*)(S.rec_ptr(u_) + tid * 4), (LAS unsigned*)(recb + (slot_) * 2048 + wid * 256), 4, 0, 0); } while (0)
#define PG8_AOFF(u_, slot_, row_) ((Sched::REC && S.has_rec(u_)) ? S.a_off_idx(u_, row_, *(const LAS int*)(recb + (slot_) * 2048 + (S.row_valid(u_, row_) ? (row_) : 0) * 8)) : S.a_off(u_, row_))
#define PG8_SA(b, h) (((b) * 2 + (h)) * HTB)
#define PG8_SB(b, h) ((4 + (b) * 2 + (h)) * HTB)
#define PG8_STAGEB(bufoff, gbase) do { if (!(WI & 2)) _Pragma("unroll") for (int _i = 0; _i < 2; ++_i) \
        __builtin_amdgcn_global_load_lds((const unsigned*)((const char*)(gbase) + voffB[_i]), (LAS unsigned*)(lds + (bufoff) + ldsw + _i * 8192), 16, 0, 0); } while (0)
#define PG8_STAGEA(bufoff, koff, o0, o1) do { if (!(WI & 1)) { \
        __builtin_amdgcn_global_load_lds((const unsigned*)(Ab + (koff) + (o0)), (LAS unsigned*)(lds + (bufoff) + ldsw), 16, 0, 0); \
        __builtin_amdgcn_global_load_lds((const unsigned*)(Ab + (koff) + (o1)), (LAS unsigned*)(lds + (bufoff) + ldsw + 8192), 16, 0, 0); } } while (0)
#define PG8_LDA(dst, b, h) do { if (!(WI & 8)) _Pragma("unroll") for (int m = 0; m < 4; ++m) { dst[m].lo = *(const LAS v4i_t*)(lds + PG8_SA(b, h) + aoff + m * 2048); dst[m].hi = *(const LAS v4i_t*)(lds + PG8_SA(b, h) + aoff + m * 2048 + 1024); } } while (0)
#define PG8_LDB(dst, b, h) do { if (!(WI & 8)) _Pragma("unroll") for (int n = 0; n < 2; ++n) { dst[n].lo = *(const LAS v4i_t*)(lds + PG8_SB(b, h) + boff + n * 2048); dst[n].hi = *(const LAS v4i_t*)(lds + PG8_SB(b, h) + boff + n * 2048 + 1024); } } while (0)
#define PG8_MMA(ai, bj, At, Bt) do { __builtin_amdgcn_s_setprio(1); if (!(WI & 16)) _Pragma("unroll") for (int m = 0; m < 4; ++m) _Pragma("unroll") for (int n = 0; n < 2; ++n) { \
        if (FP8) asm volatile("v_mfma_scale_f32_16x16x128_f8f6f4 %0, %1, %2, %0, %3, %4 op_sel_hi:[0,0,0]" : "+v"(acc[ai][bj][m][n]) : "v"(Bt[n]), "v"(At[m]), "v"(sclB), "v"(sclA)); \
        else { const v4i_t bl_ = Bt[n].lo, bh_ = Bt[n].hi, al_ = At[m].lo, ah_ = At[m].hi;     \
               acc[ai][bj][m][n] = __builtin_amdgcn_mfma_f32_16x16x32_bf16(__builtin_bit_cast(bf16x8, bl_), __builtin_bit_cast(bf16x8, al_), acc[ai][bj][m][n], 0, 0, 0); \
               acc[ai][bj][m][n] = __builtin_amdgcn_mfma_f32_16x16x32_bf16(__builtin_bit_cast(bf16x8, bh_), __builtin_bit_cast(bf16x8, ah_), acc[ai][bj][m][n], 0, 0, 0); } } \
        __builtin_amdgcn_s_setprio(0); } while (0)
#define PG8_WAIT_V(n) asm volatile("s_waitcnt vmcnt(" #n ")" ::: "memory")
#define PG8_WAIT_VF(f) do { if (Sched::BSTAT && (f)) asm volatile("s_waitcnt vmcnt(4)" ::: "memory"); else asm volatile("s_waitcnt vmcnt(8)" ::: "memory"); } while (0)
#define PG8_WAIT_VG(f) do { if (Sched::BSTAT && (f)) asm volatile("s_waitcnt vmcnt(5)" ::: "memory"); else asm volatile("s_waitcnt vmcnt(8)" ::: "memory"); } while (0)
#define PG8_WAIT_L(n) asm volatile("s_waitcnt lgkmcnt(" #n ")" ::: "memory")
#define PG8_BAR do { if (!(WI & 32)) __builtin_amdgcn_s_barrier(); } while (0)
#define PG8_SCHED __builtin_amdgcn_sched_barrier(0)
    Unit cur, nxt; int ui = 0;
    if (!S.next(0, cur)) return;
    f32x4 acc[2][2][4][2];
#pragma unroll
    for (int a = 0; a < 2; ++a)
#pragma unroll
        for (int b = 0; b < 2; ++b)
#pragma unroll
            for (int m = 0; m < 4; ++m)
#pragma unroll
                for (int n = 0; n < 2; ++n) acc[a][b][m][n] = (f32x4){0.f, 0.f, 0.f, 0.f};
    v8i_t At[4], B0[2], B1[2];
    if (WI & 8) { _Pragma("unroll") for (int m = 0; m < 4; ++m) At[m] = (v8i_t){tid, m, 3, 4, 5, 6, 7, 8}; B0[0] = B0[1] = B1[0] = B1[1] = (v8i_t){tid, 1, 2, 3, 4, 5, 6, 7}; }
    int sclA = Sched::SCALE_A, sclB = Sched::SCALE_B; asm volatile("" : "+v"(sclA), "+v"(sclB));
    const char* cB = S.b_base(cur);
    Unit nn; bool has_nn = false;
    if (Sched::REC) { has_nn = S.next(1, nn); PG8_RECISSUE(cur, 0); PG8_RECISSUE(has_nn ? nn : cur, 1); asm volatile("s_waitcnt vmcnt(0)" ::: "memory"); __syncthreads(); }
    unsigned vc00 = PG8_AOFF(cur, 0, Rr[0]) + Cc[0], vc01 = PG8_AOFF(cur, 0, Rr[1]) + Cc[1], vc10 = PG8_AOFF(cur, 0, HALF + Rr[0]) + Cc[0], vc11 = PG8_AOFF(cur, 0, HALF + Rr[1]) + Cc[1];
    int slot = 0; bool skp = false;
    PG8_STAGEB(PG8_SB(0, 0), cB); PG8_STAGEB(PG8_SB(0, 1), cB + hstep); PG8_STAGEA(PG8_SA(0, 0), 0, vc00, vc01); PG8_STAGEA(PG8_SA(0, 1), 0, vc10, vc11);
    if (wr == 1) PG8_BAR;
    PG8_WAIT_V(2); PG8_BAR;
    PG8_STAGEB(PG8_SB(1, 0), cB + kstep); PG8_STAGEA(PG8_SA(1, 0), kstep, vc00, vc01); PG8_STAGEB(PG8_SB(1, 1), cB + hstep + kstep);
    PG8_WAIT_V(6); PG8_BAR;
    for (;;) {
        bool has_next;
        if (Sched::REC) { has_next = has_nn; nxt = nn; has_nn = S.next(ui + 2, nn); } else has_next = S.next(ui + 1, nxt);
        const char* nB = has_next ? S.b_base(nxt) : cB;
        unsigned vn00 = vc00, vn01 = vc01, vn10 = vc10, vn11 = vc11;
        const int nslot = (slot + 1) & 3;
        if (Sched::REC) { PG8_RECISSUE(has_nn ? nn : cur, (slot + 2) & 3); }
        else if (has_next) { vn00 = S.a_off(nxt, Rr[0]) + Cc[0]; vn01 = S.a_off(nxt, Rr[1]) + Cc[1]; vn10 = S.a_off(nxt, HALF + Rr[0]) + Cc[0]; vn11 = S.a_off(nxt, HALF + Rr[1]) + Cc[1]; }
#pragma unroll 1
        for (int t = 0; t < nt; t += 2) {
            const bool last = (t == nt - 2);
            const bool skb = Sched::BSTAT && last && has_next && (nB == cB);
            const size_t ko1 = (size_t)(t + 1) * kstep;
            const size_t ko2 = last ? 0 : (size_t)(t + 2) * kstep, ko3 = ko2 + kstep;
            const char* b2 = last ? nB : cB + (size_t)(t + 2) * kstep; const char* b3 = b2 + kstep;
            if (Sched::REC && last && has_next) {
                if (S.has_rec(nxt)) {
                    const int nv = S.nvalid(nxt); LAS const unsigned char* rb = recb + nslot * 2048;
                    const int q00 = Rr[0] < nv ? Rr[0] : 0, q01 = Rr[1] < nv ? Rr[1] : 0, q10 = (HALF + Rr[0]) < nv ? (HALF + Rr[0]) : 0, q11 = (HALF + Rr[1]) < nv ? (HALF + Rr[1]) : 0;
                    const int i00 = *(LAS const int*)(rb + q00 * 8), i01 = *(LAS const int*)(rb + q01 * 8), i10 = *(LAS const int*)(rb + q10 * 8), i11 = *(LAS const int*)(rb + q11 * 8);
                    vn00 = S.a_off_idx(nxt, 0, i00) + Cc[0]; vn01 = S.a_off_idx(nxt, 0, i01) + Cc[1]; vn10 = S.a_off_idx(nxt, 0, i10) + Cc[0]; vn11 = S.a_off_idx(nxt, 0, i11) + Cc[1];
                } else { vn00 = S.a_off(nxt, Rr[0]) + Cc[0]; vn01 = S.a_off(nxt, Rr[1]) + Cc[1]; vn10 = S.a_off(nxt, HALF + Rr[0]) + Cc[0]; vn11 = S.a_off(nxt, HALF + Rr[1]) + Cc[1]; }
            }
            const unsigned o00 = last ? vn00 : vc00, o01 = last ? vn01 : vc01, o10 = last ? vn10 : vc10, o11 = last ? vn11 : vc11;
            PG8_LDB(B0, 0, 0); PG8_LDB(B1, 0, 1); PG8_SCHED; PG8_LDA(At, 0, 0); PG8_STAGEA(PG8_SA(1, 1), ko1, vc10, vc11);
            PG8_WAIT_VG(skp); PG8_WAIT_L(0); PG8_BAR; PG8_MMA(0, 0, At, B0); PG8_MMA(0, 1, At, B1); PG8_BAR; PG8_SCHED;
            PG8_LDA(At, 0, 1); if (!skb) { PG8_STAGEB(PG8_SB(0, 0), b2); PG8_STAGEB(PG8_SB(0, 1), b2 + hstep); } PG8_STAGEA(PG8_SA(0, 0), ko2, o00, o01);
            PG8_WAIT_VG(skb); PG8_WAIT_L(0); PG8_BAR; PG8_MMA(1, 0, At, B0); PG8_MMA(1, 1, At, B1); PG8_BAR; PG8_SCHED;
            PG8_LDB(B0, 1, 0); PG8_LDB(B1, 1, 1); PG8_SCHED; PG8_LDA(At, 1, 0); PG8_STAGEA(PG8_SA(0, 1), ko2, o10, o11);
            PG8_WAIT_VF(skb); PG8_WAIT_L(0); PG8_BAR; PG8_MMA(0, 0, At, B0); PG8_MMA(0, 1, At, B1); PG8_BAR; PG8_SCHED;
            PG8_LDA(At, 1, 1); if (!skb) { PG8_STAGEB(PG8_SB(1, 0), b3); PG8_STAGEB(PG8_SB(1, 1), b3 + hstep); } PG8_STAGEA(PG8_SA(1, 0), ko3, o00, o01);
            PG8_WAIT_VF(skb); PG8_WAIT_L(0);
            skp = skb; PG8_BAR; PG8_MMA(1, 0, At, B0); PG8_MMA(1, 1, At, B1); PG8_BAR; PG8_SCHED;
        }
        if (wr == 0) PG8_BAR;
        if (FP8) asm volatile("s_nop 15\n\ts_nop 15" ::: "memory");
        if (!(WI & 4)) E(acc, cur, wr, wc, fr, fq, (LAS const unsigned char*)(recb + slot * 2048));
        if (PROBE_DBL == 81 && FP8 && K == 128) E(acc, cur, wr, wc, fr, fq, (LAS const unsigned char*)(recb + slot * 2048));
        if (PROBE_DBL == 71 && FP8 && K == 512) E(acc, cur, wr, wc, fr, fq, (LAS const unsigned char*)(recb + slot * 2048));
        if (!has_next) break;
#pragma unroll
        for (int a = 0; a < 2; ++a)
#pragma unroll
            for (int b = 0; b < 2; ++b)
#pragma unroll
                for (int m = 0; m < 4; ++m)
#pragma unroll
                    for (int n = 0; n < 2; ++n) acc[a][b][m][n] = (f32x4){0.f, 0.f, 0.f, 0.f};
        cur = nxt; cB = nB; vc00 = vn00; vc01 = vn01; vc10 = vn10; vc11 = vn11; ++ui; slot = nslot;
        if (wr == 1) PG8_BAR;
    }
    PG8_WAIT_V(0);
    PG8_BAR;
#undef PG8_SA
#undef PG8_RECISSUE
#undef PG8_AOFF
#undef PG8_SB
#undef PG8_STAGEA
#undef PG8_STAGEB
#undef PG8_LDA
#undef PG8_LDB
#undef PG8_MMA
#undef PG8_WAIT_V
#undef PG8_WAIT_VF
#undef PG8_WAIT_VG
#undef PG8_WAIT_L
#undef PG8_BAR
#undef PG8_SCHED
}
struct DenseOrder {
    static constexpr bool REC = false, BSTAT = false; static constexpr int SCALE_A = 0, SCALE_B = 0;
    int nM, nN, nwg, G, c; const char* Bt; int K;
    __device__ __forceinline__ const char* rec_ptr(const Unit&) const { return nullptr; }
    __device__ __forceinline__ bool has_rec(const Unit&) const { return false; }
    __device__ __forceinline__ bool row_valid(const Unit&, int) const { return true; }
    __device__ __forceinline__ int nvalid(const Unit&) const { return 256; }
    __device__ __forceinline__ unsigned a_off_idx(const Unit&, int, int) const { return 0u; }
    __device__ void init(int M, int N, int K_, const bf16_t* Bt_, int G_, int c_) { nM = M / BM; nN = N / BM; nwg = nM * nN; G = G_; c = c_; Bt = (const char*)Bt_; K = K_; }
    __device__ __forceinline__ bool next(int i, Unit& u) const {
        const long L = (long)i * G + c; if (L >= nwg) return false;
        int wgid = (int)L; { const int q = nwg / 8, r = nwg % 8, xcd = wgid % 8, off = wgid / 8; wgid = (xcd < r ? xcd * (q + 1) : r * (q + 1) + (xcd - r) * q) + off; }
        const int nig = 8 * nN, gid = wgid / nig, fm = gid * 8, gsz = (nM - fm) < 8 ? (nM - fm) : 8;
        u.pm = fm + ((wgid % nig) % gsz); u.pn = (wgid % nig) / gsz; u.e = 0; u.lt = 0; return true;
    }
    __device__ __forceinline__ const char* b_base(const Unit& u) const { return Bt + (size_t)u.pn * BM * K * 2; }
    __device__ __forceinline__ unsigned a_off(const Unit& u, int row) const { return (unsigned)(u.pm * BM + row) * (unsigned)(K * 2); }
};
__device__ __forceinline__ unsigned cvt_pk_bf16(float lo, float hi) { return pk2(lo, hi); }
struct EpiStoreBf16 { bf16_t* O; int ldc;
    __device__ __forceinline__ void operator()(const f32x4 (&acc)[2][2][4][2], const Unit& u, int wr, int wc, int fr, int fq, LAS const unsigned char*) const {
        const int row0 = u.pm * BM + wr * 64 + fr, col0 = u.pn * BM + wc * 32 + 8 * fq;
#pragma unroll
        for (int ai = 0; ai < 2; ++ai)
#pragma unroll
            for (int m = 0; m < 4; ++m) { bf16_t* rowp = O + (size_t)(row0 + ai * HALF + m * 16) * ldc + col0;
#pragma unroll
                for (int bj = 0; bj < 2; ++bj) { const f32x4 v0 = acc[ai][bj][m][0], v1 = acc[ai][bj][m][1];
                    u32x4 w; w.x = pk2(v0[0], v0[1]); w.y = pk2(v0[2], v0[3]); w.z = pk2(v1[0], v1[1]); w.w = pk2(v1[2], v1[3]);
                    *(u32x4*)(rowp + bj * HALF) = w; } }
    } };
}
constexpr int LDS_PG8 = 2048;
__device__ __forceinline__ void phase1(const Params& p) {
  const int tid_ = opaque_tid(); const int lane = tid_ & 63, gw = blockIdx.x * 8 + (tid_ >> 6), nw = gridDim.x * 8;
  const float* mod = (const float*)(p.ws + OFF_MOD);
  bf16_t* H1 = (bf16_t*)(p.ws + OFF_ACTA);
  float4 g[4];
#pragma unroll
  for (int i = 0; i < 4; ++i) g[i] = *(const float4*)(p.g_mix_pre + (lane + 64 * i) * 4);
  float4 vn[4];
  if (gw < T_TOK) {
#pragma unroll
    for (int i = 0; i < 4; ++i) vn[i] = ((const float4*)(p.x + (size_t)gw * 1024))[lane + 64 * i];
  }
#pragma unroll 1
  for (int row = gw; row < T_TOK; row += nw) {
    float4 v[4]; float ss = 0.f;
#pragma unroll
    for (int i = 0; i < 4; ++i) { v[i] = vn[i]; ss += v[i].x * v[i].x + v[i].y * v[i].y + v[i].z * v[i].z + v[i].w * v[i].w; }
    { const int rn = (row + nw < T_TOK) ? row + nw : row;
#pragma unroll
      for (int i = 0; i < 4; ++i) vn[i] = ((const float4*)(p.x + (size_t)rn * 1024))[lane + 64 * i]; }
    ss = wave_sum(ss);
    const float rs = rsqrtf(ss * (1.0f / 1024.f) + EPS);
    const int b = row >> 12;
    const float* sh = mod + b * 6144; const float* sc = sh + 1024;
#pragma unroll
    for (int i = 0; i < 4; ++i) {
      const int c = (lane + 64 * i) * 4;
      const float4 s1 = *(const float4*)(sc + c), h1 = *(const float4*)(sh + c);
      u32x2 w;
      w.x = pk2(v[i].x * rs * g[i].x * (1.f + s1.x) + h1.x, v[i].y * rs * g[i].y * (1.f + s1.y) + h1.y);
      w.y = pk2(v[i].z * rs * g[i].z * (1.f + s1.z) + h1.z, v[i].w * rs * g[i].w * (1.f + s1.w) + h1.w);
      *(u32x2*)(H1 + (size_t)row * 1024 + c) = w;
    }
  }
}

struct EpiProj { bf16_t* O; float* OL;
  __device__ __forceinline__ void operator()(const f32x4 (&acc)[2][2][4][2], const pg8::Unit& u, int wr, int wc, int fr, int fq, LAS const unsigned char*) const {
    const int row0 = u.pm * 256 + wr * 64 + fr;
    if (u.pn < 12) {
      const int col0 = u.pn * 256 + wc * 32 + 8 * fq;
#pragma unroll
      for (int ai = 0; ai < 2; ++ai)
#pragma unroll
        for (int m = 0; m < 4; ++m) { bf16_t* rowp = O + (size_t)(row0 + ai * 128 + m * 16) * PLD + col0;
#pragma unroll
          for (int bj = 0; bj < 2; ++bj) { const f32x4 v0 = acc[ai][bj][m][0], v1 = acc[ai][bj][m][1];
            u32x4 w; w.x = pk2(v0[0], v0[1]); w.y = pk2(v0[2], v0[3]); w.z = pk2(v1[0], v1[1]); w.w = pk2(v1[2], v1[3]);
            *(u32x4*)(rowp + bj * 128) = w; } }
    } else {
      const int col0 = wc * 32 + 8 * fq;
#pragma unroll
      for (int ai = 0; ai < 2; ++ai)
#pragma unroll
        for (int m = 0; m < 4; ++m) { float* rowp = OL + (size_t)(row0 + ai * 128 + m * 16) * 128 + col0;
          *(f32x4*)rowp = acc[ai][0][m][0]; *(f32x4*)(rowp + 4) = acc[ai][0][m][1]; }
    }
  } };
__device__ __forceinline__ void phase2(const Params& p) {
  pg8::DenseOrder S; S.init(T_TOK, NPROJ, 1024, (const bf16_t*)(p.ws + OFF_WIN), gridDim.x, blockIdx.x);
  EpiProj E{(bf16_t*)(p.ws + OFF_PROJ), (float*)(p.ws + OFF_PROJL)};
  pg8::gemm_phase(SMEM + LDS_PG8, (const bf16_t*)(p.ws + OFF_ACTA), 1024, S, E);
}

__device__ __forceinline__ void unpack8(const u32x4 v, float (&o)[8]) { o[0] = bflo(v.x); o[1] = bfhi(v.x); o[2] = bflo(v.y); o[3] = bfhi(v.y); o[4] = bflo(v.z); o[5] = bfhi(v.z); o[6] = bflo(v.w); o[7] = bfhi(v.w); }
__device__ __forceinline__ u32x4 packf8(const float (&o)[8]) { u32x4 w; w.x = pk2(o[0], o[1]); w.y = pk2(o[2], o[3]); w.z = pk2(o[4], o[5]); w.w = pk2(o[6], o[7]); return w; }
__device__ __forceinline__ void rope8(float (&own)[8], const float (&oth)[8], bool first, const float* cs) {
#pragma unroll
  for (int i = 0; i < 8; ++i) { const float c = cs[2 * i], s = cs[2 * i + 1]; own[i] = first ? (own[i] * c - oth[i] * s) : (own[i] * c + oth[i] * s); }
}
__device__ __forceinline__ void phase2b(const Params& p) {
  const bf16_t* PROJ = (const bf16_t*)(p.ws + OFF_PROJ); const float* PL = (const float*)(p.ws + OFF_PROJL);
  bf16_t* dst = (bf16_t*)(p.ws + OFF_MQKC); bf16_t* AKR = (bf16_t*)(p.ws + OFF_AK); bf16_t* IK = (bf16_t*)(p.ws + OFF_IK);
  const float* R128 = (const float*)(p.ws + OFF_ROPE); const float* R64 = R128 + 4096 * 32;
  const unsigned gtid = blockIdx.x * NTHR + opaque_tid(), gstride = gridDim.x * NTHR;
  for (unsigned id = gtid; id < (unsigned)(T_TOK / 8) * 128u; id += gstride) {
    const size_t tok0 = (size_t)(id >> 7) * 8; const int c0 = (int)(id & 127u) * 8; const int pos0 = (int)(tok0 & 4095);
    u32x4 raw[11];
#pragma unroll
    for (int r = 0; r < 11; ++r) raw[r] = (pos0 + r - 3 >= 0) ? *(const u32x4*)(PROJ + (tok0 + r - 3) * PLD + c0) : (u32x4){0u, 0u, 0u, 0u};
    float w[4][8], bias[8];
#pragma unroll
    for (int j = 0; j < 4; ++j) { const float4 w0 = *(const float4*)(p.conv_w + j * 1024 + c0), w1 = *(const float4*)(p.conv_w + j * 1024 + c0 + 4);
      w[j][0] = w0.x; w[j][1] = w0.y; w[j][2] = w0.z; w[j][3] = w0.w; w[j][4] = w1.x; w[j][5] = w1.y; w[j][6] = w1.z; w[j][7] = w1.w; }
    { const float4 b0 = *(const float4*)(p.conv_b + c0), b1 = *(const float4*)(p.conv_b + c0 + 4);
      bias[0] = b0.x; bias[1] = b0.y; bias[2] = b0.z; bias[3] = b0.w; bias[4] = b1.x; bias[5] = b1.y; bias[6] = b1.z; bias[7] = b1.w; }
    const float sc = (c0 >= 512) ? 0.08838834764831845f : 1.0f;
#pragma unroll
    for (int t = 0; t < 8; ++t) {
      float acc[8];
#pragma unroll
      for (int i = 0; i < 8; ++i) acc[i] = bias[i];
#pragma unroll
      for (int j = 0; j < 4; ++j) { float v[8]; unpack8(raw[t + j], v);
#pragma unroll
        for (int i = 0; i < 8; ++i) acc[i] += v[i] * w[j][i]; }
#pragma unroll
      for (int i = 0; i < 8; ++i) acc[i] = acc[i] * __builtin_amdgcn_rcpf(1.0f + __expf(-acc[i])) * sc;
      *(u32x4*)(dst + (tok0 + t) * 1024 + c0) = packf8(acc);
    }
  }
  for (unsigned id = gtid; id < (unsigned)T_TOK * 16u; id += gstride) {
    const size_t tok = id >> 4; const int c0 = (int)(id & 15u) * 8; const int pos = (int)(tok & 4095);
    float own[8]; unpack8(*(const u32x4*)(PROJ + tok * PLD + 2560 + c0), own);
    if (c0 < 32) { float oth[8]; unpack8(*(const u32x4*)(PROJ + tok * PLD + 2560 + (c0 ^ 16)), oth); rope8(own, oth, c0 < 16, R128 + (size_t)pos * 32 + (c0 & 15) * 2); }
    *(u32x4*)(AKR + tok * 128 + c0) = packf8(own);
  }
  {
    const int tid_ = opaque_tid(); const int lane = tid_ & 63, gwv = blockIdx.x * 8 + (tid_ >> 6), nwv = gridDim.x * 8;
    const float gk = p.g_idx_k[lane], bk = p.b_idx_k[lane];
    for (int tok = gwv; tok < T_TOK; tok += nwv) {
      const int pos = tok & 4095;
      const float* tr = PL + (size_t)tok * 128;
      const float v = tr[lane];
      const float mu = wave_sum(v) * (1.f / 64.f);
      const float d = v - mu;
      const float var = wave_sum(d * d) * (1.f / 64.f);
      float y = d * rsqrtf(var + EPS) * gk + bk;
      const float yo = __shfl_xor(y, 8);
      if (lane < 16) { const float cs = R64[(size_t)pos * 16 + (lane & 7) * 2], sn = R64[(size_t)pos * 16 + (lane & 7) * 2 + 1]; y = (lane < 8) ? (y * cs - yo * sn) : (y * cs + yo * sn); }
      const float yn = __shfl_down(y, 1);
      if ((lane & 1) == 0) *(unsigned*)(IK + (size_t)tok * 64 + lane) = pk2(y, yn);
      if (lane < 8) ((float*)(p.ws + OFF_GATES))[(size_t)tok * 8 + lane] = tr[64 + lane] + ((lane < 4) ? p.b_igate[lane] : p.b_fgate[lane - 4]);
      else if (lane < 12) ((float*)(p.ws + OFF_IW))[(size_t)tok * 4 + (lane - 8)] = tr[72 + (lane - 8)] * 0.0625f;
    }
  }
  {
    const int tid_ = opaque_tid(); const int lane = tid_ & 63, gwv = blockIdx.x * 8 + (tid_ >> 6), nwv = gridDim.x * 8;
    float* GLb = (float*)(p.ws + OFF_GL); float* GLa = GLb + 64 * 4096; float* GLm = GLa + 64 * 4096; float* SEG = GLm + 64 * 4096;
    for (int item = gwv; item < 512; item += nwv) {
      const int bh = item >> 3, seg = item & 7, b = bh >> 2, h = bh & 3;
      const float bi = p.b_igate[h], bfg = p.b_fgate[h];
      float bl = 0.f, ml = -1e30f;
      for (int c = 0; c < 8; ++c) {
        const int ts = seg * 512 + c * 64 + lane; const size_t tok = (size_t)b * 4096 + ts;
        const float ig = PL[tok * 128 + 64 + h] + bi, fg = PL[tok * 128 + 68 + h] + bfg;
        const float lf = fminf(fg, 0.f) - log1pf(expf(-fabsf(fg)));
        float cs = lf;
#pragma unroll
        for (int off = 1; off < 64; off <<= 1) { const float t = __shfl_up(cs, off); if (lane >= off) cs += t; }
        const float bloc = bl + cs, aloc = ig - bloc;
        float mx = aloc;
#pragma unroll
        for (int off = 1; off < 64; off <<= 1) { const float t = __shfl_up(mx, off); if (lane >= off) mx = fmaxf(mx, t); }
        const float mloc = fmaxf(ml, mx);
        GLb[bh * 4096 + ts] = bloc; GLa[bh * 4096 + ts] = aloc; GLm[bh * 4096 + ts] = mloc;
        bl = __shfl(bloc, 63); ml = __shfl(mloc, 63);
      }
      if (lane == 0) { SEG[(bh * 8 + seg) * 2] = bl; SEG[(bh * 8 + seg) * 2 + 1] = ml; }
    }
  }
}
namespace ml {
constexpr int QS = 0, KS = 17408, VS = 34816, VWS = 54272, PS = 73728, CB = 82944, SEGT = 122112, GA = 122624;
constexpr int QLD = 136, VLD = 152, TLD = 72;
}
__device__ __forceinline__ bf16x8 ml_tr(LAS const bf16_t* p0, int rowstride) {
  const v4i16_t a = __builtin_amdgcn_ds_read_tr16_b64_v4i16((LAS v4i16_t*)p0), b = __builtin_amdgcn_ds_read_tr16_b64_v4i16((LAS v4i16_t*)(p0 + 4 * rowstride));
  bf16x8 r; r[0] = a[0]; r[1] = a[1]; r[2] = a[2]; r[3] = a[3]; r[4] = b[0]; r[5] = b[1]; r[6] = b[2]; r[7] = b[3]; return r;
}
__device__ __forceinline__ void mlstm_item(const Params& p, int id) {
  using namespace ml;
  const int tid = opaque_tid(), lane = tid & 63, w = tid >> 6, fr = lane & 15, fq = lane >> 4;
  const int b = id >> 2, h = id & 3;
  const size_t tok0 = (size_t)b * 4096;
  LAS unsigned char* L = SMEM + LDS_MAIN;
  LAS bf16_t* Qs = (LAS bf16_t*)(L + QS); LAS bf16_t* Ks = (LAS bf16_t*)(L + KS); LAS bf16_t* Vs = (LAS bf16_t*)(L + VS); LAS bf16_t* VWs = (LAS bf16_t*)(L + VWS);
  LAS bf16_t* Ps = (LAS bf16_t*)(L + PS); LAS bf16_t* Cb = (LAS bf16_t*)(L + CB);
  LAS float* segt = (LAS float*)(L + SEGT); LAS float* gab = (LAS float*)(L + GA);
  const float* GLb = (const float*)(p.ws + OFF_GL) + (size_t)(b * 4 + h) * 4096; const float* GLa = GLb + 64 * 4096; const float* GLm = GLa + 64 * 4096; const float* SEG = (const float*)(p.ws + OFF_GL) + 3 * 64 * 4096 + (b * 4 + h) * 16;
  const bf16_t* MQKC = (const bf16_t*)(p.ws + OFF_MQKC); const bf16_t* MV = (const bf16_t*)(p.ws + OFF_PROJ) + 1024 + h * 128; const bf16_t* MO = (const bf16_t*)(p.ws + OFF_PROJ) + 1536 + h * 128;
  bf16_t* A2 = (bf16_t*)(p.ws + OFF_ACTA) + h * 128;

  f32x4 Cacc[2][9];
#pragma unroll
  for (int i = 0; i < 2; ++i)
#pragma unroll
    for (int j = 0; j < 9; ++j) Cacc[i][j] = (f32x4){0.f, 0.f, 0.f, 0.f};
  for (int i = tid; i < 144 * QLD; i += NTHR) Cb[i] = 0;
  for (int i = tid; i < 64 * VLD; i += NTHR) { const int col = i % VLD; Vs[i] = (col == 128) ? (bf16_t)0x3F80 : (bf16_t)0; VWs[i] = 0; }
  if (tid == 0) { float bo = 0.f, mp = -1e30f; for (int k = 0; k < 8; ++k) { segt[2 * k] = bo; segt[2 * k + 1] = mp; mp = fmaxf(mp, SEG[2 * k + 1] - bo); bo += SEG[2 * k]; } }
  u32x4 q0, q1, k0, k1, v0, v1; float ga0 = 0.f, ga1 = 0.f, gb = 0.f, gm = 0.f, gme = 0.f, gmp = 0.f;
  const int srow = tid >> 4, scc = tid & 15;
  const int gs = tid & 63;
  auto gload = [&](int c) {
    const size_t t0 = tok0 + (size_t)c * 64;
    q0 = *(const u32x4*)(MQKC + (t0 + srow) * 1024 + h * 128 + scc * 8); q1 = *(const u32x4*)(MQKC + (t0 + srow + 32) * 1024 + h * 128 + scc * 8);
    k0 = *(const u32x4*)(MQKC + (t0 + srow) * 1024 + 512 + h * 128 + scc * 8); k1 = *(const u32x4*)(MQKC + (t0 + srow + 32) * 1024 + 512 + h * 128 + scc * 8);
    v0 = *(const u32x4*)(MV + (t0 + srow) * PLD + scc * 8); v1 = *(const u32x4*)(MV + (t0 + srow + 32) * PLD + scc * 8);
    ga0 = GLa[c * 64 + srow]; ga1 = GLa[c * 64 + srow + 32];
    const int ts = c * 64 + gs; gb = GLb[ts]; gm = GLm[ts]; gme = GLm[c * 64 + 63]; gmp = GLm[(c > 0) ? (c * 64 - 1) : 0];
  };
  auto sstore = [&](int cs) {
    *(LAS u32x4*)(Qs + srow * QLD + scc * 8) = q0; *(LAS u32x4*)(Qs + (srow + 32) * QLD + scc * 8) = q1;
    *(LAS u32x4*)(Ks + srow * QLD + scc * 8) = k0; *(LAS u32x4*)(Ks + (srow + 32) * QLD + scc * 8) = k1;
    *(LAS u32x4*)(Vs + srow * VLD + scc * 8) = v0; *(LAS u32x4*)(Vs + (srow + 32) * VLD + scc * 8) = v1;
    const float bo = segt[2 * (cs >> 3)], mpv = segt[2 * (cs >> 3) + 1];
    const float Mend = fmaxf(mpv, gme - bo);
    const float w0 = __expf(ga0 - bo - Mend), w1 = __expf(ga1 - bo - Mend);
    { float f[8]; unpack8(v0, f);
#pragma unroll
      for (int i = 0; i < 8; ++i) f[i] *= w0;
      *(LAS u32x4*)(VWs + srow * VLD + scc * 8) = packf8(f);
      unpack8(v1, f);
#pragma unroll
      for (int i = 0; i < 8; ++i) f[i] *= w1;
      *(LAS u32x4*)(VWs + (srow + 32) * VLD + scc * 8) = packf8(f); }
    if (scc == 0) { VWs[srow * VLD + 128] = (bf16_t)f2bf(w0); VWs[(srow + 32) * VLD + 128] = (bf16_t)f2bf(w1); }
    if (tid < 64) {
      LAS float* ga = gab + (cs & 1) * 336;
      const float gav = (gs < 32) ? ga0 : ga1;
      (void)gav;
      const float a = GLa[cs * 64 + gs] - bo, Bs = bo + gb, Mt = fmaxf(mpv, gm - bo);
      float Mp = -1e30f;
      if (cs > 0) { const int sp = (cs * 64 - 1) >> 9; Mp = fmaxf(segt[2 * sp + 1], gmp - segt[2 * sp]); }
      ga[gs] = a; ga[64 + gs] = Mt; ga[128 + gs] = __expf(Mp - Mt); ga[192 + gs] = __expf(-(Bs + Mt));
      if (gs == 0) ga[320] = __expf(Mp - Mend);
    }
  };
  __syncthreads();
  gload(0); sstore(0);
  __syncthreads();
  const int tt = w >> 1, st0 = (w & 1) * 2;
  const int trq = fr >> 2, trp = fr & 3;
#pragma unroll 1
  for (int c = 0; c < 64; ++c) {
    if (c < 63) gload(c + 1);
    LAS const float* ga = gab + (c & 1) * 336;
    {
      f32x4 S[2];
#pragma unroll
      for (int i = 0; i < 2; ++i) S[i] = (f32x4){0.f, 0.f, 0.f, 0.f};
#pragma unroll
      for (int kk = 0; kk < 4; ++kk) {
        const bf16x8 bq = *(LAS bf16x8*)(Qs + (tt * 16 + fr) * QLD + kk * 32 + fq * 8);
#pragma unroll
        for (int i = 0; i < 2; ++i) if (st0 + i <= tt) {
          const bf16x8 ak = *(LAS bf16x8*)(Ks + ((st0 + i) * 16 + fr) * QLD + kk * 32 + fq * 8);
          S[i] = __builtin_amdgcn_mfma_f32_16x16x32_bf16(ak, bq, S[i], 0, 0, 0);
        }
      }
      const int t = tt * 16 + fr; const float Mt = ga[64 + t];
#pragma unroll
      for (int i = 0; i < 2; ++i) {
        const int s0 = (st0 + i) * 16 + fq * 4;
        const f32x4 as = *(LAS const f32x4*)(ga + s0);
        float pv[4];
#pragma unroll
        for (int j = 0; j < 4; ++j) pv[j] = (s0 + j <= t) ? S[i][j] * __expf(as[j] - Mt) : 0.f;
        u32x2 pw; pw.x = pk2(pv[0], pv[1]); pw.y = pk2(pv[2], pv[3]);
        *(LAS u32x2*)(Ps + t * TLD + s0) = pw;
      }
    }
    __syncthreads();
    if (w < 4) {
      f32x4 N1[9];
#pragma unroll
      for (int j = 0; j < 9; ++j) N1[j] = (f32x4){0.f, 0.f, 0.f, 0.f};
#pragma unroll
      for (int kk = 0; kk < 4; ++kk) {
        const bf16x8 bq = *(LAS bf16x8*)(Qs + (w * 16 + fr) * QLD + kk * 32 + fq * 8);
#pragma unroll
        for (int j = 0; j < 9; ++j) { const bf16x8 ac = *(LAS bf16x8*)(Cb + (j * 16 + fr) * QLD + kk * 32 + fq * 8); N1[j] = __builtin_amdgcn_mfma_f32_16x16x32_bf16(ac, bq, N1[j], 0, 0, 0); }
      }
      const int t = w * 16 + fr; const float inter = ga[128 + t], low = ga[192 + t];
#pragma unroll
      for (int j = 0; j < 9; ++j) N1[j] = N1[j] * inter;
#pragma unroll
      for (int kk = 0; kk < 2; ++kk) {
        const bf16x8 bp = *(LAS bf16x8*)(Ps + (w * 16 + fr) * TLD + kk * 32 + fq * 8);
        LAS const bf16_t* vb = Vs + (kk * 32 + fq * 8 + trq) * VLD + trp * 4;
#pragma unroll
        for (int j = 0; j < 9; ++j) { const bf16x8 av = ml_tr(vb + j * 16, VLD); N1[j] = __builtin_amdgcn_mfma_f32_16x16x32_bf16(av, bp, N1[j], 0, 0, 0); }
      }
      const float dsrc = N1[8][0];
      const float dn = fmaxf(fabsf(__shfl(dsrc, fr)), low);
      const float inv = __builtin_amdgcn_rcpf(dn);
      float ss = 0.f;
#pragma unroll
      for (int j = 0; j < 8; ++j)
#pragma unroll
        for (int r = 0; r < 4; ++r) { const float hv = N1[j][r] * inv; N1[j][r] = hv; ss += hv * hv; }
      ss += __shfl_xor(ss, 16); ss += __shfl_xor(ss, 32);
      const float rs = rsqrtf(ss * (1.f / 128.f) + EPS);
      bf16_t* op = A2 + (tok0 + (size_t)c * 64 + t) * 1024 + fq * 4;
#pragma unroll
      for (int j = 0; j < 8; ++j) {
        const float4 gh = *(const float4*)(p.g_mlstm_head + h * 128 + j * 16 + fq * 4);
        const u32x2 mo = *(const u32x2*)(MO + (tok0 + (size_t)c * 64 + t) * PLD + j * 16 + fq * 4);
        const float o0 = N1[j][0] * rs * gh.x * sigmoidf_(bflo(mo.x)), o1 = N1[j][1] * rs * gh.y * sigmoidf_(bfhi(mo.x));
        const float o2 = N1[j][2] * rs * gh.z * sigmoidf_(bflo(mo.y)), o3 = N1[j][3] * rs * gh.w * sigmoidf_(bfhi(mo.y));
        u32x2 hw; hw.x = pk2(o0, o1); hw.y = pk2(o2, o3);
        *(u32x2*)(op + j * 16) = hw;
      }
    } else {
      const float dcy = ga[320];
#pragma unroll
      for (int i = 0; i < 2; ++i)
#pragma unroll
        for (int j = 0; j < 9; ++j) Cacc[i][j] = Cacc[i][j] * dcy;
#pragma unroll
      for (int kk = 0; kk < 2; ++kk) {
        LAS const bf16_t* kb0 = Ks + (kk * 32 + fq * 8 + trq) * QLD + trp * 4;
        LAS const bf16_t* vwb = VWs + (kk * 32 + fq * 8 + trq) * VLD + trp * 4;
        bf16x8 akt[2];
#pragma unroll
        for (int i = 0; i < 2; ++i) akt[i] = ml_tr(kb0 + ((w - 4) * 2 + i) * 16, QLD);
#pragma unroll
        for (int j = 0; j < 9; ++j) {
          const bf16x8 bv = ml_tr(vwb + j * 16, VLD);
#pragma unroll
          for (int i = 0; i < 2; ++i) Cacc[i][j] = __builtin_amdgcn_mfma_f32_16x16x32_bf16(akt[i], bv, Cacc[i][j], 0, 0, 0);
        }
      }
    }
    __syncthreads();
    if (w >= 4) {
#pragma unroll
      for (int i = 0; i < 2; ++i)
#pragma unroll
        for (int j = 0; j < 9; ++j) { u32x2 cw; cw.x = pk2(Cacc[i][j][0], Cacc[i][j][1]); cw.y = pk2(Cacc[i][j][2], Cacc[i][j][3]);
          *(LAS u32x2*)(Cb + (j * 16 + fr) * QLD + ((w - 4) * 2 + i) * 16 + fq * 4) = cw; }
    }
    if (c < 63) sstore(c + 1);
    __syncthreads();
  }
}
namespace ds {
constexpr int KEYS = 0, HIST = 131072;
constexpr int KT = 0, VT = 34816, PW = 71680, MSK = 108544;
constexpr int KLD = 136, VLD = 72;
}
__device__ __forceinline__ unsigned score_key16(float s4096) {
  const float t = __builtin_amdgcn_fmed3f(s4096, -32767.0f, 32767.0f);
  return (unsigned)(32768 + (int)floorf(t));
}
__device__ __forceinline__ void hist_find(LAS const unsigned* hist, int lane, unsigned target, unsigned& bin, unsigned& above) {
  const u32x4 h4 = *(LAS const u32x4*)(hist + 4 * lane);
  const unsigned lsum = h4.x + h4.y + h4.z + h4.w;
  const unsigned inc_ = wave_incl_scan(lsum);
  const unsigned suf = (unsigned)__builtin_amdgcn_readlane((int)inc_, 63) - inc_ + lsum;
  unsigned cum = suf - lsum; bool found = false; unsigned fb = 0, fa = 0;
  { const unsigned hv = h4.w; if (!found && cum < target && cum + hv >= target) { found = true; fb = 4 * lane + 3; fa = cum; } cum += hv; }
  { const unsigned hv = h4.z; if (!found && cum < target && cum + hv >= target) { found = true; fb = 4 * lane + 2; fa = cum; } cum += hv; }
  { const unsigned hv = h4.y; if (!found && cum < target && cum + hv >= target) { found = true; fb = 4 * lane + 1; fa = cum; } cum += hv; }
  { const unsigned hv = h4.x; if (!found && cum < target && cum + hv >= target) { found = true; fb = 4 * lane + 0; fa = cum; } cum += hv; }
  const unsigned long long m = __ballot(found);
  const int src = m ? (__ffsll((long long)m) - 1) : 0;
  bin = (unsigned)__builtin_amdgcn_readlane((int)fb, src); above = (unsigned)__builtin_amdgcn_readlane((int)fa, src);
}
typedef long long i64; typedef long long i64x2 __attribute__((ext_vector_type(2)));
__device__ __forceinline__ bf16x8 tr_pair(LAS const bf16_t* p0, LAS const bf16_t* p1) {
  const v4i16_t a = __builtin_amdgcn_ds_read_tr16_b64_v4i16((LAS v4i16_t*)p0), b = __builtin_amdgcn_ds_read_tr16_b64_v4i16((LAS v4i16_t*)p1);
  bf16x8 r; r[0] = a[0]; r[1] = a[1]; r[2] = a[2]; r[3] = a[3]; r[4] = b[0]; r[5] = b[1]; r[6] = b[2]; r[7] = b[3]; return r;
}
__device__ __forceinline__ void dsa_item(const Params& p, int b, int qc) {
  using namespace ds;
  const int tid = opaque_tid(), lane = tid & 63, w = tid >> 6, fr = lane & 15, fq = lane >> 4;
  LAS unsigned char* L = SMEM + LDS_MAIN;
  const size_t kb = (size_t)b * 4096;
  const size_t q0 = kb + (size_t)qc * 64;
  const int n = (qc + 1) * 64, ntile = qc + 1;
  unsigned long long* BITM = (unsigned long long*)(p.ws + OFF_BITM);
  unsigned char* BITB = (unsigned char*)(p.ws + OFF_BITM);
  const bf16_t* IQ = (const bf16_t*)(p.ws + OFF_PROJ) + 2816; const float* R128 = (const float*)(p.ws + OFF_ROPE); const float* R64 = R128 + 4096 * 32;
  const bf16_t* IK = (const bf16_t*)(p.ws + OFF_IK); const float* IW = (const float*)(p.ws + OFF_IW);
  for (int rep_s = 0; rep_s < ((PROBE_DBL == 33) ? 2 : 1); ++rep_s)
  if (n <= 256) {
    for (int i = tid; i < 64 * ntile; i += NTHR) { const int q = i / ntile, kt = i - q * ntile; BITM[(q0 + q) * 64 + kt] = ~0ull; }
  } else {
    LAS unsigned short* keys = (LAS unsigned short*)(L + KEYS);
    LAS unsigned* histq = (LAS unsigned*)(L + HIST);
    const int nk16 = n >> 4, nblk = (n + 511) >> 9;
    { LAS u32x4* hz = (LAS u32x4*)(L + HIST) + tid * 2; hz[0] = (u32x4){0u, 0u, 0u, 0u}; hz[1] = (u32x4){0u, 0u, 0u, 0u}; }
    __syncthreads();
#pragma unroll 1
    for (int g = 0; g < 4; ++g) {
      const size_t qg = q0 + g * 16;
      bf16x8 af[4][2]; f32x4 iw[4];
#pragma unroll
      for (int hh = 0; hh < 4; ++hh)
#pragma unroll
        for (int ks = 0; ks < 2; ++ks) {
          const bf16_t* src = IQ + (qg + fr) * PLD + hh * 64 + ks * 32 + fq * 8;
          u32x4 raw = *(const u32x4*)src;
          if (ks == 0 && fq < 2) { float own[8], oth[8]; unpack8(raw, own); unpack8(*(const u32x4*)(IQ + (qg + fr) * PLD + hh * 64 + (fq ^ 1) * 8), oth);
            rope8(own, oth, fq == 0, R64 + (size_t)((qg + fr) & 4095) * 16); raw = packf8(own); }
          af[hh][ks] = __builtin_bit_cast(bf16x8, raw);
        }
#pragma unroll
      for (int j = 0; j < 4; ++j) iw[j] = *(const f32x4*)(IW + (qg + fq * 4 + j) * 4) * 4096.0f;

      {
        const int nbat = n >> 6;
        bf16x8 bc[4][2], bn[4][2];
        {
          const int bt = (w < nbat) ? w : 0;
#pragma unroll
          for (int u = 0; u < 4; ++u) { const bf16_t* kp = IK + (kb + (size_t)(bt * 4 + u) * 16 + fr) * 64 + fq * 8; bc[u][0] = *(const bf16x8*)kp; bc[u][1] = *(const bf16x8*)(kp + 32); }
        }
        for (int bt = w; bt < nbat; bt += 8) {
          const int btn = (bt + 8 < nbat) ? bt + 8 : bt;
#pragma unroll
          for (int u = 0; u < 4; ++u) { const bf16_t* kp = IK + (kb + (size_t)(btn * 4 + u) * 16 + fr) * 64 + fq * 8; bn[u][0] = *(const bf16x8*)kp; bn[u][1] = *(const bf16x8*)(kp + 32); }
#pragma unroll
          for (int u = 0; u < 4; ++u) {
            float sc[4] = {0.f, 0.f, 0.f, 0.f};
#pragma unroll
            for (int hh = 0; hh < 4; ++hh) {
              f32x4 a = (f32x4){0.f, 0.f, 0.f, 0.f};
              a = __builtin_amdgcn_mfma_f32_16x16x32_bf16(af[hh][0], bc[u][0], a, 0, 0, 0);
              a = __builtin_amdgcn_mfma_f32_16x16x32_bf16(af[hh][1], bc[u][1], a, 0, 0, 0);
#pragma unroll
              for (int j = 0; j < 4; ++j) sc[j] += iw[j][hh] * fmaxf(a[j], 0.f);
            }
#pragma unroll
            for (int j = 0; j < 4; ++j) { const unsigned k16 = score_key16(sc[j]); keys[(fq * 4 + j) * 4096 + (bt * 4 + u) * 16 + fr] = (unsigned short)k16;
              __hip_atomic_fetch_add(histq + (fq * 4 + j) * 256 + (k16 >> 8), 1u, __ATOMIC_RELAXED, __HIP_MEMORY_SCOPE_WORKGROUP); }
          }
#pragma unroll
          for (int u = 0; u < 4; ++u) { bc[u][0] = bn[u][0]; bc[u][1] = bn[u][1]; }
        }
      }
      __syncthreads();
#pragma unroll 1
      for (int qq = 0; qq < 2; ++qq) {
        const int ql = w * 2 + (qq & 1);
        LAS const unsigned short* kq = keys + ql * 4096;
        LAS unsigned* hist = histq + ql * 256;
        unsigned bin1, above1; hist_find(hist, lane, 256u, bin1, above1);
        *(LAS u32x4*)(hist + 4 * lane) = (u32x4){0u, 0u, 0u, 0u};
        for (int blk = 0; blk < nblk; ++blk) {
          const int k0i = blk * 512 + lane * 8;
          if (k0i < n) {
            const u32x4 kv = *(LAS const u32x4*)(kq + k0i);
#define DS_P2(word) { const unsigned ka = (word) & 0xffffu, kb2 = (word) >> 16; \
              if ((ka >> 8) == bin1) __hip_atomic_fetch_add(hist + (ka & 255u), 1u, __ATOMIC_RELAXED, __HIP_MEMORY_SCOPE_WORKGROUP); \
              if ((kb2 >> 8) == bin1) __hip_atomic_fetch_add(hist + (kb2 & 255u), 1u, __ATOMIC_RELAXED, __HIP_MEMORY_SCOPE_WORKGROUP); }
            DS_P2(kv.x) DS_P2(kv.y) DS_P2(kv.z) DS_P2(kv.w)
#undef DS_P2
          }
        }
        asm volatile("s_waitcnt lgkmcnt(0)" ::: "memory");
        unsigned bin2, above2; hist_find(hist, lane, 256u - above1, bin2, above2);
        *(LAS u32x4*)(hist + 4 * lane) = (u32x4){0u, 0u, 0u, 0u};
        const unsigned tau = (bin1 << 8) | bin2, rties = 256u - above1 - above2;
        unsigned tbase = 0;
        for (int blk = 0; blk < nblk; ++blk) {
          const int k0i = blk * 512 + lane * 8;
          u32x4 kv = (u32x4){0u, 0u, 0u, 0u};
          if (k0i < n) kv = *(LAS const u32x4*)(kq + k0i);
          unsigned kk[8] = {kv.x & 0xffffu, kv.x >> 16, kv.y & 0xffffu, kv.y >> 16, kv.z & 0xffffu, kv.z >> 16, kv.w & 0xffffu, kv.w >> 16};
          unsigned ne = 0;
#pragma unroll
          for (int e = 0; e < 8; ++e) ne += (kk[e] == tau) ? 1u : 0u;
          if (k0i >= n) ne = 0;
          unsigned mbyte = 0;
          if (__ballot(ne != 0u) == 0ull) {
#pragma unroll
            for (int e = 0; e < 8; ++e) mbyte |= (kk[e] > tau) ? (1u << e) : 0u;
          } else {
            const unsigned inc = wave_incl_scan(ne);
            unsigned rank = tbase + inc - ne;
#pragma unroll
            for (int e = 0; e < 8; ++e) { const bool eq = kk[e] == tau; const bool sel = (kk[e] > tau) || (eq && rank < rties); mbyte |= sel ? (1u << e) : 0u; rank += eq ? 1u : 0u; }
            tbase += (unsigned)__builtin_amdgcn_readlane((int)inc, 63);
          }
          if (k0i < n) BITB[(qg + ql) * 512 + blk * 64 + lane] = (unsigned char)mbyte;
        }
      }
      __syncthreads();
    }
  }
  asm volatile("s_waitcnt vmcnt(0)" ::: "memory");
  __threadfence_block();
  __syncthreads();
  const bf16_t* AQ = (const bf16_t*)(p.ws + OFF_PROJ) + 2048; const bf16_t* AK = (const bf16_t*)(p.ws + OFF_AK); const bf16_t* AV = (const bf16_t*)(p.ws + OFF_PROJ) + 2688;
  bf16_t* A2 = (bf16_t*)(p.ws + OFF_ACTA);
  const float qscale = 0.08838834764831845f * 1.4426950408889634f;
  constexpr int RS = 36864;
  const int wv = __builtin_amdgcn_readfirstlane(w);
  const int prow0 = wv * 4 + (lane >> 4), prow1 = 32 + prow0;
  const int pch0 = (lane & 15) ^ (prow0 & 15), pch1 = (lane & 15) ^ (prow1 & 15);
  const unsigned koff0 = (unsigned)(prow0 * 128 + pch0 * 8) * 2u, koff1 = (unsigned)(prow1 * 128 + pch1 * 8) * 2u;
  const unsigned voff0 = (unsigned)(prow0 * PLD + pch0 * 8) * 2u, voff1 = (unsigned)(prow1 * PLD + pch1 * 8) * 2u;
  const unsigned moff = (unsigned)(((tid & 127) >> 1) * 512 + (tid & 1) * 4);
#define DS_GLDS(gp, ldsoff, sz) __builtin_amdgcn_global_load_lds((const unsigned*)(gp), (LAS unsigned*)(L + (ldsoff)), sz, 0, 0)
#define DS_ISSUE(kt_, stg_) do { const size_t t0_ = kb + (size_t)(kt_) * 64; const int so_ = (stg_) * RS; \
    DS_GLDS((const char*)(AK + t0_ * 128) + koff0, so_ + wv * 1024, 16); DS_GLDS((const char*)(AK + t0_ * 128) + koff1, so_ + 8192 + wv * 1024, 16); \
    DS_GLDS((const char*)(AV + t0_ * PLD) + voff0, so_ + 16384 + wv * 1024, 16); DS_GLDS((const char*)(AV + t0_ * PLD) + voff1, so_ + 16384 + 8192 + wv * 1024, 16); \
    DS_GLDS((const char*)(BITM + q0 * 64 + (kt_)) + moff, so_ + 32768 + wv * 256, 4); } while (0)
#pragma unroll 1
  for (int hp = 0; hp < ((PROBE_DBL == 34) ? 2 : 1); ++hp) {
    const int hd0 = (w >> 2) * 2, qh = (w & 3) * 16;
    bf16x8 qf[2][4];
#pragma unroll
    for (int hx = 0; hx < 2; ++hx)
#pragma unroll
      for (int kk = 0; kk < 4; ++kk) {
        const bf16_t* src = AQ + (q0 + qh + fr) * PLD + (hd0 + hx) * 128 + kk * 32 + fq * 8;
        float own[8]; unpack8(*(const u32x4*)src, own);
        if (kk == 0) { float oth[8]; unpack8(*(const u32x4*)(AQ + (q0 + qh + fr) * PLD + (hd0 + hx) * 128 + (fq ^ 2) * 8), oth);
          rope8(own, oth, fq < 2, R128 + (size_t)((q0 + qh + fr) & 4095) * 32 + (fq & 1) * 16); }
#pragma unroll
        for (int i = 0; i < 8; ++i) own[i] *= qscale;
        qf[hx][kk] = __builtin_bit_cast(bf16x8, packf8(own));
      }
    f32x4 O[2][8];
#pragma unroll
    for (int hx = 0; hx < 2; ++hx)
#pragma unroll
      for (int di = 0; di < 8; ++di) O[hx][di] = (f32x4){0.f, 0.f, 0.f, 0.f};
    float mrun[2] = {0.f, 0.f};
    f32x4 Lacc[2] = {(f32x4){0.f, 0.f, 0.f, 0.f}, (f32x4){0.f, 0.f, 0.f, 0.f}};
    const bf16x8 ones8 = __builtin_bit_cast(bf16x8, (u32x4){0x3F803F80u, 0x3F803F80u, 0x3F803F80u, 0x3F803F80u});
    const unsigned r15 = (unsigned)(fq * 4 + (fr >> 2));
    const unsigned vrb = r15 * 256u + (unsigned)(fr & 1) * 8u, vcx = (unsigned)((fr & 3) >> 1);
    const unsigned va0 = vrb + (((0u + vcx) ^ r15) << 4), va1 = vrb + (((2u + vcx) ^ r15) << 4), va2 = vrb + (((4u + vcx) ^ r15) << 4), va3 = vrb + (((6u + vcx) ^ r15) << 4);
    const unsigned va4 = vrb + (((8u + vcx) ^ r15) << 4), va5 = vrb + (((10u + vcx) ^ r15) << 4), va6 = vrb + (((12u + vcx) ^ r15) << 4), va7 = vrb + (((14u + vcx) ^ r15) << 4);
    asm volatile("s_waitcnt vmcnt(0)" ::: "memory");
    DS_ISSUE(0, 0);
    DS_ISSUE((ntile > 1) ? 1 : 0, 1);
#pragma unroll 1
    for (int kt = 0; kt < ntile; ++kt) {
      const int stg = kt % 3;
      asm volatile("s_waitcnt vmcnt(5)" ::: "memory");
      asm volatile("s_waitcnt lgkmcnt(0)" ::: "memory");
      __builtin_amdgcn_s_barrier();
      { const int ktn = (kt + 2 < ntile) ? kt + 2 : ntile - 1; DS_ISSUE(ktn, (kt + 2) % 3); }
      LAS const unsigned char* Kt = L + stg * RS;
      f32x4 S[2][4];
#pragma unroll
      for (int hx = 0; hx < 2; ++hx)
#pragma unroll
        for (int ni = 0; ni < 4; ++ni) { const float nb = -mrun[hx]; S[hx][ni] = (f32x4){nb, nb, nb, nb}; }
#pragma unroll
      for (int kk = 0; kk < 4; ++kk)
#pragma unroll
        for (int ni = 0; ni < 4; ++ni) {
          const bf16x8 ak = *(LAS const bf16x8*)(Kt + (ni * 16 + fr) * 256 + (((kk * 4 + fq) ^ fr) << 4));
          S[0][ni] = __builtin_amdgcn_mfma_f32_16x16x32_bf16(ak, qf[0][kk], S[0][ni], 0, 0, 0);
          S[1][ni] = __builtin_amdgcn_mfma_f32_16x16x32_bf16(ak, qf[1][kk], S[1][ni], 0, 0, 0);
        }
#define DS_TRI(o0, o1, aa, ab, ac, ad, r0, r1, r2, r3, r4, r5, r6, r7) asm volatile( \
        "ds_read_b64_tr_b16 %0, %8 offset:" #o0 "\n\tds_read_b64_tr_b16 %1, %8 offset:" #o1 "\n\tds_read_b64_tr_b16 %2, %9 offset:" #o0 "\n\tds_read_b64_tr_b16 %3, %9 offset:" #o1 "\n\t" \
        "ds_read_b64_tr_b16 %4, %10 offset:" #o0 "\n\tds_read_b64_tr_b16 %5, %10 offset:" #o1 "\n\tds_read_b64_tr_b16 %6, %11 offset:" #o0 "\n\tds_read_b64_tr_b16 %7, %11 offset:" #o1 \
        : "=&v"(r0), "=&v"(r1), "=&v"(r2), "=&v"(r3), "=&v"(r4), "=&v"(r5), "=&v"(r6), "=&v"(r7) : "v"((aa) + sb), "v"((ab) + sb), "v"((ac) + sb), "v"((ad) + sb) : "memory")
#define DS_TRW(r0, r1, r2, r3, r4, r5, r6, r7) asm volatile("s_waitcnt lgkmcnt(0)" : "+v"(r0), "+v"(r1), "+v"(r2), "+v"(r3), "+v"(r4), "+v"(r5), "+v"(r6), "+v"(r7) :: "memory")
      const unsigned sb = (unsigned)(LDS_MAIN + stg * RS + 16384);
      LAS const unsigned* wp = (LAS const unsigned*)(Kt + 32768 + (qh + fr) * 8);
      const unsigned mlo = wp[0] >> (fq * 4), mhi = wp[1] >> (fq * 4);
      unsigned pm[4][2];
#pragma unroll
      for (int ni = 0; ni < 4; ++ni)
#pragma unroll
        for (int jp = 0; jp < 2; ++jp) {
          const unsigned m = (ni < 2) ? mlo : mhi; const int sh = 16 * (ni & 1) + 2 * jp;
          const unsigned lo = (unsigned)__builtin_amdgcn_sbfe((int)m, sh, 1), hi = (unsigned)__builtin_amdgcn_sbfe((int)m, sh + 1, 1);
          pm[ni][jp] = __builtin_amdgcn_perm(hi, lo, 0x05040100u);
        }
      i64 t0, t1, t2, t3, t4, t5, t6, t7, u0, u1, u2, u3, u4, u5, u6, u7;
      __builtin_amdgcn_sched_barrier(0);
      DS_TRI(0, 4096, va0, va1, va2, va3, t0, t1, t2, t3, t4, t5, t6, t7);
      __builtin_amdgcn_sched_barrier(0);
      unsigned pk[2][4][2];
#pragma unroll
      for (int hx = 0; hx < 2; ++hx) {
        float mx = fmaxf(fmaxf(S[hx][0][0], S[hx][0][1]), fmaxf(S[hx][0][2], S[hx][0][3]));
#pragma unroll
        for (int ni = 1; ni < 4; ++ni) mx = fmaxf(mx, fmaxf(fmaxf(S[hx][ni][0], S[hx][ni][1]), fmaxf(S[hx][ni][2], S[hx][ni][3])));
        mx = rowmax4(mx);
        const bool up = (kt == 0) || (mx > 8.0f);
        if (__ballot(up) != 0ull) {
          const float d = up ? mx : 0.f;
          const float alpha = __builtin_amdgcn_exp2f(-d);
          mrun[hx] += d;
#pragma unroll
          for (int ni = 0; ni < 4; ++ni)
#pragma unroll
            for (int j = 0; j < 4; ++j) S[hx][ni][j] -= d;
#pragma unroll
          for (int di = 0; di < 8; ++di) O[hx][di] = O[hx][di] * alpha;
          Lacc[hx] = Lacc[hx] * alpha;
        }
#pragma unroll
        for (int ni = 0; ni < 4; ++ni)
#pragma unroll
          for (int jp = 0; jp < 2; ++jp)
            pk[hx][ni][jp] = pk2(__builtin_amdgcn_exp2f(S[hx][ni][2 * jp]), __builtin_amdgcn_exp2f(S[hx][ni][2 * jp + 1])) & pm[ni][jp];
      }
#define DS_PV(di, ta, tb) { const bf16x8 av = __builtin_bit_cast(bf16x8, (i64x2){ta, tb}); \
        O[0][di] = __builtin_amdgcn_mfma_f32_16x16x32_bf16(av, pb0, O[0][di], 0, 0, 0); O[1][di] = __builtin_amdgcn_mfma_f32_16x16x32_bf16(av, pb1, O[1][di], 0, 0, 0); }
      DS_TRW(t0, t1, t2, t3, t4, t5, t6, t7);
      {
        u32x4 pw;
        pw.x = pk[0][0][0]; pw.y = pk[0][0][1]; pw.z = pk[0][1][0]; pw.w = pk[0][1][1];
        const bf16x8 pb0 = __builtin_bit_cast(bf16x8, pw);
        pw.x = pk[1][0][0]; pw.y = pk[1][0][1]; pw.z = pk[1][1][0]; pw.w = pk[1][1][1];
        const bf16x8 pb1 = __builtin_bit_cast(bf16x8, pw);
        DS_TRI(0, 4096, va4, va5, va6, va7, u0, u1, u2, u3, u4, u5, u6, u7);
        __builtin_amdgcn_sched_barrier(0);
        Lacc[0] = __builtin_amdgcn_mfma_f32_16x16x32_bf16(ones8, pb0, Lacc[0], 0, 0, 0);
        Lacc[1] = __builtin_amdgcn_mfma_f32_16x16x32_bf16(ones8, pb1, Lacc[1], 0, 0, 0);
        DS_PV(0, t0, t1) DS_PV(1, t2, t3) DS_PV(2, t4, t5) DS_PV(3, t6, t7)
        __builtin_amdgcn_sched_barrier(0);
        DS_TRW(u0, u1, u2, u3, u4, u5, u6, u7);
        DS_TRI(8192, 12288, va0, va1, va2, va3, t0, t1, t2, t3, t4, t5, t6, t7);
        __builtin_amdgcn_sched_barrier(0);
        DS_PV(4, u0, u1) DS_PV(5, u2, u3) DS_PV(6, u4, u5) DS_PV(7, u6, u7)
        __builtin_amdgcn_sched_barrier(0);
      }
      {
        u32x4 pw;
        pw.x = pk[0][2][0]; pw.y = pk[0][2][1]; pw.z = pk[0][3][0]; pw.w = pk[0][3][1];
        const bf16x8 pb0 = __builtin_bit_cast(bf16x8, pw);
        pw.x = pk[1][2][0]; pw.y = pk[1][2][1]; pw.z = pk[1][3][0]; pw.w = pk[1][3][1];
        const bf16x8 pb1 = __builtin_bit_cast(bf16x8, pw);
        DS_TRW(t0, t1, t2, t3, t4, t5, t6, t7);
        DS_TRI(8192, 12288, va4, va5, va6, va7, u0, u1, u2, u3, u4, u5, u6, u7);
        __builtin_amdgcn_sched_barrier(0);
        Lacc[0] = __builtin_amdgcn_mfma_f32_16x16x32_bf16(ones8, pb0, Lacc[0], 0, 0, 0);
        Lacc[1] = __builtin_amdgcn_mfma_f32_16x16x32_bf16(ones8, pb1, Lacc[1], 0, 0, 0);
        DS_PV(0, t0, t1) DS_PV(1, t2, t3) DS_PV(2, t4, t5) DS_PV(3, t6, t7)
        __builtin_amdgcn_sched_barrier(0);
        DS_TRW(u0, u1, u2, u3, u4, u5, u6, u7);
        DS_PV(4, u0, u1) DS_PV(5, u2, u3) DS_PV(6, u4, u5) DS_PV(7, u6, u7)
      }
#undef DS_PV
#undef DS_TRI
#undef DS_TRW
    }
    asm volatile("s_waitcnt vmcnt(0)" ::: "memory");
#pragma unroll
    for (int hx = 0; hx < 2; ++hx) {
      const float inv = 1.0f / Lacc[hx][0];
      bf16_t* op = A2 + (q0 + qh + fr) * 1024 + 512 + (hd0 + hx) * 128 + fq * 4;
#pragma unroll
      for (int di = 0; di < 8; ++di) { u32x2 wv2; wv2.x = pk2(O[hx][di][0] * inv, O[hx][di][1] * inv); wv2.y = pk2(O[hx][di][2] * inv, O[hx][di][3] * inv); *(u32x2*)(op + di * 16) = wv2; }
    }
    __syncthreads();
  }
#undef DS_ISSUE
#undef DS_GLDS
}
__device__ __forceinline__ void phase3(const Params& p) {
  for (int rep = 0; rep < ((PROBE_DBL == 31) ? 2 : 1); ++rep)
  for (int id = blockIdx.x; id < 64; id += gridDim.x) { mlstm_item(p, id); __syncthreads(); }
  unsigned* qctr = (unsigned*)(p.ws + OFF_CTL) + CW_Q;
  LAS unsigned* qk = (LAS unsigned*)(SMEM + LDS_MISC);
  for (;;) {
    __syncthreads();
    if (threadIdx.x == 0) qk[0] = __hip_atomic_fetch_add(qctr, 1u, __ATOMIC_RELAXED, __HIP_MEMORY_SCOPE_AGENT);
    __syncthreads();
    const unsigned k = qk[0];
    if (k >= 1024u) break;
    dsa_item(p, (int)(k & 15u), 63 - (int)(k >> 4));
  }
}
struct EpiY { bf16_t* Y; int m0, n0;
  __device__ __forceinline__ void operator()(LAS const float* tile, int r, int c0) const { *(u32x4*)(Y + (size_t)(m0 + r) * 1024 + n0 + c0) = pack8(tile + r * TILE_LD + c0); } };
__device__ __forceinline__ void rows6(const Params& p, int row0) {
  const int tid_ = opaque_tid(); const int lane = tid_ & 63, wv = tid_ >> 6;
  const float* mb = (const float*)(p.ws + OFF_MOD) + (row0 >> 12) * 6144;
  const bf16_t* Y = (const bf16_t*)(p.ws + OFF_Y);
  bf16_t* H2 = (bf16_t*)(p.ws + OFF_ACTA); bf16_t* H2L = (bf16_t*)(p.ws + OFF_H2LO);
  float4 gpo[4], gt1[4], gpr[4], sh2[4], sc2[4];
#pragma unroll
  for (int i = 0; i < 4; ++i) { const int c = (lane + 64 * i) * 4; gpo[i] = *(const float4*)(p.g_mix_post + c); gt1[i] = *(const float4*)(mb + 2048 + c);
    gpr[i] = *(const float4*)(p.g_ffn_pre + c); sh2[i] = *(const float4*)(mb + 3072 + c); sc2[i] = *(const float4*)(mb + 4096 + c); }
  u32x2 yn[4]; float4 xn[4];
  const int rfirst = row0 + wv * 32;
#pragma unroll
  for (int i = 0; i < 4; ++i) { const int c = (lane + 64 * i) * 4; yn[i] = __builtin_nontemporal_load((const u32x2*)(Y + (size_t)rfirst * 1024 + c)); xn[i] = *(const float4*)(p.x + (size_t)rfirst * 1024 + c); }
#pragma unroll 1
  for (int r = 0; r < 32; ++r) {
    const int row = rfirst + r;
    u32x2 yc[4]; float4 xc[4];
#pragma unroll
    for (int i = 0; i < 4; ++i) { yc[i] = yn[i]; xc[i] = xn[i]; }
    if (r + 1 < 32) {
#pragma unroll
      for (int i = 0; i < 4; ++i) { const int c = (lane + 64 * i) * 4; yn[i] = __builtin_nontemporal_load((const u32x2*)(Y + (size_t)(row + 1) * 1024 + c)); xn[i] = *(const float4*)(p.x + (size_t)(row + 1) * 1024 + c); }
    }
    float y[16], xv[16]; float ssy = 0.f;
#pragma unroll
    for (int i = 0; i < 4; ++i) {
      y[4 * i] = bflo(yc[i].x); y[4 * i + 1] = bfhi(yc[i].x); y[4 * i + 2] = bflo(yc[i].y); y[4 * i + 3] = bfhi(yc[i].y);
      xv[4 * i] = xc[i].x; xv[4 * i + 1] = xc[i].y; xv[4 * i + 2] = xc[i].z; xv[4 * i + 3] = xc[i].w;
#pragma unroll
      for (int k = 0; k < 4; ++k) ssy += y[4 * i + k] * y[4 * i + k];
    }
    ssy = wave_sum(ssy);
    const float rsy = rsqrtf(ssy * (1.f / 1024.f) + EPS);
    float ss1 = 0.f;
#pragma unroll
    for (int i = 0; i < 4; ++i) {
      const int c = (lane + 64 * i) * 4;
      xv[4 * i] += gt1[i].x * (y[4 * i] * rsy * gpo[i].x); xv[4 * i + 1] += gt1[i].y * (y[4 * i + 1] * rsy * gpo[i].y);
      xv[4 * i + 2] += gt1[i].z * (y[4 * i + 2] * rsy * gpo[i].z); xv[4 * i + 3] += gt1[i].w * (y[4 * i + 3] * rsy * gpo[i].w);
      { u32x2 xb; xb.x = pk2(xv[4 * i], xv[4 * i + 1]); xb.y = pk2(xv[4 * i + 2], xv[4 * i + 3]); *(u32x2*)((bf16_t*)(p.out + (size_t)row * 1024) + c) = xb; }
#pragma unroll
      for (int k = 0; k < 4; ++k) ss1 += xv[4 * i + k] * xv[4 * i + k];
    }
    ss1 = wave_sum(ss1);
    const float rs1 = rsqrtf(ss1 * (1.f / 1024.f) + EPS);
#pragma unroll
    for (int i = 0; i < 4; ++i) {
      const int c = (lane + 64 * i) * 4;
      const float h0 = xv[4 * i] * rs1 * gpr[i].x * (1.f + sc2[i].x) + sh2[i].x, h1 = xv[4 * i + 1] * rs1 * gpr[i].y * (1.f + sc2[i].y) + sh2[i].y;
      const float h2 = xv[4 * i + 2] * rs1 * gpr[i].z * (1.f + sc2[i].z) + sh2[i].z, h3 = xv[4 * i + 3] * rs1 * gpr[i].w * (1.f + sc2[i].w) + sh2[i].w;
      const unsigned hw0 = pk2(h0, h1), hw1 = pk2(h2, h3);
      u32x2 hi; hi.x = hw0; hi.y = hw1;
      u32x2 lo; lo.x = pk2(h0 - bflo(hw0), h1 - bfhi(hw0)); lo.y = pk2(h2 - bflo(hw1), h3 - bfhi(hw1));
      *(u32x2*)(H2 + (size_t)row * 1024 + c) = hi; *(u32x2*)(H2L + (size_t)row * 1024 + c) = lo;
      { const int q8 = cvt4_fp8(__builtin_amdgcn_fmed3f(h0, -448.f, 448.f), __builtin_amdgcn_fmed3f(h1, -448.f, 448.f), __builtin_amdgcn_fmed3f(h2, -448.f, 448.f), __builtin_amdgcn_fmed3f(h3, -448.f, 448.f)); *(int*)(p.ws + OFF_H2Q + (size_t)row * 1024 + c) = q8; }
    }
  }
}
constexpr int LDS_RT = LDS_MAIN + 4 * GT_STAGE;
constexpr int LDS_RTX = LDS_RT + 512 + 320 + 1024;
__device__ __forceinline__ void route6g(const Params& p, int mt_begin, int mt_end) {
  const int tid = opaque_tid();
  GemmArgs<3> g{}; g.lda = 1024; g.ldb = 1024; g.K = 1024;
  const bf16_t* Hh = (const bf16_t*)(p.ws + OFF_ACTA); const bf16_t* Hl = (const bf16_t*)(p.ws + OFF_H2LO);
  const bf16_t* Wh = (const bf16_t*)(p.ws + OFF_WR); const bf16_t* Wl = Wh + 128 * 1024;
  g.A0 = Hh; g.B0 = Wh; g.A1 = Hl; g.B1 = Wh; g.A2 = Hh; g.B2 = Wl;
  unsigned* cnt = (unsigned*)(p.ws + OFF_CTL) + CW_CNT;
  int* SORTED = (int*)(p.ws + OFF_SORTED); float* GW = (float*)(p.ws + OFF_GW);
  LAS unsigned* cntl = (LAS unsigned*)(SMEM + LDS_RT); LAS unsigned* basel = cntl + 64;
  for (int rep6 = ((PROBE_DBL == 66) ? 0 : 1); rep6 < 2; ++rep6)
  for (int mt = mt_begin; mt < mt_end; ++mt) {
    const long ar = (long)mt * 128 + (tid >> 3);
    if (tid < 64) cntl[tid] = 0u;
    gemm_mainloop<3, true>(g, ar, ar + 64);
    LAS float* tile = (LAS float*)(SMEM + LDS_MAIN);
    const int tok = mt * 128 + tid;
    LAS int* rei = (LAS int*)(SMEM + LDS_RTX) + tid * 8; LAS float* rgw = (LAS float*)(SMEM + LDS_RTX + 4096) + tid * 8; LAS unsigned* rrk = (LAS unsigned*)(SMEM + LDS_RTX + 8192) + tid * 8;
    if (tid < 128) {
      LAS float* tr = tile + tid * TILE_LD;
      for (int e = 0; e < 64; ++e) { const float s = sigmoidf_(tr[e]); tr[64 + e] = s; tr[e] = s + p.b_router[e]; }
      float gs[8];
#pragma unroll
      for (int gi = 0; gi < 8; ++gi) {
        float m1 = -INFINITY, m2 = -INFINITY;
#pragma unroll
        for (int k = 0; k < 8; ++k) { const float v = tr[gi * 8 + k]; if (v > m1) { m2 = m1; m1 = v; } else if (v > m2) m2 = v; }
        gs[gi] = m1 + m2;
      }
#pragma unroll
      for (int gi = 0; gi < 8; ++gi) {
        int rank = 0;
#pragma unroll
        for (int gj = 0; gj < 8; ++gj) rank += (gs[gj] > gs[gi] || (gs[gj] == gs[gi] && gj < gi)) ? 1 : 0;
        if (rank >= 4) {
#pragma unroll
          for (int k = 0; k < 8; ++k) tr[gi * 8 + k] = -INFINITY; }
      }
      float gsum = 0.f;
#pragma unroll 1
      for (int it = 0; it < 8; ++it) {
        float best = -INFINITY; int bi = 0;
        for (int e = 0; e < 64; ++e) { const float v = tr[e]; if (v > best) { best = v; bi = e; } }
        const float sv = tr[64 + bi];
        rei[it] = bi; rgw[it] = sv; gsum += sv; tr[bi] = -INFINITY;
      }
      const float gn = 2.5f / gsum;
#pragma unroll 1
      for (int it = 0; it < 8; ++it) { rgw[it] *= gn; rrk[it] = __hip_atomic_fetch_add(cntl + rei[it], 1u, __ATOMIC_RELAXED, __HIP_MEMORY_SCOPE_WORKGROUP); }
    }
    __syncthreads();
    if (tid < 64) { const unsigned c = cntl[tid]; basel[tid] = (c && rep6 == 1) ? __hip_atomic_fetch_add(cnt + tid, c, __ATOMIC_RELAXED, __HIP_MEMORY_SCOPE_AGENT) : 0u; }
    __syncthreads();
    if (tid < 128 && rep6 == 1) {
#pragma unroll 1
      for (int it = 0; it < 8; ++it) {
        const int e = rei[it];
        const unsigned pos = basel[e] + rrk[it];
        u32x2 rec; rec.x = (unsigned)(tok * 8 + it); rec.y = __builtin_bit_cast(unsigned, rgw[it]);
        *(u32x2*)(SORTED + ((size_t)e * 65536 + pos) * 2) = rec;
      }
    }
    __syncthreads();
  }
}

struct PanelOrder {
  static constexpr bool REC = false, BSTAT = false; static constexpr int SCALE_A = 0, SCALE_B = 0;
  int pm; const char* Bt;
  __device__ __forceinline__ bool next(int i, pg8::Unit& u) const { if (i >= 4) return false; u.pm = pm; u.pn = i; u.e = 0; u.lt = 0; return true; }
  __device__ __forceinline__ const char* b_base(const pg8::Unit& u) const { return Bt + (size_t)u.pn * 256 * 1024 * 2; }
  __device__ __forceinline__ unsigned a_off(const pg8::Unit& u, int row) const { return (unsigned)(u.pm * 256 + row) * 2048u; }
  __device__ __forceinline__ const char* rec_ptr(const pg8::Unit&) const { return nullptr; }
  __device__ __forceinline__ bool has_rec(const pg8::Unit&) const { return false; }
  __device__ __forceinline__ bool row_valid(const pg8::Unit&, int) const { return true; }
  __device__ __forceinline__ int nvalid(const pg8::Unit&) const { return 256; }
  __device__ __forceinline__ unsigned a_off_idx(const pg8::Unit&, int, int) const { return 0u; }
};
__device__ __forceinline__ void phase56(const Params& p) {
#pragma unroll 1
  for (int pm = blockIdx.x; pm < 256; pm += gridDim.x) {
    PanelOrder S{pm, (const char*)(p.ws + OFF_WOUT)};
    pg8::EpiStoreBf16 E{(bf16_t*)(p.ws + OFF_Y), 1024};
    pg8::gemm_phase(SMEM + LDS_PG8, (const bf16_t*)(p.ws + OFF_ACTA), 1024, S, E);
    rows6(p, pm * 256);
    asm volatile("s_waitcnt vmcnt(0)" ::: "memory");
    __syncthreads();
    route6g(p, pm * 2, pm * 2 + 2);
  }
}
constexpr int LDS_PRE = LDS_PG8 + 131072 + 8192 + 256;
constexpr int LDS_TAB = LDS_PRE + 1024;
typedef float f32x2 __attribute__((ext_vector_type(2)));
__device__ __forceinline__ void moe_prefix(const Params& p) {
  LAS int* pre = (LAS int*)(SMEM + LDS_PRE); LAS unsigned char* tab = SMEM + LDS_TAB;
  const unsigned* cnt = (const unsigned*)(p.ws + OFF_CTL) + CW_CNT;
  __syncthreads();
  if (threadIdx.x < 64) {
    const int e = threadIdx.x; const int c = (int)cnt[e]; const int nt_ = (c + 255) >> 8; int inc = nt_;
#pragma unroll
    for (int d = 1; d < 64; d <<= 1) { const int o = __shfl_up(inc, d, 64); if (e >= d) inc += o; }
    const int beg = inc - nt_;
    pre[e] = beg; if (e == 63) pre[64] = inc; pre[128 + e] = c;
    for (int t = beg; t < inc; ++t) tab[t] = (unsigned char)e;
  }
  __syncthreads();
}
template <int SA, int SB, int NT, bool BS = false>
struct MoeOrder {
  static constexpr bool REC = true, BSTAT = BS;
  static constexpr int SCALE_A = SA * 0x01010101, SCALE_B = SB * 0x01010101;
  int R, nwg, G, c, hf, mode, rowbytes, routed; const unsigned* cnt; const int* list; const char* W; size_t estride, tstride;
  __device__ __forceinline__ bool next(int i, pg8::Unit& u) const {
    const int cc = (c & 7) * (G >> 3) + (c >> 3);
    if (BS) {
      const int nch = G / NT, j = cc / NT, q = R / nch, r = R - q * nch;
      const int start = j * q + (j < r ? j : r), len = q + (j < r ? 1 : 0);
      if (j >= nch || i >= len) return false;
      u.pm = start + i; u.pn = cc - j * NT;
    } else {
    const int L = i * G + cc; if (L >= nwg) return false;
    u.pm = L / NT; u.pn = L - u.pm * NT; }
    if (u.pm >= routed) { u.e = 64; u.lt = u.pm - routed; }
    else { u.e = (int)(SMEM + LDS_TAB)[u.pm]; u.lt = u.pm - ((LAS const int*)(SMEM + LDS_PRE))[u.e]; }
    return true;
  }
  __device__ __forceinline__ const char* b_base(const pg8::Unit& u) const { return W + (size_t)u.e * estride + (size_t)u.pn * tstride; }
  __device__ __forceinline__ const char* rec_ptr(const pg8::Unit& u) const { return (const char*)(list + ((size_t)(u.e < 64 ? u.e : 0) * 65536 + (u.e < 64 ? u.lt * 256 : 0)) * 2); }
  __device__ __forceinline__ bool has_rec(const pg8::Unit& u) const { return u.e < 64; }
  __device__ __forceinline__ bool row_valid(const pg8::Unit& u, int row) const { return (u.lt * 256 + row) < ((LAS const int*)(SMEM + LDS_PRE))[128 + (u.e < 64 ? u.e : 0)]; }
  __device__ __forceinline__ int nvalid(const pg8::Unit& u) const { return ((LAS const int*)(SMEM + LDS_PRE))[128 + (u.e < 64 ? u.e : 0)] - u.lt * 256; }
  __device__ __forceinline__ unsigned a_off_idx(const pg8::Unit& u, int row, int idx) const { const int arow = (mode == 0) ? (idx >> 3) : idx; return (unsigned)arow * (unsigned)rowbytes; }
  __device__ __forceinline__ unsigned a_off(const pg8::Unit& u, int row) const {
    const int tl = u.lt * 256 + row; const int arow = (mode == 0) ? tl : (524288 + tl);
    return (unsigned)arow * (unsigned)rowbytes;
  }
};
constexpr int LDS_EPI = LDS_TAB + 2560;
#define EPI_BAR() do { asm volatile("s_waitcnt lgkmcnt(0)" ::: "memory"); __builtin_amdgcn_s_barrier(); } while (0)
struct EpiU { unsigned char* U; const unsigned* cnt; const int* list; int hf;
  __device__ __forceinline__ void operator()(const f32x4 (&acc)[2][2][4][2], const pg8::Unit& u, int wr, int wc, int fr, int fq, LAS const unsigned char* rec) const {
    const bool rt = u.e < 64;
    const int nrow = rt ? ((LAS const int*)(SMEM + LDS_PRE))[128 + u.e] : 0x7fffffff;
    LAS unsigned char* st = SMEM + LDS_EPI;
    const int tid = (wr * 4 + wc) * 64 + fq * 16 + fr;
    const int c16 = tid & 7;
    int ridx[2][2];
#pragma unroll
    for (int ai = 0; ai < 2; ++ai)
#pragma unroll
      for (int i = 0; i < 2; ++i) ridx[ai][i] = *(LAS const int*)(rec + (ai * 128 + ((tid + 512 * i) >> 3)) * 8);
    unsigned dp[2][2]; bool ok[2][2];
#pragma unroll
    for (int ai = 0; ai < 2; ++ai)
#pragma unroll
      for (int i = 0; i < 2; ++i) {
        const int li = u.lt * 256 + ai * 128 + ((tid + 512 * i) >> 3);
        ok[ai][i] = li < nrow;
        const int ur = rt ? ridx[ai][i] : (524288 + li);
        dp[ai][i] = (unsigned)ur * 256u + (unsigned)(u.pn * 128 + c16 * 16);
      }
#pragma unroll
    for (int ai = 0; ai < 2; ++ai) {
      int gwu[4];
#pragma unroll
      for (int m = 0; m < 4; ++m) gwu[m] = ((LAS const int*)(rec + (ai * 128 + wr * 64 + m * 16 + fr) * 8))[1];
#pragma unroll
      for (int m = 0; m < 4; ++m) {
        const int gb = gwu[m]; const float us = rt ? U_SCALE * __builtin_bit_cast(float, gb) : U_SCALE;
#pragma unroll
        for (int bj = 0; bj < 2; ++bj) {
          const f32x4 g = acc[ai][bj][m][0], up = acc[ai][bj][m][1];
          float uu[4];
#pragma unroll
          for (int i = 0; i < 4; ++i) uu[i] = __builtin_amdgcn_fmed3f(siluf_(g[i]) * up[i] * us, -448.f, 448.f);
          const int w8 = cvt4_fp8(uu[0], uu[1], uu[2], uu[3]);
          *(LAS int*)(st + (wr * 64 + m * 16 + fr) * 144 + bj * 64 + wc * 16 + 4 * fq) = w8;
        }
      }
      EPI_BAR();
#pragma unroll
      for (int i = 0; i < 2; ++i) {
        const int row = (tid + 512 * i) >> 3;
        if (ok[ai][i]) { const u32x4 v = *(LAS const u32x4*)(st + row * 144 + c16 * 16); *(u32x4*)(U + dp[ai][i]) = v; }
      }
      EPI_BAR();
    }
  } };
__device__ __forceinline__ void phase7(const Params& p) {
  const int hf = 0; moe_prefix(p);
  const int routed = ((LAS const int*)(SMEM + LDS_PRE))[64];
  MoeOrder<127, 122, 2> S; S.R = routed + 256; S.nwg = S.R * 2; S.G = gridDim.x; S.c = blockIdx.x; S.hf = hf; S.mode = 0; S.rowbytes = 1024; S.routed = routed;
  S.cnt = (const unsigned*)(p.ws + OFF_CTL) + CW_CNT; S.list = (const int*)(p.ws + OFF_SORTED);
  S.W = (const char*)(p.ws + OFF_WGU); S.estride = (size_t)512 * 1024; S.tstride = (size_t)256 * 1024;
  EpiU E{p.ws + OFF_U, S.cnt, S.list, hf};
  pg8::gemm_phase<EpiU, MoeOrder<127, 122, 2>, true>(SMEM + LDS_PG8, (const bf16_t*)(p.ws + OFF_H2Q), 512, S, E);
}
#ifdef PROBE_WI
#define PWI PROBE_WI
#else
#define PWI 0
#endif
struct EpiYE { unsigned char* YE; const float* GW; const unsigned* cnt; const int* list; int hf; int pmode;
  __device__ __forceinline__ void operator()(const f32x4 (&acc)[2][2][4][2], const pg8::Unit& u, int wr, int wc, int fr, int fq, LAS const unsigned char* rec) const {
    const bool rt = u.e < 64;
    const int nrow = rt ? ((LAS const int*)(SMEM + LDS_PRE))[128 + u.e] : 0x7fffffff;
    LAS unsigned char* st = SMEM + LDS_EPI;
    const int tid = (wr * 4 + wc) * 64 + fq * 16 + fr;
    const int c16 = tid & 7;
    int ridx[2][2];
#pragma unroll
    for (int ai = 0; ai < 2; ++ai) {
#pragma unroll
      for (int i = 0; i < 2; ++i) ridx[ai][i] = *(LAS const int*)(rec + (ai * 128 + ((tid + 512 * i) >> 3)) * 8);
    }
    unsigned dp[2][2]; bool ok[2][2];
#pragma unroll
    for (int ai = 0; ai < 2; ++ai)
#pragma unroll
      for (int i = 0; i < 2; ++i) {
        const int li = u.lt * 256 + ai * 128 + ((tid + 512 * i) >> 3);
        ok[ai][i] = li < nrow;
        const int idx = ridx[ai][i];
        const int dst = rt ? ((idx >> 3) * 9 + (idx & 7)) : (li * 9 + 8);
        dp[ai][i] = (unsigned)dst * 1024u + (unsigned)(u.pn * 256 + c16 * 16);
      }
#pragma unroll
    for (int ai = 0; ai < 2; ++ai) {
#pragma unroll
      for (int bj = 0; bj < 2; ++bj) {
#pragma unroll
        for (int m = 0; m < 4; ++m) {
          const f32x4 v0 = acc[ai][bj][m][0], v1 = acc[ai][bj][m][1];
          float o[8];
#pragma unroll
          for (int i = 0; i < 4; ++i) { o[i] = v0[i]; o[4 + i] = v1[i]; }
          int w0 = 0, w1 = 0;
          if ((PWI & 64) && pmode) { w0 = __builtin_bit_cast(int, v0[0]); w1 = __builtin_bit_cast(int, v1[1]); } else {
#pragma unroll
          for (int i = 0; i < 8; ++i) o[i] = __builtin_amdgcn_fmed3f(o[i], -448.f, 448.f);
          if ((PWI & 512) && pmode) { v2i16_t q0 = {0, 0}, q1 = {0, 0};
            q0 = __builtin_amdgcn_cvt_scalef32_pk_fp8_f32(q0, o[0], o[1], 1.0f, false); q0 = __builtin_amdgcn_cvt_scalef32_pk_fp8_f32(q0, o[2], o[3], 1.0f, true);
            q1 = __builtin_amdgcn_cvt_scalef32_pk_fp8_f32(q1, o[4], o[5], 1.0f, false); q1 = __builtin_amdgcn_cvt_scalef32_pk_fp8_f32(q1, o[6], o[7], 1.0f, true);
            w0 = __builtin_bit_cast(int, q0); w1 = __builtin_bit_cast(int, q1); }
          else if ((PWI & 1024) && pmode) { v2i16_t q0 = {0, 0}, q1 = {0, 0};
            const unsigned b0 = pk2(o[0], o[1]), b1 = pk2(o[2], o[3]), b2 = pk2(o[4], o[5]), b3 = pk2(o[6], o[7]);
            q0 = __builtin_amdgcn_cvt_scalef32_pk_fp8_bf16(q0, __builtin_bit_cast(bf16x2_t, b0), 1.0f, false); q0 = __builtin_amdgcn_cvt_scalef32_pk_fp8_bf16(q0, __builtin_bit_cast(bf16x2_t, b1), 1.0f, true);
            q1 = __builtin_amdgcn_cvt_scalef32_pk_fp8_bf16(q1, __builtin_bit_cast(bf16x2_t, b2), 1.0f, false); q1 = __builtin_amdgcn_cvt_scalef32_pk_fp8_bf16(q1, __builtin_bit_cast(bf16x2_t, b3), 1.0f, true);
            w0 = __builtin_bit_cast(int, q0); w1 = __builtin_bit_cast(int, q1); }
          else           if ((PWI & 256) && pmode) { w0 = (int)(pk2(o[0], o[1]) ^ pk2(o[2], o[3])); w1 = (int)(pk2(o[4], o[5]) ^ pk2(o[6], o[7])); } else {
          w0 = cvt4_fp8(o[0], o[1], o[2], o[3]); w1 = cvt4_fp8(o[4], o[5], o[6], o[7]); } }
          u32x2 w; w.x = (unsigned)w0; w.y = (unsigned)w1;
          *(LAS u32x2*)(st + (wr * 64 + m * 16 + fr) * 144 + wc * 32 + 8 * fq) = w;
        }
        if (!(PWI & 128) || pmode == 0) EPI_BAR();
#pragma unroll
        for (int i = 0; i < 2; ++i) {
          const int row = (tid + 512 * i) >> 3;
          if (ok[ai][i]) {
            const u32x4 v = *(LAS const u32x4*)(st + row * 144 + c16 * 16);
            if (PROBE_DBL != 83 || pmode == 0 || v.x == 0x7fc12345u) *(u32x4*)(YE + (dp[ai][i] + (unsigned)(bj * 128))) = v;
          }
        }
        if (!(PWI & 128) || pmode == 0) EPI_BAR();
      }
    }
  } };
__device__ __forceinline__ void phase8(const Params& p, const int pmode = 0) {
  const int hf = 0; moe_prefix(p);
  const int routed = ((LAS const int*)(SMEM + LDS_PRE))[64];
  MoeOrder<125, 125, 4, true> S; S.R = routed + 256; S.nwg = S.R * 4; S.G = gridDim.x; S.c = blockIdx.x; S.hf = hf; S.mode = 1; S.rowbytes = 256; S.routed = routed;
  S.cnt = (const unsigned*)(p.ws + OFF_CTL) + CW_CNT; S.list = (const int*)(p.ws + OFF_SORTED);
  S.W = (const char*)(p.ws + OFF_WDN); S.estride = (size_t)1024 * 256; S.tstride = (size_t)256 * 256;
  EpiYE E{p.ws + OFF_YE, (const float*)(p.ws + OFF_GW), S.cnt, S.list, hf, pmode};
#ifdef PROBE_WI
  if (pmode) pg8::gemm_phase<EpiYE, MoeOrder<125, 125, 4, true>, true, PROBE_WI>(SMEM + LDS_PG8, (const bf16_t*)(p.ws + OFF_U), 128, S, E); else
#endif
  pg8::gemm_phase<EpiYE, MoeOrder<125, 125, 4, true>, true>(SMEM + LDS_PG8, (const bf16_t*)(p.ws + OFF_U), 128, S, E);
}
__device__ __forceinline__ void phase9(const Params& p) {
  const int tid_ = opaque_tid(); const int lane = tid_ & 63, gw = blockIdx.x * 8 + (tid_ >> 6), nw = gridDim.x * 8;
  const float* mod = (const float*)(p.ws + OFF_MOD);
  const unsigned char* YE = p.ws + OFF_YE;
  const int c = lane * 16;
  float4 gp[4];
#pragma unroll
  for (int i = 0; i < 4; ++i) gp[i] = *(const float4*)(p.g_ffn_post + c + 4 * i);
  u32x4 vn[9]; u32x4 xn[2];
  if (gw < T_TOK) {
#pragma unroll
    for (int s = 0; s < 9; ++s) vn[s] = *(const u32x4*)(YE + ((size_t)gw * 9 + s) * 1024 + c);
    xn[0] = *(const u32x4*)((const bf16_t*)(p.out + (size_t)gw * 1024) + c); xn[1] = *(const u32x4*)((const bf16_t*)(p.out + (size_t)gw * 1024) + c + 8);
  }
  for (int rep9 = ((PROBE_DBL == 9) ? 0 : 1); rep9 < 2; ++rep9)
#pragma unroll 1
  for (int row = gw; row < T_TOK; row += nw) {
    const int b = row >> 12;
    u32x4 vc[9]; u32x4 xc[2];
#pragma unroll
    for (int s = 0; s < 9; ++s) vc[s] = vn[s];
    xc[0] = xn[0]; xc[1] = xn[1];
    { const int rn = (row + nw < T_TOK) ? row + nw : row;
#pragma unroll
      for (int s = 0; s < 9; ++s) vn[s] = *(const u32x4*)(YE + ((size_t)rn * 9 + s) * 1024 + c);
      xn[0] = *(const u32x4*)((const bf16_t*)(p.out + (size_t)rn * 1024) + c); xn[1] = *(const u32x4*)((const bf16_t*)(p.out + (size_t)rn * 1024) + c + 8); }
    float acc[16];
#pragma unroll
    for (int i = 0; i < 16; ++i) acc[i] = 0.f;
#pragma unroll
    for (int s = 0; s < 9; ++s) {
      const unsigned vw[4] = {vc[s].x, vc[s].y, vc[s].z, vc[s].w};
#pragma unroll
      for (int k = 0; k < 4; ++k) {
        const f32x2 lo = __builtin_amdgcn_cvt_pk_f32_fp8((int)vw[k], false), hi = __builtin_amdgcn_cvt_pk_f32_fp8((int)vw[k], true);
        acc[4 * k] += lo[0]; acc[4 * k + 1] += lo[1]; acc[4 * k + 2] += hi[0]; acc[4 * k + 3] += hi[1];
      }
    }
    float ss = 0.f;
#pragma unroll
    for (int i = 0; i < 16; ++i) { acc[i] *= (1.0f / YE_SCALE); ss += acc[i] * acc[i]; }
    ss = wave_sum(ss);
    const float rs = rsqrtf(ss * (1.f / 1024.f) + EPS);
    float* op = p.out + (size_t)row * 1024 + c;
#pragma unroll
    for (int i = 0; i < 4; ++i) {
      const unsigned xw0 = (i == 0) ? xc[0].x : (i == 1) ? xc[0].z : (i == 2) ? xc[1].x : xc[1].z, xw1 = (i == 0) ? xc[0].y : (i == 1) ? xc[0].w : (i == 2) ? xc[1].y : xc[1].w;
      float4 x1 = make_float4(bflo(xw0), bfhi(xw0), bflo(xw1), bfhi(xw1));
      const float4 gt = *(const float4*)(mod + b * 6144 + 5120 + c + 4 * i);
      x1.x += gt.x * (acc[4 * i] * rs * gp[i].x); x1.y += gt.y * (acc[4 * i + 1] * rs * gp[i].y); x1.z += gt.z * (acc[4 * i + 2] * rs * gp[i].z); x1.w += gt.w * (acc[4 * i + 3] * rs * gp[i].w);
      if (rep9 == 1) *(float4*)(op + 4 * i) = x1; else if (x1.x == 123456.789f) *(float4*)(op + 4 * i) = x1;
    }
  }
}

#define DBL(n, call) do { call; if (PROBE_DBL == (n)) { xcd_barrier(bar); call; } } while (0)
#ifndef STOP_AFTER
#define STOP_AFTER 99
#endif
__global__ void __launch_bounds__(NTHR) fwd_kernel(Params p) {
  volatile LAS unsigned* st = (volatile LAS unsigned*)(SMEM + LDS_ST);
  if (threadIdx.x < 4) st[threadIdx.x] = 0u;
  __syncthreads();
  XcdBarrier bar = xcd_barrier_post((unsigned*)(p.ws + OFF_CTL) + CW_BAR, st);
  __syncthreads();
  DBL(0, phase0(p));  xcd_barrier(bar);
  DBL(1, phase1(p));  xcd_barrier(bar);
  DBL(2, phase2(p));  xcd_barrier(bar);
  DBL(20, phase2b(p)); xcd_barrier(bar);
  DBL(3, phase3(p));  xcd_barrier(bar);
  phase56(p); xcd_barrier(bar);
#ifdef PROBE_CLK
  long long pc0 = 0, pw0 = 0, pc1 = 0, pw1 = 0;
  if (PROBE_CLK == 7) { pc0 = clock64(); pw0 = wall_clock64(); }
#endif
  DBL(7, phase7(p)); xcd_barrier(bar);
  DBL(8, phase8(p)); if (PROBE_DBL == 83) { xcd_barrier(bar); phase8(p, 1); } xcd_barrier(bar);
#ifdef PROBE_CLK
  if (PROBE_CLK == 7) { pc1 = clock64(); pw1 = wall_clock64(); }
#endif
  phase9(p);
#ifdef PROBE_SAT
  {
    float a = 1000.f, b = 3.0e38f, c = 500.f, d = 448.f; asm volatile("" : "+v"(a), "+v"(b), "+v"(c), "+v"(d));
    const int r1 = cvt4_fp8(a, -a, c, d), r2 = cvt4_fp8(b, -b, 449.f + (a - 1000.f), -c);
    xcd_barrier(bar);
    if (blockIdx.x == 0 && threadIdx.x == 0 && (r1 != 0x7E7EFE7E || r2 != (int)0xFE7EFE7Eu)) p.out[0] = __builtin_nanf("");
  }
#endif
#ifdef PROBE_CLK
  if (blockIdx.x == 0 && threadIdx.x == 0) {
    const long long mhz = (pc1 - pc0) * 100 / (pw1 - pw0 + 1);
    const long long ticks = mhz * 25;
    const long long ts = wall_clock64();
    while (wall_clock64() - ts < ticks) __builtin_amdgcn_s_sleep(20);
  }
#endif
}

extern "C" void kernel_launch(void* const* d_in, const int* in_sizes, int n_in, void* d_out, int out_size, void* d_ws, size_t ws_size, hipStream_t stream) {
  static int grid_blocks = 0;
  if (!grid_blocks) {
    int dev = 0, cus = 0, per_cu = 0;
    (void)hipGetDevice(&dev);
    (void)hipDeviceGetAttribute(&cus, hipDeviceAttributeMultiprocessorCount, dev);
    (void)hipFuncSetAttribute((const void*)fwd_kernel, hipFuncAttributeMaxDynamicSharedMemorySize, LDS_BYTES);
    (void)hipOccupancyMaxActiveBlocksPerMultiprocessor(&per_cu, (const void*)fwd_kernel, NTHR, LDS_BYTES);
    grid_blocks = cus;
    if (per_cu < 1 || ws_size < WS_NEED || n_in != 25) fprintf(stderr, "kernel_launch: per_cu=%d ws=%zu need=%zu n_in=%d\n", per_cu, ws_size, (size_t)WS_NEED, n_in);
  }
  (void)hipMemsetAsync((char*)d_ws + OFF_CTL, 0, CTL_ZERO_BYTES, stream);
  Params p{};
  const float** f = (const float**)&p;
  for (int i = 0; i < 25; ++i) f[i] = (const float*)d_in[i];
  p.out = (float*)d_out; p.ws = (unsigned char*)d_ws;
  void* args[] = {&p};
  hipError_t e = hipLaunchCooperativeKernel((void*)fwd_kernel, dim3(grid_blocks), dim3(NTHR), args, LDS_BYTES, stream);
  if (e != hipSuccess) fprintf(stderr, "cooperative launch failed: %s (grid %d)\n", hipGetErrorString(e), grid_blocks);
}
```

```cpp
#include <hip/hip_runtime.h>
#include <cstdio>
#include <cstdint>
#ifndef PROBE_DBL
#define PROBE_DBL -1
#endif
#define LAS __attribute__((address_space(3)))
typedef unsigned short bf16_t;
typedef short bf16x8 __attribute__((ext_vector_type(8)));
typedef float f32x4 __attribute__((ext_vector_type(4)));
typedef unsigned u32x4 __attribute__((ext_vector_type(4)));
typedef unsigned u32x2 __attribute__((ext_vector_type(2)));
typedef short v4i16_t __attribute__((ext_vector_type(4)));

constexpr int T_TOK = 65536, DM = 1024, SEQ = 4096, NB = 16;
constexpr int NPROJ = 3328; constexpr int PLD = 3072;
constexpr float EPS = 1e-6f;
constexpr int NTHR = 512;
constexpr size_t MB = 1u << 20;
constexpr size_t OFF_CTL = 0;
constexpr size_t OFF_MOD = 64 * 1024;
constexpr size_t CTL_ZERO_BYTES = 64 * 1024 + 512 * 1024;
constexpr size_t OFF_ROPE = 1 * MB;
constexpr size_t OFF_WR = 2 * MB;
constexpr size_t OFF_WIN = 3 * MB;
constexpr size_t OFF_WOUT = 10 * MB;
constexpr size_t OFF_WGU = 12 * MB;
constexpr size_t OFF_WDN = 80 * MB;
constexpr size_t OFF_ACTA = 116 * MB;
constexpr size_t OFF_P = 244 * MB;
constexpr size_t OFF_PROJ = OFF_P + 0;
constexpr size_t OFF_MQKC = OFF_P + 384 * MB;
constexpr size_t OFF_AK = OFF_P + 512 * MB;
constexpr size_t OFF_IK = OFF_P + 528 * MB;
constexpr size_t OFF_GATES = OFF_P + 536 * MB;
constexpr size_t OFF_IW = OFF_P + 538 * MB;
constexpr size_t OFF_PROJL = OFF_P + 540 * MB;
constexpr size_t OFF_HMRAW = OFF_P + 572 * MB;
constexpr size_t OFF_BITM = OFF_P + 636 * MB;
constexpr size_t OFF_GL = OFF_P + 668 * MB;
constexpr size_t OFF_Y = OFF_P + 0;
constexpr size_t OFF_H2LO = OFF_P + 128 * MB;
constexpr size_t OFF_SORTED = 932 * MB;
constexpr size_t OFF_GW = OFF_P + 272 * MB;
constexpr size_t OFF_H2Q = 868 * MB;
constexpr size_t OFF_U = 724 * MB;
constexpr size_t OFF_YE = 120 * MB;
constexpr size_t WS_NEED = 964 * MB;
constexpr int CW_BAR = 0;
constexpr int CW_CNT = 4096;
constexpr int CW_Q = 4352;
constexpr float YE_SCALE = 16.0f;
constexpr float U_SCALE = 16.0f;

struct Params {
  const float *x, *c, *w_ada, *b_ada, *g_mix_pre, *g_mix_post, *g_ffn_pre, *g_ffn_post, *w_in, *conv_w, *conv_b, *b_igate, *b_fgate,
      *g_mlstm_head, *g_idx_k, *b_idx_k, *w_out, *w_router, *b_router, *w_exp_gate, *w_exp_up, *w_exp_down, *w_sh_gate, *w_sh_up, *w_sh_down;
  float* out; unsigned char* ws;
};

__device__ __forceinline__ unsigned f2bf(float f) { unsigned u = __builtin_bit_cast(unsigned, f); return (u + 0x7fffu + ((u >> 16) & 1u)) >> 16; }
typedef float f32x2_t __attribute__((ext_vector_type(2)));
typedef __bf16 bf16x2_t __attribute__((ext_vector_type(2)));
__device__ __forceinline__ unsigned pk2(float lo, float hi) { const f32x2_t v = {lo, hi}; const bf16x2_t b = __builtin_convertvector(v, bf16x2_t); return __builtin_bit_cast(unsigned, b); }
__device__ __forceinline__ float bf2f(unsigned h) { return __builtin_bit_cast(float, h << 16); }
__device__ __forceinline__ float bflo(unsigned w) { return __builtin_bit_cast(float, w << 16); }
__device__ __forceinline__ float bfhi(unsigned w) { return __builtin_bit_cast(float, w & 0xffff0000u); }
typedef short v2i16_t __attribute__((ext_vector_type(2)));
__device__ __forceinline__ int cvt4_fp8(float a, float b, float c, float d) {
  v2i16_t q = {0, 0};
  q = __builtin_amdgcn_cvt_scalef32_pk_fp8_f32(q, a, b, 1.0f, false);
  q = __builtin_amdgcn_cvt_scalef32_pk_fp8_f32(q, c, d, 1.0f, true);
  return __builtin_bit_cast(int, q);
}
__device__ __forceinline__ float add_s(float a, float b) { float r; asm("v_add_f32 %0, %1, %2" : "=v"(r) : "v"(a), "v"(b)); return r; }
__device__ __forceinline__ float mul_s(float a, float b) { float r; asm("v_mul_f32 %0, %1, %2" : "=v"(r) : "v"(a), "v"(b)); return r; }
__device__ __forceinline__ unsigned wave_incl_scan(unsigned x) {
  x += (unsigned)__builtin_amdgcn_update_dpp(0, (int)x, 0x111, 0xf, 0xf, false);
  x += (unsigned)__builtin_amdgcn_update_dpp(0, (int)x, 0x112, 0xf, 0xf, false);
  x += (unsigned)__builtin_amdgcn_update_dpp(0, (int)x, 0x114, 0xf, 0xf, false);
  x += (unsigned)__builtin_amdgcn_update_dpp(0, (int)x, 0x118, 0xf, 0xf, false);
  x += (unsigned)__builtin_amdgcn_update_dpp(0, (int)x, 0x142, 0xa, 0xf, false);
  x += (unsigned)__builtin_amdgcn_update_dpp(0, (int)x, 0x143, 0xc, 0xf, false);
  return x;
}
typedef unsigned u32x2s_t __attribute__((ext_vector_type(2)));
__device__ __forceinline__ float fmax_nc(float a, float b) { return __builtin_amdgcn_fmed3f(a, b, 3.0e38f); }
__device__ __forceinline__ float rowmax4(float v) {
  unsigned b = __builtin_bit_cast(unsigned, v);
  u32x2s_t r = __builtin_amdgcn_permlane16_swap(b, b, false, false);
  unsigned r0 = r.x, r1 = r.y;
  v = fmax_nc(__builtin_bit_cast(float, r0), __builtin_bit_cast(float, r1));
  b = __builtin_bit_cast(unsigned, v);
  r = __builtin_amdgcn_permlane32_swap(b, b, false, false);
  r0 = r.x; r1 = r.y;
  return fmax_nc(__builtin_bit_cast(float, r0), __builtin_bit_cast(float, r1));
}
__device__ __forceinline__ float rowsum4(float v) {
  unsigned b = __builtin_bit_cast(unsigned, v);
  u32x2s_t r = __builtin_amdgcn_permlane16_swap(b, b, false, false);
  unsigned r0 = r.x, r1 = r.y;
  v = __builtin_bit_cast(float, r0) + __builtin_bit_cast(float, r1);
  b = __builtin_bit_cast(unsigned, v);
  r = __builtin_amdgcn_permlane32_swap(b, b, false, false);
  r0 = r.x; r1 = r.y;
  return __builtin_bit_cast(float, r0) + __builtin_bit_cast(float, r1);
}
__device__ __forceinline__ float dpp_ror(float v, const int ctrl_sel) {
  const int b = __builtin_bit_cast(int, v);
  int r;
  if (ctrl_sel == 8) r = __builtin_amdgcn_update_dpp(0, b, 0x128, 0xf, 0xf, false);
  else if (ctrl_sel == 4) r = __builtin_amdgcn_update_dpp(0, b, 0x124, 0xf, 0xf, false);
  else if (ctrl_sel == 2) r = __builtin_amdgcn_update_dpp(0, b, 0x122, 0xf, 0xf, false);
  else r = __builtin_amdgcn_update_dpp(0, b, 0x121, 0xf, 0xf, false);
  return __builtin_bit_cast(float, r);
}
__device__ __forceinline__ float row_sum16(float v) { v += dpp_ror(v, 8); v += dpp_ror(v, 4); v += dpp_ror(v, 2); v += dpp_ror(v, 1); return v; }
__device__ __forceinline__ float wave_incl_scan_addf(float x) {
#define WS_STEP(ctrl, rm) x += __builtin_bit_cast(float, __builtin_amdgcn_update_dpp(0, __builtin_bit_cast(int, x), ctrl, rm, 0xf, false))
  WS_STEP(0x111, 0xf); WS_STEP(0x112, 0xf); WS_STEP(0x114, 0xf); WS_STEP(0x118, 0xf); WS_STEP(0x142, 0xa); WS_STEP(0x143, 0xc);
#undef WS_STEP
  return x;
}
__device__ __forceinline__ float wave_incl_scan_maxf(float x) {
  const int lo = __builtin_bit_cast(int, -1e30f);
#define WS_STEP(ctrl, rm) x = fmaxf(x, __builtin_bit_cast(float, __builtin_amdgcn_update_dpp(lo, __builtin_bit_cast(int, x), ctrl, rm, 0xf, false)))
  WS_STEP(0x111, 0xf); WS_STEP(0x112, 0xf); WS_STEP(0x114, 0xf); WS_STEP(0x118, 0xf); WS_STEP(0x142, 0xa); WS_STEP(0x143, 0xc);
#undef WS_STEP
  return x;
}
__device__ __forceinline__ float wave_sum(float v) {
  v += dpp_ror(v, 8); v += dpp_ror(v, 4); v += dpp_ror(v, 2); v += dpp_ror(v, 1);
  return rowsum4(v);
}
__device__ __forceinline__ int opaque_tid() { int t = threadIdx.x; asm volatile("" : "+v"(t)); return t; }
__device__ __forceinline__ float sigmoidf_(float x) { return __builtin_amdgcn_rcpf(1.0f + __expf(-x)); }
__device__ __forceinline__ float siluf_(float x) { return x * __builtin_amdgcn_rcpf(1.0f + __expf(-x)); }

#define XB_TMO      128
#define XB_XCNT(j)  (256  + 64 * (j))
#define XB_XSUB(j)  (1280 + 64 * (j))
#define XB_XGEN(j)  (2304 + 64 * (j))
#define XB_TOP      3328
#define XB_TOPGEN   3392
#define XCD_BAR_WORDS 3456
#define XB_SPIN_CAP (1u << 24)
__device__ __forceinline__ unsigned xb_ld(unsigned* p)              { return __hip_atomic_load(p, __ATOMIC_RELAXED, __HIP_MEMORY_SCOPE_AGENT); }
__device__ __forceinline__ unsigned xb_add(unsigned* p, unsigned v) { return __hip_atomic_fetch_add(p, v, __ATOMIC_RELAXED, __HIP_MEMORY_SCOPE_AGENT); }
__device__ __forceinline__ unsigned xb_xcc_id() { return (unsigned)__builtin_amdgcn_s_getreg((3 << 11) | 20) & 0xFu; }
#define XB_SPIN(cond, bar) do { unsigned _sp = 0; while (cond) { __builtin_amdgcn_s_sleep(1); \
    if ((++_sp & 255u) == 0u) { if (xb_ld(&(bar)[XB_TMO])) break; if (_sp > XB_SPIN_CAP) { xb_add(&(bar)[XB_TMO], 1u); break; } } } } while (0)
struct XcdBarrier { unsigned* bar; volatile LAS unsigned* st; };
__device__ __forceinline__ XcdBarrier xcd_barrier_post(unsigned* bar, volatile LAS unsigned* st) {
    XcdBarrier b; b.bar = bar; b.st = st;
    if (threadIdx.x == 0) { const unsigned x = xb_xcc_id(); st[2] = x; (void)xb_add(&bar[XB_XCNT(x)], 1u); }
    return b;
}
__device__ __forceinline__ void xcd_barrier_complete(unsigned* bar, unsigned x, unsigned& nloc, unsigned& nx) {
    const unsigned G = gridDim.x * gridDim.y * gridDim.z;
    unsigned sum, cnt, mine, sp = 0u;
    for (;;) {
        sum = 0u; cnt = 0u; mine = 0u;
#pragma unroll
        for (unsigned j = 0; j < 16; ++j) { const unsigned c = xb_ld(&bar[XB_XCNT(j)]); sum += c; cnt += (c > 0u) ? 1u : 0u; mine = (j == x) ? c : mine; }
        if (sum == G) break;
        __builtin_amdgcn_s_sleep(1);
        if ((++sp & 255u) == 0u) { if (xb_ld(&bar[XB_TMO])) break; if (sp > XB_SPIN_CAP) { xb_add(&bar[XB_TMO], 1u); break; } }
    }
    nloc = mine > 0u ? mine : 1u; nx = cnt > 0u ? cnt : 1u;
}
__device__ __forceinline__ void xcd_barrier(const XcdBarrier& b) {
    asm volatile("s_waitcnt vmcnt(0)" ::: "memory");
    __syncthreads();
    if (threadIdx.x == 0) {
        unsigned* bar = b.bar;
        __builtin_amdgcn_s_waitcnt(0);
        unsigned nloc = b.st[0], nx = b.st[1]; const unsigned bx = b.st[2];
        if (nloc == 0u) { xcd_barrier_complete(bar, bx, nloc, nx); b.st[0] = nloc; b.st[1] = nx; }
        const unsigned old = xb_add(&bar[XB_XSUB(bx)], 1u);
        const unsigned gen = old / nloc;
        if (old + 1u == (gen + 1u) * nloc) {
            __builtin_amdgcn_fence(__ATOMIC_RELEASE, "agent");
            asm volatile("s_waitcnt vmcnt(0)" ::: "memory");
            const unsigned og = xb_add(&bar[XB_TOP], 1u);
            const unsigned tg = og / nx;
            if (og + 1u == (tg + 1u) * nx) xb_add(&bar[XB_TOPGEN], 1u);
            else XB_SPIN(xb_ld(&bar[XB_TOPGEN]) == tg, bar);
            __builtin_amdgcn_fence(__ATOMIC_ACQUIRE, "agent");
            xb_add(&bar[XB_XGEN(bx)], 1u);
            asm volatile("s_waitcnt vmcnt(0)" ::: "memory");
        } else {
            XB_SPIN(xb_ld(&bar[XB_XGEN(bx)]) == gen, bar);
            __builtin_amdgcn_fence(__ATOMIC_ACQUIRE, "agent");
            asm volatile("s_waitcnt vmcnt(0)" ::: "memory");
        }
    }
    __syncthreads();
}

extern __shared__ __attribute__((aligned(16))) unsigned char smem_raw[];
#define SMEM ((LAS unsigned char*)smem_raw)
constexpr int LDS_ST = 0;
constexpr int LDS_MISC = 16;
constexpr int LDS_MAIN = 1040;
constexpr int LDS_BYTES = 160 * 1024;
constexpr int GT_STAGE = 32768, TILE_LD = 132;
__device__ __forceinline__ int swz_off(int r, int c8) { return r * 128 + ((c8 ^ (r & 7)) << 4); }
template <int NSEG> struct GemmArgs { const bf16_t *A0, *A1, *A2, *B0, *B1, *B2; int lda, ldb, K; };

template <int NSEG, bool NTA = false>
__device__ __forceinline__ void gemm_mainloop(const GemmArgs<NSEG>& g, long arow0, long arow1) {
  const int tid = opaque_tid(), lane = tid & 63, wid = __builtin_amdgcn_readfirstlane(tid >> 6), wr = wid >> 2, wc = wid & 3, fr = lane & 15, fq = lane >> 4;
  const int r0 = tid >> 3, cs = ((tid & 7) ^ (r0 & 7)) * 8;
  const int nk = g.K >> 6, nsteps = NSEG * nk;
  f32x4 acc[4][2];
#pragma unroll
  for (int m = 0; m < 4; ++m)
#pragma unroll
    for (int n = 0; n < 2; ++n) acc[m][n] = (f32x4){0.f, 0.f, 0.f, 0.f};
  LAS unsigned char* ring = SMEM + LDS_MAIN;
#define GM_ISSUE(s_) do { int s1_ = (s_) < nsteps ? (s_) : nsteps - 1; int seg_ = 0, ks_ = s1_; if (NSEG > 1) { seg_ = s1_ / nk; ks_ = s1_ - seg_ * nk; } \
    const bf16_t* Ap_ = g.A0; const bf16_t* Bp_ = g.B0; if (NSEG > 1) { if (seg_ == 1) { Ap_ = g.A1; Bp_ = g.B1; } else if (seg_ == 2) { Ap_ = g.A2; Bp_ = g.B2; } } \
    LAS unsigned char* st_ = ring + ((s_) & 3) * GT_STAGE + wid * 1024; const int k0_ = ks_ * 64 + cs; \
    if (NTA) { __builtin_amdgcn_global_load_lds((const unsigned*)(Ap_ + arow0 * g.lda + k0_), (LAS unsigned*)st_, 16, 0, 2); __builtin_amdgcn_global_load_lds((const unsigned*)(Ap_ + arow1 * g.lda + k0_), (LAS unsigned*)(st_ + 8192), 16, 0, 2); } \
    else { __builtin_amdgcn_global_load_lds((const unsigned*)(Ap_ + arow0 * g.lda + k0_), (LAS unsigned*)st_, 16, 0, 0); __builtin_amdgcn_global_load_lds((const unsigned*)(Ap_ + arow1 * g.lda + k0_), (LAS unsigned*)(st_ + 8192), 16, 0, 0); } \
    __builtin_amdgcn_global_load_lds((const unsigned*)(Bp_ + (long)r0 * g.ldb + k0_), (LAS unsigned*)(st_ + 16384), 16, 0, 0); \
    __builtin_amdgcn_global_load_lds((const unsigned*)(Bp_ + (long)(r0 + 64) * g.ldb + k0_), (LAS unsigned*)(st_ + 16384 + 8192), 16, 0, 0); } while (0)
  asm volatile("s_waitcnt vmcnt(0)" ::: "memory");
  GM_ISSUE(0); GM_ISSUE(1); GM_ISSUE(2);
#pragma unroll 1
  for (int s = 0; s < nsteps; ++s) {
    asm volatile("s_waitcnt vmcnt(8)" ::: "memory");
    asm volatile("s_waitcnt lgkmcnt(0)" ::: "memory");
    __builtin_amdgcn_s_barrier();
    GM_ISSUE(s + 3);
    LAS unsigned char* sa = ring + (s & 3) * GT_STAGE;
    LAS unsigned char* sb = sa + 16384;
#pragma unroll
    for (int kk = 0; kk < 2; ++kk) {
      bf16x8 af[4], bfr[2];
#pragma unroll
      for (int m = 0; m < 4; ++m) af[m] = *(LAS bf16x8*)(sa + swz_off(wr * 64 + m * 16 + fr, kk * 4 + fq));
#pragma unroll
      for (int n = 0; n < 2; ++n) bfr[n] = *(LAS bf16x8*)(sb + swz_off(wc * 32 + n * 16 + fr, kk * 4 + fq));
#pragma unroll
      for (int m = 0; m < 4; ++m)
#pragma unroll
        for (int n = 0; n < 2; ++n) acc[m][n] = __builtin_amdgcn_mfma_f32_16x16x32_bf16(af[m], bfr[n], acc[m][n], 0, 0, 0);
    }
  }
#undef GM_ISSUE
  asm volatile("s_waitcnt vmcnt(0)" ::: "memory");
  asm volatile("s_waitcnt lgkmcnt(0)" ::: "memory");
  __builtin_amdgcn_s_barrier();
  LAS float* tile = (LAS float*)(SMEM + LDS_MAIN);
#pragma unroll
  for (int m = 0; m < 4; ++m)
#pragma unroll
    for (int n = 0; n < 2; ++n)
#pragma unroll
      for (int j = 0; j < 4; ++j) tile[(wr * 64 + m * 16 + fq * 4 + j) * TILE_LD + wc * 32 + n * 16 + fr] = acc[m][n][j];
  __syncthreads();
}
template <int NSEG, class Epi>
__device__ __forceinline__ void gemm_tile(const GemmArgs<NSEG>& g, long arow0, long arow1, Epi&& epi) {
  gemm_mainloop<NSEG>(g, arow0, arow1);
  LAS const float* tile = (LAS const float*)(SMEM + LDS_MAIN);
  const int tid = opaque_tid();
#pragma unroll 1
  for (int i = 0; i < 4; ++i) { const int id = tid + i * NTHR; epi(tile, id >> 4, (id & 15) * 8); }
  __syncthreads();
}
__device__ __forceinline__ u32x4 pack8(LAS const float* p) {
  const f32x4 v0 = *(LAS const f32x4*)p, v1 = *(LAS const f32x4*)(p + 4);
  u32x4 w; w.x = pk2(v0[0], v0[1]); w.y = pk2(v0[2], v0[3]); w.z = pk2(v1[0], v1[1]); w.w = pk2(v1[2], v1[3]); return w;
}

__device__ __forceinline__ int win_rowmap(int n) {
  if (n < 2048) return n;
  if (n < 2056) return 3136 + (n - 2048);
  if (n < 2568) return 2048 + (n - 2056);
  if (n < 2696) return 2560 + (n - 2568);
  if (n < 2824) return 2688 + (n - 2696);
  if (n < 3080) return 2816 + (n - 2824);
  if (n < 3144) return 3072 + (n - 3080);
  return n;
}
struct P1Step {
  const Params& p; int lane, nw, row; float4 g[4], vn[4], scn[4], shn[4];
  __device__ __forceinline__ void prefetch(int r) {
    const float* mod = (const float*)(p.ws + OFF_MOD) + (r >> 12) * 6144;
#pragma unroll
    for (int i = 0; i < 4; ++i) { vn[i] = ((const float4*)(p.x + (size_t)r * 1024))[lane + 64 * i]; shn[i] = *(const float4*)(mod + (lane + 64 * i) * 4); scn[i] = *(const float4*)(mod + 1024 + (lane + 64 * i) * 4); }
  }
  __device__ __forceinline__ void init(int tid_) {
    lane = tid_ & 63; nw = gridDim.x * 8; row = blockIdx.x * 8 + (tid_ >> 6);
#pragma unroll
    for (int i = 0; i < 4; ++i) g[i] = *(const float4*)(p.g_mix_pre + (lane + 64 * i) * 4);
    if (row < T_TOK) prefetch(row);
  }
  __device__ __forceinline__ void operator()() {
    if (row >= T_TOK) return;
    bf16_t* H1 = (bf16_t*)(p.ws + OFF_ACTA);
    float4 v[4], s1[4], h1[4]; float ss = 0.f;
#pragma unroll
    for (int i = 0; i < 4; ++i) { v[i] = vn[i]; s1[i] = scn[i]; h1[i] = shn[i]; ss += v[i].x * v[i].x + v[i].y * v[i].y + v[i].z * v[i].z + v[i].w * v[i].w; }
    { const int rn = (row + nw < T_TOK) ? row + nw : row; prefetch(rn); }
    ss = wave_sum(ss);
    const float rs = rsqrtf(ss * (1.0f / 1024.f) + EPS);
#pragma unroll
    for (int i = 0; i < 4; ++i) {
      const int c = (lane + 64 * i) * 4;
      u32x2 w;
      w.x = pk2(v[i].x * rs * g[i].x * (1.f + s1[i].x) + h1[i].x, v[i].y * rs * g[i].y * (1.f + s1[i].y) + h1[i].y);
      w.y = pk2(v[i].z * rs * g[i].z * (1.f + s1[i].z) + h1[i].z, v[i].w * rs * g[i].w * (1.f + s1[i].w) + h1[i].w);
      *(u32x2*)(H1 + (size_t)row * 1024 + c) = w;
    }
    row += nw;
  }
};
struct NoStep { __device__ __forceinline__ void operator()() const {} };
template <int KIND, int MODE, class H>
__device__ __forceinline__ void cvt_tile(const float* src, int ld_src, int nvalid, int k0, int n0, bf16_t* dst, int ld_dst, H& hook) {
  LAS bf16_t* tt = (LAS bf16_t*)(SMEM + LDS_MAIN);
  const int tid = opaque_tid();
  {
    const int n = tid & 63, kb = tid >> 6;
    const bool ok = (n0 + n) < nvalid;
    float vv[8];
#pragma unroll
    for (int i = 0; i < 8; ++i) { const int k = kb + 8 * i; vv[i] = ok ? src[(long)(k0 + k) * ld_src + n0 + n] : 0.f; }
    hook();
#pragma unroll
    for (int i = 0; i < 8; ++i) {
      const int k = kb + 8 * i;
      float v = vv[i];
      unsigned h = f2bf(v);
      if (MODE == 1) h = f2bf(v - bf2f(h));
      tt[n * 72 + k] = (bf16_t)h;
    }
  }
  __syncthreads();
  {
    const int n = tid >> 3, kc = tid & 7; const int nn = n0 + n;
    int r;
    if (KIND == 0) r = nn; else if (KIND == 1) r = win_rowmap(nn); else if (KIND == 2) r = (nn >> 2) * 8 + (nn & 3); else r = (nn >> 2) * 8 + 4 + (nn & 3);
    const u32x4 v = *(LAS const u32x4*)(tt + n * 72 + kc * 8);
    *(u32x4*)(dst + (long)r * ld_dst + k0 + kc * 8) = v;
  }
  __syncthreads();
}
template <int KIND, class H>
__device__ __forceinline__ void cvt_tile8(const float* src, int ld_src, int k0, int n0, unsigned char* dst, int ld_dst, float scale, H& hook) {
  LAS unsigned char* tt = SMEM + LDS_MAIN;
  const int tid = opaque_tid();
  {
    const int n = tid & 63, kb = tid >> 6;
    float vv[8];
#pragma unroll
    for (int i = 0; i < 4; ++i) { const int k = kb * 2 + 16 * i; vv[2 * i] = src[(long)(k0 + k) * ld_src + n0 + n]; vv[2 * i + 1] = src[(long)(k0 + k + 1) * ld_src + n0 + n]; }
    hook();
#pragma unroll
    for (int i = 0; i < 4; ++i) {
      const int k = kb * 2 + 16 * i;
      const float v0 = __builtin_amdgcn_fmed3f(vv[2 * i] * scale, -448.f, 448.f), v1 = __builtin_amdgcn_fmed3f(vv[2 * i + 1] * scale, -448.f, 448.f);
      v2i16_t wq = {0, 0}; wq = __builtin_amdgcn_cvt_scalef32_pk_fp8_f32(wq, v0, v1, 1.0f, false); const int w = __builtin_bit_cast(int, wq);
      *(LAS unsigned short*)(tt + n * 80 + k) = (unsigned short)(w & 0xffff);
    }
  }
  __syncthreads();
  if (tid < 256) {
    const int n = tid >> 2, kc = tid & 3; const int nn = n0 + n;
    int r;
    if (KIND == 0) r = nn; else if (KIND == 2) r = (nn >> 2) * 8 + (nn & 3); else r = (nn >> 2) * 8 + 4 + (nn & 3);
    const u32x4 v = *(LAS const u32x4*)(tt + n * 80 + kc * 16);
    *(u32x4*)(dst + (long)r * ld_dst + k0 + kc * 16) = v;
  }
  __syncthreads();
}
__device__ __forceinline__ void sincos_d(double a, float& s, float& c) {
  const double twopi = 6.283185307179586476925286766559, inv = 0.15915494309189533576888376337251;
  const double k = __builtin_rint(a * inv);
  const double r = a - k * twopi;
  const double r2 = r * r;
  double ts = 1.0, tc = 1.0, ss = 1.0, cs = 1.0;
#pragma unroll
  for (int i = 1; i <= 13; ++i) { tc = -tc * r2 / (double)((2 * i - 1) * (2 * i)); cs += tc; ts = -ts * r2 / (double)((2 * i) * (2 * i + 1)); ss += ts; }
  s = (float)(r * ss); c = (float)cs;
}
template <int PART>
__device__ __forceinline__ void phase01(const Params& p) {
  constexpr int NA = 22;
  unsigned char* ws = p.ws;
  const int tid = opaque_tid();
  constexpr int U_WIN = 16 * 52, U_WOUT = 256, U_EG = 65 * 64, U_EU = 65 * 64, U_ED = 65 * 64, U_R = 64, U_ADA = 192, U_ROPE = 192;
  constexpr int B1 = U_WIN, B2 = B1 + U_WOUT, B3 = B2 + U_EG, B4 = B3 + U_EU, B5 = B4 + U_ED, B6 = B5 + U_R, B7 = B6 + U_ADA, B8 = B7 + U_ROPE;
  P1Step step{p}; NoStep nostep;
  if (PART == 1) step.init(tid);
  const int ubeg = (PART == 0) ? (int)blockIdx.x : (int)(blockIdx.x + NA * gridDim.x), uend = (PART == 0) ? (int)(NA * gridDim.x < (unsigned)B8 ? NA * gridDim.x : B8) : B8;
  for (int u0 = ubeg; u0 < uend; u0 += gridDim.x) {
    const int u = (u0 < U_ADA) ? (B6 + u0) : ((u0 < B6 + U_ADA) ? (u0 - U_ADA) : u0);
    if (u < B1) { const int kt = u / 52, nt = u % 52; if (PART == 1) cvt_tile<1, 0>(p.w_in, 3148, 3148, kt * 64, nt * 64, (bf16_t*)(ws + OFF_WIN), 1024, step); else cvt_tile<1, 0>(p.w_in, 3148, 3148, kt * 64, nt * 64, (bf16_t*)(ws + OFF_WIN), 1024, nostep); }
    else if (u < B2) { const int v = u - B1, kt = v >> 4, nt = v & 15; if (PART == 1) cvt_tile<0, 0>(p.w_out, 1024, 1024, kt * 64, nt * 64, (bf16_t*)(ws + OFF_WOUT), 1024, step); else cvt_tile<0, 0>(p.w_out, 1024, 1024, kt * 64, nt * 64, (bf16_t*)(ws + OFF_WOUT), 1024, nostep); }
    else if (u < B4) {
      const bool up = u >= B3; const int v = up ? u - B3 : u - B2; const int e = v >> 6, kt = (v >> 2) & 15, nt = v & 3;
      const float* src = (e < 64) ? ((up ? p.w_exp_up : p.w_exp_gate) + (size_t)e * 1024 * 256) : (up ? p.w_sh_up : p.w_sh_gate);
      unsigned char* dst = ws + OFF_WGU + (size_t)e * 512 * 1024;
      if (PART == 1) { if (up) cvt_tile8<3>(src, 256, kt * 64, nt * 64, dst, 1024, 32.0f, step); else cvt_tile8<2>(src, 256, kt * 64, nt * 64, dst, 1024, 32.0f, step); }
      else { if (up) cvt_tile8<3>(src, 256, kt * 64, nt * 64, dst, 1024, 32.0f, nostep); else cvt_tile8<2>(src, 256, kt * 64, nt * 64, dst, 1024, 32.0f, nostep); }
    }
    else if (u < B5) {
      const int v = u - B4; const int e = v >> 6, kt = (v >> 4) & 3, nt = v & 15;
      const float* src = (e < 64) ? (p.w_exp_down + (size_t)e * 256 * 1024) : p.w_sh_down;
      if (PART == 1) cvt_tile8<0>(src, 1024, kt * 64, nt * 64, ws + OFF_WDN + (size_t)e * 1024 * 256, 256, 16.0f, step); else cvt_tile8<0>(src, 1024, kt * 64, nt * 64, ws + OFF_WDN + (size_t)e * 1024 * 256, 256, 16.0f, nostep);
    }
    else if (u < B6) {
      const int v = u - B5; const int lo = v >> 5, kt = (v >> 1) & 15, nt = v & 1;
      bf16_t* dst = (bf16_t*)(ws + OFF_WR) + (size_t)lo * 128 * 1024;
      if (PART == 1) { if (lo) cvt_tile<0, 1>(p.w_router, 64, 64, kt * 64, nt * 64, dst, 1024, step); else cvt_tile<0, 0>(p.w_router, 64, 64, kt * 64, nt * 64, dst, 1024, step); }
      else { if (lo) cvt_tile<0, 1>(p.w_router, 64, 64, kt * 64, nt * 64, dst, 1024, nostep); else cvt_tile<0, 0>(p.w_router, 64, 64, kt * 64, nt * 64, dst, 1024, nostep); }
    }
    else if (u < B7) {
      const int v = u - B6;
      LAS float* sc = (LAS float*)(SMEM + LDS_MAIN);
      LAS float* part = sc + 16 * 1024;
      for (int i = tid; i < 16 * 1024; i += NTHR) sc[i] = siluf_(p.c[i]);
      __syncthreads();
      const int jl = tid & 31, dq = tid >> 5, j = v * 32 + jl;
      float acc[16];
#pragma unroll
      for (int b = 0; b < 16; ++b) acc[b] = 0.f;
      const float* wp = p.w_ada + (size_t)(dq * 64) * 6144 + j;
#pragma unroll 8
      for (int d = 0; d < 64; ++d) {
        const float w = wp[(size_t)d * 6144];
#pragma unroll
        for (int b = 0; b < 16; ++b) acc[b] += sc[b * 1024 + dq * 64 + d] * w;
      }
#pragma unroll
      for (int b = 0; b < 16; ++b) part[(dq * 16 + b) * 32 + jl] = acc[b];
      __syncthreads();
      float* mod = (float*)(ws + OFF_MOD);
      {
        const int b = tid >> 5, jj = tid & 31;
        float sum = 0.f;
#pragma unroll
        for (int g = 0; g < 16; ++g) sum += part[(g * 16 + b) * 32 + jj];
        mod[b * 6144 + v * 32 + jj] = sum + p.b_ada[v * 32 + jj];
      }
      __syncthreads();
    }
    else {
      if (PART == 1) step();
      const int v = u - B7; const int idx = v * NTHR + tid;
      const int pos = idx / 24, f = idx - pos * 24;
      const double lt = 13.122363377404328;
      float s, c;
      if (f < 16) { const double inv = exp(-lt * (double)f * (2.0 / 32.0)); sincos_d((double)pos * inv, s, c);
        float* R = (float*)(ws + OFF_ROPE); R[(pos * 16 + f) * 2] = c; R[(pos * 16 + f) * 2 + 1] = s; }
      else { const int g = f - 16; const double inv = exp(-lt * (double)g * (2.0 / 16.0)); sincos_d((double)pos * inv, s, c);
        float* R = (float*)(ws + OFF_ROPE) + 4096 * 32; R[(pos * 8 + g) * 2] = c; R[(pos * 8 + g) * 2 + 1] = s; }
    }
  }
  if (PART == 1) { while (step.row < T_TOK) step(); }
}
namespace pg8 {
constexpr int BM = 256, BK = 64, HALF = 128, HTB = HALF * BK * 2, STAGE_BYTES = 8 * HTB;
__device__ __forceinline__ int lds_byte(int r, int c) { const int st = (r >> 4) * 2 + (c >> 5), rr = r & 15, cc = c & 31, ob = rr * 64 + cc * 2; return st * 1024 + (ob ^ (((ob >> 9) & 1) << 5)); }
__device__ __forceinline__ void stage_rc(int b, int& R, int& C) { const int st = b / 1024, sb = b % 1024, swz = sb ^ (((sb >> 9) & 1) << 5); R = (st >> 1) * 16 + swz / 64; C = (st & 1) * 32 + (swz % 64) / 2; }
__device__ __forceinline__ int perm32(int rho) { const int n = rho >> 4, i = rho & 15; return 8 * (i >> 2) + 4 * n + (i & 3); }
struct Unit { int pm, pn, e, lt; };
typedef int v8i_t __attribute__((ext_vector_type(8)));
typedef int v4i_t __attribute__((ext_vector_type(4)));
template <class Epi, class Sched, bool FP8 = false, int WI = 0>
__device__ __forceinline__ void gemm_phase(LAS unsigned char* lds, const bf16_t* Abase, const int K, const Sched& S, const Epi& E) {
    const int tid = opaque_tid(), wid = __builtin_amdgcn_readfirstlane(tid >> 6), lane = tid & 63, wr = wid >> 2, wc = wid & 3, fr = lane & 15, fq = lane >> 4;
    const int nt = K / BK;
    int Rr[2], Cc[2]; unsigned voffB[2];
#pragma unroll
    for (int i = 0; i < 2; ++i) { int R, C; stage_rc(tid * 16 + i * 8192, R, C); Rr[i] = R; Cc[i] = C * 2; const int Rb = (R & ~31) + perm32(R & 31); voffB[i] = (unsigned)(Rb * K + C) * 2u; }
    const size_t kstep = (size_t)(BK * 2);
    const size_t hstep = (size_t)HALF * K * 2;
    const unsigned ldsw = (unsigned)wid * 1024u;
    const int aoff = lds_byte(wr * 64 + fr, fq * 8), boff = lds_byte(wc * 32 + fr, fq * 8);
    const char* Ab = (const char*)Abase;
    LAS unsigned char* recb = lds + STAGE_BYTES;
#define PG8_RECISSUE(u_, slot_) do { if (Sched::REC) __builtin_amdgcn_global_load_lds((const unsigned*)(S.rec_ptr(u_) + tid * 4), (LAS unsigned*)(recb + (slot_) * 2048 + wid * 256), 4, 0, 0); } while (0)
#define PG8_AOFF(u_, slot_, row_) ((Sched::REC && S.has_rec(u_)) ? S.a_off_idx(u_, row_, *(const LAS int*)(recb + (slot_) * 2048 + (S.row_valid(u_, row_) ? (row_) : 0) * 8)) : S.a_off(u_, row_))
#define PG8_SA(b, h) (((b) * 2 + (h)) * HTB)
#define PG8_SB(b, h) ((4 + (b) * 2 + (h)) * HTB)
#define PG8_STAGEB(bufoff, gbase) do { if (!(WI & 2)) _Pragma("unroll") for (int _i = 0; _i < 2; ++_i) \
        __builtin_amdgcn_global_load_lds((const unsigned*)((const char*)(gbase) + voffB[_i]), (LAS unsigned*)(lds + (bufoff) + ldsw + _i * 8192), 16, 0, 0); } while (0)
#define PG8_STAGEA(bufoff, koff, o0, o1) do { if (!(WI & 1)) { \
        __builtin_amdgcn_global_load_lds((const unsigned*)(Ab + (koff) + (o0)), (LAS unsigned*)(lds + (bufoff) + ldsw), 16, 0, 0); \
        __builtin_amdgcn_global_load_lds((const unsigned*)(Ab + (koff) + (o1)), (LAS unsigned*)(lds + (bufoff) + ldsw + 8192), 16, 0, 0); } } while (0)
#define PG8_LDA(dst, b, h) do { if (!(WI & 8)) _Pragma("unroll") for (int m = 0; m < 4; ++m) { dst[m].lo = *(const LAS v4i_t*)(lds + PG8_SA(b, h) + aoff + m * 2048); dst[m].hi = *(const LAS v4i_t*)(lds + PG8_SA(b, h) + aoff + m * 2048 + 1024); } } while (0)
#define PG8_LDB(dst, b, h) do { if (!(WI & 8)) _Pragma("unroll") for (int n = 0; n < 2; ++n) { dst[n].lo = *(const LAS v4i_t*)(lds + PG8_SB(b, h) + boff + n * 2048); dst[n].hi = *(const LAS v4i_t*)(lds + PG8_SB(b, h) + boff + n * 2048 + 1024); } } while (0)
#define PG8_MMA(ai, bj, At, Bt) do { __builtin_amdgcn_s_setprio(1); if (!(WI & 16)) _Pragma("unroll") for (int m = 0; m < 4; ++m) _Pragma("unroll") for (int n = 0; n < 2; ++n) { \
        if (FP8) asm volatile("v_mfma_scale_f32_16x16x128_f8f6f4 %0, %1, %2, %0, %3, %4 op_sel_hi:[0,0,0]" : "+v"(acc[ai][bj][m][n]) : "v"(Bt[n]), "v"(At[m]), "v"(sclB), "v"(sclA)); \
        else { const v4i_t bl_ = Bt[n].lo, bh_ = Bt[n].hi, al_ = At[m].lo, ah_ = At[m].hi;     \
               acc[ai][bj][m][n] = __builtin_amdgcn_mfma_f32_16x16x32_bf16(__builtin_bit_cast(bf16x8, bl_), __builtin_bit_cast(bf16x8, al_), acc[ai][bj][m][n], 0, 0, 0); \
               acc[ai][bj][m][n] = __builtin_amdgcn_mfma_f32_16x16x32_bf16(__builtin_bit_cast(bf16x8, bh_), __builtin_bit_cast(bf16x8, ah_), acc[ai][bj][m][n], 0, 0, 0); } } \
        __builtin_amdgcn_s_setprio(0); } while (0)
#define PG8_WAIT_V(n) asm volatile("s_waitcnt vmcnt(" #n ")" ::: "memory")
#define PG8_WAIT_VF(f) do { if (Sched::BSTAT && (f)) asm volatile("s_waitcnt vmcnt(4)" ::: "memory"); else asm volatile("s_waitcnt vmcnt(8)" ::: "memory"); } while (0)
#define PG8_WAIT_VG(f) do { if (Sched::BSTAT && (f)) asm volatile("s_waitcnt vmcnt(5)" ::: "memory"); else asm volatile("s_waitcnt vmcnt(8)" ::: "memory"); } while (0)
#define PG8_WAIT_L(n) asm volatile("s_waitcnt lgkmcnt(" #n ")" ::: "memory")
#define PG8_BAR do { if (!(WI & 32)) __builtin_amdgcn_s_barrier(); } while (0)
#define PG8_SCHED __builtin_amdgcn_sched_barrier(0)
    Unit cur, nxt; int ui = 0;
    if (!S.next(0, cur)) return;
    f32x4 acc[2][2][4][2];
#pragma unroll
    for (int a = 0; a < 2; ++a)
#pragma unroll
        for (int b = 0; b < 2; ++b)
#pragma unroll
            for (int m = 0; m < 4; ++m)
#pragma unroll
                for (int n = 0; n < 2; ++n) acc[a][b][m][n] = (f32x4){0.f, 0.f, 0.f, 0.f};
    v8i_t At[4], B0[2], B1[2];
    if (WI & 8) { _Pragma("unroll") for (int m = 0; m < 4; ++m) At[m] = (v8i_t){tid, m, 3, 4, 5, 6, 7, 8}; B0[0] = B0[1] = B1[0] = B1[1] = (v8i_t){tid, 1, 2, 3, 4, 5, 6, 7}; }
    int sclA = Sched::SCALE_A, sclB = Sched::SCALE_B; asm volatile("" : "+v"(sclA), "+v"(sclB));
    const char* cB = S.b_base(cur);
    Unit nn; bool has_nn = false;
    if (Sched::REC) { has_nn = S.next(1, nn); PG8_RECISSUE(cur, 0); PG8_RECISSUE(has_nn ? nn : cur, 1); asm volatile("s_waitcnt vmcnt(0)" ::: "memory"); __syncthreads(); }
    unsigned vc00 = PG8_AOFF(cur, 0, Rr[0]) + Cc[0], vc01 = PG8_AOFF(cur, 0, Rr[1]) + Cc[1], vc10 = PG8_AOFF(cur, 0, HALF + Rr[0]) + Cc[0], vc11 = PG8_AOFF(cur, 0, HALF + Rr[1]) + Cc[1];
    int slot = 0; bool skp = false;
    PG8_STAGEB(PG8_SB(0, 0), cB); PG8_STAGEB(PG8_SB(0, 1), cB + hstep); PG8_STAGEA(PG8_SA(0, 0), 0, vc00, vc01); PG8_STAGEA(PG8_SA(0, 1), 0, vc10, vc11);
    if (wr == 1) PG8_BAR;
    PG8_WAIT_V(2); PG8_BAR;
    PG8_STAGEB(PG8_SB(1, 0), cB + kstep); PG8_STAGEA(PG8_SA(1, 0), kstep, vc00, vc01); PG8_STAGEB(PG8_SB(1, 1), cB + hstep + kstep);
    PG8_WAIT_V(6); PG8_BAR;
    for (;;) {
        bool has_next;
        if (Sched::REC) { has_next = has_nn; nxt = nn; has_nn = S.next(ui + 2, nn); } else has_next = S.next(ui + 1, nxt);
        const char* nB = has_next ? S.b_base(nxt) : cB;
        unsigned vn00 = vc00, vn01 = vc01, vn10 = vc10, vn11 = vc11;
        const int nslot = (slot + 1) & 3;
        if (Sched::REC) { PG8_RECISSUE(has_nn ? nn : cur, (slot + 2) & 3); }
        else if (has_next) { vn00 = S.a_off(nxt, Rr[0]) + Cc[0]; vn01 = S.a_off(nxt, Rr[1]) + Cc[1]; vn10 = S.a_off(nxt, HALF + Rr[0]) + Cc[0]; vn11 = S.a_off(nxt, HALF + Rr[1]) + Cc[1]; }
#pragma unroll 1
        for (int t = 0; t < nt; t += 2) {
            const bool last = (t == nt - 2);
            const bool skb = Sched::BSTAT && last && has_next && (nB == cB);
            const size_t ko1 = (size_t)(t + 1) * kstep;
            const size_t ko2 = last ? 0 : (size_t)(t + 2) * kstep, ko3 = ko2 + kstep;
            const char* b2 = last ? nB : cB + (size_t)(t + 2) * kstep; const char* b3 = b2 + kstep;
            if (Sched::REC && last && has_next) {
                if (S.has_rec(nxt)) {
                    const int nv = S.nvalid(nxt); LAS const unsigned char* rb = recb + nslot * 2048;
                    const int q00 = Rr[0] < nv ? Rr[0] : 0, q01 = Rr[1] < nv ? Rr[1] : 0, q10 = (HALF + Rr[0]) < nv ? (HALF + Rr[0]) : 0, q11 = (HALF + Rr[1]) < nv ? (HALF + Rr[1]) : 0;
                    const int i00 = *(LAS const int*)(rb + q00 * 8), i01 = *(LAS const int*)(rb + q01 * 8), i10 = *(LAS const int*)(rb + q10 * 8), i11 = *(LAS const int*)(rb + q11 * 8);
                    vn00 = S.a_off_idx(nxt, 0, i00) + Cc[0]; vn01 = S.a_off_idx(nxt, 0, i01) + Cc[1]; vn10 = S.a_off_idx(nxt, 0, i10) + Cc[0]; vn11 = S.a_off_idx(nxt, 0, i11) + Cc[1];
                } else { vn00 = S.a_off(nxt, Rr[0]) + Cc[0]; vn01 = S.a_off(nxt, Rr[1]) + Cc[1]; vn10 = S.a_off(nxt, HALF + Rr[0]) + Cc[0]; vn11 = S.a_off(nxt, HALF + Rr[1]) + Cc[1]; }
            }
            const unsigned o00 = last ? vn00 : vc00, o01 = last ? vn01 : vc01, o10 = last ? vn10 : vc10, o11 = last ? vn11 : vc11;
            PG8_LDB(B0, 0, 0); PG8_LDB(B1, 0, 1); PG8_SCHED; PG8_LDA(At, 0, 0); PG8_STAGEA(PG8_SA(1, 1), ko1, vc10, vc11);
            PG8_WAIT_VG(skp); PG8_WAIT_L(0); PG8_BAR; PG8_MMA(0, 0, At, B0); PG8_MMA(0, 1, At, B1); PG8_BAR; PG8_SCHED;
            PG8_LDA(At, 0, 1); if (!skb) { PG8_STAGEB(PG8_SB(0, 0), b2); PG8_STAGEB(PG8_SB(0, 1), b2 + hstep); } PG8_STAGEA(PG8_SA(0, 0), ko2, o00, o01);
            PG8_WAIT_VG(skb); PG8_WAIT_L(0); PG8_BAR; PG8_MMA(1, 0, At, B0); PG8_MMA(1, 1, At, B1); PG8_BAR; PG8_SCHED;
            PG8_LDB(B0, 1, 0); PG8_LDB(B1, 1, 1); PG8_SCHED; PG8_LDA(At, 1, 0); PG8_STAGEA(PG8_SA(0, 1), ko2, o10, o11);
            PG8_WAIT_VF(skb); PG8_WAIT_L(0); PG8_BAR; PG8_MMA(0, 0, At, B0); PG8_MMA(0, 1, At, B1); PG8_BAR; PG8_SCHED;
            PG8_LDA(At, 1, 1); if (!skb) { PG8_STAGEB(PG8_SB(1, 0), b3); PG8_STAGEB(PG8_SB(1, 1), b3 + hstep); } PG8_STAGEA(PG8_SA(1, 0), ko3, o00, o01);
            PG8_WAIT_VF(skb); PG8_WAIT_L(0);
            skp = skb; PG8_BAR; PG8_MMA(1, 0, At, B0); PG8_MMA(1, 1, At, B1); PG8_BAR; PG8_SCHED;
        }
        if (wr == 0) PG8_BAR;
        if (FP8) asm volatile("s_nop 15\n\ts_nop 15" ::: "memory");
        if (!(WI & 4)) E(acc, cur, wr, wc, fr, fq, (LAS const unsigned char*)(recb + slot * 2048));
        if (PROBE_DBL == 81 && FP8 && K == 128) E(acc, cur, wr, wc, fr, fq, (LAS const unsigned char*)(recb + slot * 2048));
        if (PROBE_DBL == 71 && FP8 && K == 512) E(acc, cur, wr, wc, fr, fq, (LAS const unsigned char*)(recb + slot * 2048));
        if (!has_next) break;
#pragma unroll
        for (int a = 0; a < 2; ++a)
#pragma unroll
            for (int b = 0; b < 2; ++b)
#pragma unroll
                for (int m = 0; m < 4; ++m)
#pragma unroll
                    for (int n = 0; n < 2; ++n) acc[a][b][m][n] = (f32x4){0.f, 0.f, 0.f, 0.f};
        cur = nxt; cB = nB; vc00 = vn00; vc01 = vn01; vc10 = vn10; vc11 = vn11; ++ui; slot = nslot;
        if (wr == 1) PG8_BAR;
    }
    PG8_WAIT_V(0);
    PG8_BAR;
#undef PG8_SA
#undef PG8_RECISSUE
#undef PG8_AOFF
#undef PG8_SB
#undef PG8_STAGEA
#undef PG8_STAGEB
#undef PG8_LDA
#undef PG8_LDB
#undef PG8_MMA
#undef PG8_WAIT_V
#undef PG8_WAIT_VF
#undef PG8_WAIT_VG
#undef PG8_WAIT_L
#undef PG8_BAR
#undef PG8_SCHED
}
struct DenseOrder {
    static constexpr bool REC = false, BSTAT = false; static constexpr int SCALE_A = 0, SCALE_B = 0;
    int nM, nN, nwg, G, c; const char* Bt; int K;
    __device__ __forceinline__ const char* rec_ptr(const Unit&) const { return nullptr; }
    __device__ __forceinline__ bool has_rec(const Unit&) const { return false; }
    __device__ __forceinline__ bool row_valid(const Unit&, int) const { return true; }
    __device__ __forceinline__ int nvalid(const Unit&) const { return 256; }
    __device__ __forceinline__ unsigned a_off_idx(const Unit&, int, int) const { return 0u; }
    __device__ void init(int M, int N, int K_, const bf16_t* Bt_, int G_, int c_) { nM = M / BM; nN = N / BM; nwg = nM * nN; G = G_; c = c_; Bt = (const char*)Bt_; K = K_; }
    __device__ __forceinline__ bool next(int i, Unit& u) const {
        const long L = (long)i * G + c; if (L >= nwg) return false;
        int wgid = (int)L; { const int q = nwg / 8, r = nwg % 8, xcd = wgid % 8, off = wgid / 8; wgid = (xcd < r ? xcd * (q + 1) : r * (q + 1) + (xcd - r) * q) + off; }
        const int nig = 8 * nN, gid = wgid / nig, fm = gid * 8, gsz = (nM - fm) < 8 ? (nM - fm) : 8;
        u.pm = fm + ((wgid % nig) % gsz); u.pn = (wgid % nig) / gsz; u.e = 0; u.lt = 0; return true;
    }
    __device__ __forceinline__ const char* b_base(const Unit& u) const { return Bt + (size_t)u.pn * BM * K * 2; }
    __device__ __forceinline__ unsigned a_off(const Unit& u, int row) const { return (unsigned)(u.pm * BM + row) * (unsigned)(K * 2); }
};
__device__ __forceinline__ unsigned cvt_pk_bf16(float lo, float hi) { return pk2(lo, hi); }
struct EpiStoreBf16 { bf16_t* O; int ldc;
    __device__ __forceinline__ void operator()(const f32x4 (&acc)[2][2][4][2], const Unit& u, int wr, int wc, int fr, int fq, LAS const unsigned char*) const {
        const int row0 = u.pm * BM + wr * 64 + fr, col0 = u.pn * BM + wc * 32 + 8 * fq;
#pragma unroll
        for (int ai = 0; ai < 2; ++ai)
#pragma unroll
            for (int m = 0; m < 4; ++m) { bf16_t* rowp = O + (size_t)(row0 + ai * HALF + m * 16) * ldc + col0;
#pragma unroll
                for (int bj = 0; bj < 2; ++bj) { const f32x4 v0 = acc[ai][bj][m][0], v1 = acc[ai][bj][m][1];
                    u32x4 w; w.x = pk2(v0[0], v0[1]); w.y = pk2(v0[2], v0[3]); w.z = pk2(v1[0], v1[1]); w.w = pk2(v1[2], v1[3]);
                    *(u32x4*)(rowp + bj * HALF) = w; } }
    } };
}
constexpr int LDS_PG8 = 2048;
__device__ __forceinline__ void phase1(const Params& p) {
  const int tid_ = opaque_tid(); const int lane = tid_ & 63, gw = blockIdx.x * 8 + (tid_ >> 6), nw = gridDim.x * 8;
  const float* mod = (const float*)(p.ws + OFF_MOD);
  bf16_t* H1 = (bf16_t*)(p.ws + OFF_ACTA);
  float4 g[4];
#pragma unroll
  for (int i = 0; i < 4; ++i) g[i] = *(const float4*)(p.g_mix_pre + (lane + 64 * i) * 4);
  float4 vn[4];
  if (gw < T_TOK) {
#pragma unroll
    for (int i = 0; i < 4; ++i) vn[i] = ((const float4*)(p.x + (size_t)gw * 1024))[lane + 64 * i];
  }
#pragma unroll 1
  for (int row = gw; row < T_TOK; row += nw) {
    float4 v[4]; float ss = 0.f;
#pragma unroll
    for (int i = 0; i < 4; ++i) { v[i] = vn[i]; ss += v[i].x * v[i].x + v[i].y * v[i].y + v[i].z * v[i].z + v[i].w * v[i].w; }
    { const int rn = (row + nw < T_TOK) ? row + nw : row;
#pragma unroll
      for (int i = 0; i < 4; ++i) vn[i] = ((const float4*)(p.x + (size_t)rn * 1024))[lane + 64 * i]; }
    ss = wave_sum(ss);
    const float rs = rsqrtf(ss * (1.0f / 1024.f) + EPS);
    const int b = row >> 12;
    const float* sh = mod + b * 6144; const float* sc = sh + 1024;
#pragma unroll
    for (int i = 0; i < 4; ++i) {
      const int c = (lane + 64 * i) * 4;
      const float4 s1 = *(const float4*)(sc + c), h1 = *(const float4*)(sh + c);
      u32x2 w;
      w.x = pk2(v[i].x * rs * g[i].x * (1.f + s1.x) + h1.x, v[i].y * rs * g[i].y * (1.f + s1.y) + h1.y);
      w.y = pk2(v[i].z * rs * g[i].z * (1.f + s1.z) + h1.z, v[i].w * rs * g[i].w * (1.f + s1.w) + h1.w);
      *(u32x2*)(H1 + (size_t)row * 1024 + c) = w;
    }
  }
}

struct EpiProj { bf16_t* O; float* OL;
  __device__ __forceinline__ void operator()(const f32x4 (&acc)[2][2][4][2], const pg8::Unit& u, int wr, int wc, int fr, int fq, LAS const unsigned char*) const {
    const int row0 = u.pm * 256 + wr * 64 + fr;
    if (u.pn < 12) {
      const int col0 = u.pn * 256 + wc * 32 + 8 * fq;
#pragma unroll
      for (int ai = 0; ai < 2; ++ai)
#pragma unroll
        for (int m = 0; m < 4; ++m) { bf16_t* rowp = O + (size_t)(row0 + ai * 128 + m * 16) * PLD + col0;
#pragma unroll
          for (int bj = 0; bj < 2; ++bj) { const f32x4 v0 = acc[ai][bj][m][0], v1 = acc[ai][bj][m][1];
            u32x4 w; w.x = pk2(v0[0], v0[1]); w.y = pk2(v0[2], v0[3]); w.z = pk2(v1[0], v1[1]); w.w = pk2(v1[2], v1[3]);
            *(u32x4*)(rowp + bj * 128) = w; } }
    } else {
      const int col0 = wc * 32 + 8 * fq;
#pragma unroll
      for (int ai = 0; ai < 2; ++ai)
#pragma unroll
        for (int m = 0; m < 4; ++m) { float* rowp = OL + (size_t)(row0 + ai * 128 + m * 16) * 128 + col0;
          *(f32x4*)rowp = acc[ai][0][m][0]; *(f32x4*)(rowp + 4) = acc[ai][0][m][1]; }
    }
  } };
__device__ __forceinline__ void phase2(const Params& p) {
  pg8::DenseOrder S; S.init(T_TOK, NPROJ, 1024, (const bf16_t*)(p.ws + OFF_WIN), gridDim.x, blockIdx.x);
  EpiProj E{(bf16_t*)(p.ws + OFF_PROJ), (float*)(p.ws + OFF_PROJL)};
  pg8::gemm_phase(SMEM + LDS_PG8, (const bf16_t*)(p.ws + OFF_ACTA), 1024, S, E);
}

__device__ __forceinline__ void unpack8(const u32x4 v, float (&o)[8]) { o[0] = bflo(v.x); o[1] = bfhi(v.x); o[2] = bflo(v.y); o[3] = bfhi(v.y); o[4] = bflo(v.z); o[5] = bfhi(v.z); o[6] = bflo(v.w); o[7] = bfhi(v.w); }
__device__ __forceinline__ u32x4 packf8(const float (&o)[8]) { u32x4 w; w.x = pk2(o[0], o[1]); w.y = pk2(o[2], o[3]); w.z = pk2(o[4], o[5]); w.w = pk2(o[6], o[7]); return w; }
__device__ __forceinline__ void rope8(float (&own)[8], const float (&oth)[8], bool first, const float* cs) {
#pragma unroll
  for (int i = 0; i < 8; ++i) { const float c = cs[2 * i], s = cs[2 * i + 1]; own[i] = first ? (own[i] * c - oth[i] * s) : (own[i] * c + oth[i] * s); }
}
__device__ __forceinline__ void phase2b(const Params& p) {
  const bf16_t* PROJ = (const bf16_t*)(p.ws + OFF_PROJ); const float* PL = (const float*)(p.ws + OFF_PROJL);
  bf16_t* dst = (bf16_t*)(p.ws + OFF_MQKC); bf16_t* AKR = (bf16_t*)(p.ws + OFF_AK); bf16_t* IK = (bf16_t*)(p.ws + OFF_IK);
  const float* R128 = (const float*)(p.ws + OFF_ROPE); const float* R64 = R128 + 4096 * 32;
  const unsigned gtid = blockIdx.x * NTHR + opaque_tid(), gstride = gridDim.x * NTHR;
  for (unsigned id = gtid; id < (unsigned)(T_TOK / 8) * 128u; id += gstride) {
    const size_t tok0 = (size_t)(id >> 7) * 8; const int c0 = (int)(id & 127u) * 8; const int pos0 = (int)(tok0 & 4095);
    u32x4 raw[11];
#pragma unroll
    for (int r = 0; r < 11; ++r) raw[r] = (pos0 + r - 3 >= 0) ? *(const u32x4*)(PROJ + (tok0 + r - 3) * PLD + c0) : (u32x4){0u, 0u, 0u, 0u};
    float w[4][8], bias[8];
#pragma unroll
    for (int j = 0; j < 4; ++j) { const float4 w0 = *(const float4*)(p.conv_w + j * 1024 + c0), w1 = *(const float4*)(p.conv_w + j * 1024 + c0 + 4);
      w[j][0] = w0.x; w[j][1] = w0.y; w[j][2] = w0.z; w[j][3] = w0.w; w[j][4] = w1.x; w[j][5] = w1.y; w[j][6] = w1.z; w[j][7] = w1.w; }
    { const float4 b0 = *(const float4*)(p.conv_b + c0), b1 = *(const float4*)(p.conv_b + c0 + 4);
      bias[0] = b0.x; bias[1] = b0.y; bias[2] = b0.z; bias[3] = b0.w; bias[4] = b1.x; bias[5] = b1.y; bias[6] = b1.z; bias[7] = b1.w; }
    const float sc = (c0 >= 512) ? 0.08838834764831845f : 1.0f;
#pragma unroll
    for (int t = 0; t < 8; ++t) {
      float acc[8];
#pragma unroll
      for (int i = 0; i < 8; ++i) acc[i] = bias[i];
#pragma unroll
      for (int j = 0; j < 4; ++j) { float v[8]; unpack8(raw[t + j], v);
#pragma unroll
        for (int i = 0; i < 8; ++i) acc[i] += v[i] * w[j][i]; }
#pragma unroll
      for (int i = 0; i < 8; ++i) acc[i] = acc[i] * __builtin_amdgcn_rcpf(1.0f + __expf(-acc[i])) * sc;
      *(u32x4*)(dst + (tok0 + t) * 1024 + c0) = packf8(acc);
    }
  }
  for (unsigned id = gtid; id < (unsigned)T_TOK * 16u; id += gstride) {
    const size_t tok = id >> 4; const int c0 = (int)(id & 15u) * 8; const int pos = (int)(tok & 4095);
    float own[8]; unpack8(*(const u32x4*)(PROJ + tok * PLD + 2560 + c0), own);
    if (c0 < 32) { float oth[8]; unpack8(*(const u32x4*)(PROJ + tok * PLD + 2560 + (c0 ^ 16)), oth); rope8(own, oth, c0 < 16, R128 + (size_t)pos * 32 + (c0 & 15) * 2); }
    *(u32x4*)(AKR + tok * 128 + c0) = packf8(own);
  }
  {
    const int tid_ = opaque_tid(); const int lane = tid_ & 63, gwv = blockIdx.x * 8 + (tid_ >> 6), nwv = gridDim.x * 8;
    const int sub = lane >> 4, cl = lane & 15, c4 = cl * 4;
    const float4 gk4 = *(const float4*)(p.g_idx_k + c4), bk4 = *(const float4*)(p.b_idx_k + c4);
    float4 gb = make_float4(0.f, 0.f, 0.f, 0.f);
    if (cl == 0) gb = *(const float4*)p.b_igate; else if (cl == 1) gb = *(const float4*)p.b_fgate;
    for (int t0 = gwv * 4; t0 < T_TOK; t0 += nwv * 4) {
      const int tok = t0 + sub; const int pos = tok & 4095;
      const float* tr = PL + (size_t)tok * 128;
      const float4 v = *(const float4*)(tr + c4);
      float4 ex = make_float4(0.f, 0.f, 0.f, 0.f), ca = ex, cb = ex;
      if (cl < 3) ex = *(const float4*)(tr + 64 + c4);
      if (cl < 4) { const float* ct = R64 + (size_t)pos * 16 + (cl & 1) * 8; ca = *(const float4*)ct; cb = *(const float4*)(ct + 4); }
      const float mu = row_sum16((v.x + v.y) + (v.z + v.w)) * (1.f / 64.f);
      const float d0 = v.x - mu, d1 = v.y - mu, d2 = v.z - mu, d3 = v.w - mu;
      const float var = row_sum16((d0 * d0 + d1 * d1) + (d2 * d2 + d3 * d3)) * (1.f / 64.f);
      const float rs = rsqrtf(var + EPS);
      float y0 = d0 * rs * gk4.x + bk4.x, y1 = d1 * rs * gk4.y + bk4.y, y2 = d2 * rs * gk4.z + bk4.z, y3 = d3 * rs * gk4.w + bk4.w;
#define P3_QX(x_) __builtin_bit_cast(float, __builtin_amdgcn_update_dpp(0, __builtin_bit_cast(int, x_), 0x4E, 0xf, 0xf, false))
      const float o0 = P3_QX(y0), o1 = P3_QX(y1), o2 = P3_QX(y2), o3 = P3_QX(y3);
#undef P3_QX
      if (cl < 4) {
        if (cl < 2) { y0 = y0 * ca.x - o0 * ca.y; y1 = y1 * ca.z - o1 * ca.w; y2 = y2 * cb.x - o2 * cb.y; y3 = y3 * cb.z - o3 * cb.w; }
        else        { y0 = y0 * ca.x + o0 * ca.y; y1 = y1 * ca.z + o1 * ca.w; y2 = y2 * cb.x + o2 * cb.y; y3 = y3 * cb.z + o3 * cb.w; }
      }
      { u32x2 w; w.x = pk2(y0, y1); w.y = pk2(y2, y3); *(u32x2*)(IK + (size_t)tok * 64 + c4) = w; }
      if (cl < 2) *(float4*)((float*)(p.ws + OFF_GATES) + (size_t)tok * 8 + cl * 4) = make_float4(ex.x + gb.x, ex.y + gb.y, ex.z + gb.z, ex.w + gb.w);
      else if (cl == 2) *(float4*)((float*)(p.ws + OFF_IW) + (size_t)tok * 4) = make_float4(ex.x * 0.0625f, ex.y * 0.0625f, ex.z * 0.0625f, ex.w * 0.0625f);
    }
  }
  {
    const int tid_ = opaque_tid(); const int lane = tid_ & 63, gwv = blockIdx.x * 8 + (tid_ >> 6), nwv = gridDim.x * 8;
    float* GLb = (float*)(p.ws + OFF_GL); float* GLa = GLb + 64 * 4096; float* GLm = GLa + 64 * 4096; float* SEG = GLm + 64 * 4096;
    for (int item = gwv; item < 512; item += nwv) {
      const int bh = item >> 3, seg = item & 7, b = bh >> 2, h = bh & 3;
      const float bi = p.b_igate[h], bfg = p.b_fgate[h];
      float bl = 0.f, ml = -1e30f;
      for (int c = 0; c < 8; ++c) {
        const int ts = seg * 512 + c * 64 + lane; const size_t tok = (size_t)b * 4096 + ts;
        const float ig = PL[tok * 128 + 64 + h] + bi, fg = PL[tok * 128 + 68 + h] + bfg;
        const float lf = fminf(fg, 0.f) - log1pf(expf(-fabsf(fg)));
        const float cs = wave_incl_scan_addf(lf);
        const float bloc = bl + cs, aloc = ig - bloc;
        const float mx = wave_incl_scan_maxf(aloc);
        const float mloc = fmaxf(ml, mx);
        GLb[bh * 4096 + ts] = bloc; GLa[bh * 4096 + ts] = aloc; GLm[bh * 4096 + ts] = mloc;
        bl = __builtin_bit_cast(float, __builtin_amdgcn_readlane(__builtin_bit_cast(int, bloc), 63)); ml = __builtin_bit_cast(float, __builtin_amdgcn_readlane(__builtin_bit_cast(int, mloc), 63));
      }
      if (lane == 0) { SEG[(bh * 8 + seg) * 2] = bl; SEG[(bh * 8 + seg) * 2 + 1] = ml; }
    }
  }
}
namespace ml {
constexpr int QS = 0, KS = 17408, VS = 34816, VWS = 54272, PS = 73728, CB = 82944, SEGT = 122112, GA = 122624;
constexpr int QLD = 136, VLD = 152, TLD = 72;
}
__device__ __forceinline__ bf16x8 ml_tr(LAS const bf16_t* p0, int rowstride) {
  const v4i16_t a = __builtin_amdgcn_ds_read_tr16_b64_v4i16((LAS v4i16_t*)p0), b = __builtin_amdgcn_ds_read_tr16_b64_v4i16((LAS v4i16_t*)(p0 + 4 * rowstride));
  bf16x8 r; r[0] = a[0]; r[1] = a[1]; r[2] = a[2]; r[3] = a[3]; r[4] = b[0]; r[5] = b[1]; r[6] = b[2]; r[7] = b[3]; return r;
}
__device__ __forceinline__ void mlstm_item(const Params& p, int id) {
  using namespace ml;
  const int tid = opaque_tid(), lane = tid & 63, w = tid >> 6, fr = lane & 15, fq = lane >> 4;
  const int b = id >> 2, h = id & 3;
  const size_t tok0 = (size_t)b * 4096;
  LAS unsigned char* L = SMEM + LDS_MAIN;
  LAS bf16_t* Qs = (LAS bf16_t*)(L + QS); LAS bf16_t* Ks = (LAS bf16_t*)(L + KS); LAS bf16_t* Vs = (LAS bf16_t*)(L + VS); LAS bf16_t* VWs = (LAS bf16_t*)(L + VWS);
  LAS bf16_t* Ps = (LAS bf16_t*)(L + PS); LAS bf16_t* Cb = (LAS bf16_t*)(L + CB);
  LAS float* segt = (LAS float*)(L + SEGT); LAS float* gab = (LAS float*)(L + GA);
  const float* GLb = (const float*)(p.ws + OFF_GL) + (size_t)(b * 4 + h) * 4096; const float* GLa = GLb + 64 * 4096; const float* GLm = GLa + 64 * 4096; const float* SEG = (const float*)(p.ws + OFF_GL) + 3 * 64 * 4096 + (b * 4 + h) * 16;
  const bf16_t* MQKC = (const bf16_t*)(p.ws + OFF_MQKC); const bf16_t* MV = (const bf16_t*)(p.ws + OFF_PROJ) + 1024 + h * 128; const bf16_t* MO = (const bf16_t*)(p.ws + OFF_PROJ) + 1536 + h * 128;
  bf16_t* A2 = (bf16_t*)(p.ws + OFF_ACTA) + h * 128;

  f32x4 Cacc[2][9];
#pragma unroll
  for (int i = 0; i < 2; ++i)
#pragma unroll
    for (int j = 0; j < 9; ++j) Cacc[i][j] = (f32x4){0.f, 0.f, 0.f, 0.f};
  for (int i = tid; i < 144 * QLD; i += NTHR) Cb[i] = 0;
  for (int i = tid; i < 64 * VLD; i += NTHR) { const int col = i % VLD; Vs[i] = (col == 128) ? (bf16_t)0x3F80 : (bf16_t)0; VWs[i] = 0; }
  if (tid == 0) { float bo = 0.f, mp = -1e30f; for (int k = 0; k < 8; ++k) { segt[2 * k] = bo; segt[2 * k + 1] = mp; mp = fmaxf(mp, SEG[2 * k + 1] - bo); bo += SEG[2 * k]; } }
  u32x4 q0, q1, k0, k1, v0, v1; float ga0 = 0.f, ga1 = 0.f, gb = 0.f, gm = 0.f, gme = 0.f, gmp = 0.f;
  const int srow = tid >> 4, scc = tid & 15;
  const int gs = tid & 63;
  auto gload = [&](int c) {
    const size_t t0 = tok0 + (size_t)c * 64;
    q0 = *(const u32x4*)(MQKC + (t0 + srow) * 1024 + h * 128 + scc * 8); q1 = *(const u32x4*)(MQKC + (t0 + srow + 32) * 1024 + h * 128 + scc * 8);
    k0 = *(const u32x4*)(MQKC + (t0 + srow) * 1024 + 512 + h * 128 + scc * 8); k1 = *(const u32x4*)(MQKC + (t0 + srow + 32) * 1024 + 512 + h * 128 + scc * 8);
    v0 = *(const u32x4*)(MV + (t0 + srow) * PLD + scc * 8); v1 = *(const u32x4*)(MV + (t0 + srow + 32) * PLD + scc * 8);
    ga0 = GLa[c * 64 + srow]; ga1 = GLa[c * 64 + srow + 32];
    const int ts = c * 64 + gs; gb = GLb[ts]; gm = GLm[ts]; gme = GLm[c * 64 + 63]; gmp = GLm[(c > 0) ? (c * 64 - 1) : 0];
  };
  auto sstore = [&](int cs) {
    *(LAS u32x4*)(Qs + srow * QLD + scc * 8) = q0; *(LAS u32x4*)(Qs + (srow + 32) * QLD + scc * 8) = q1;
    *(LAS u32x4*)(Ks + srow * QLD + scc * 8) = k0; *(LAS u32x4*)(Ks + (srow + 32) * QLD + scc * 8) = k1;
    *(LAS u32x4*)(Vs + srow * VLD + scc * 8) = v0; *(LAS u32x4*)(Vs + (srow + 32) * VLD + scc * 8) = v1;
    const float bo = segt[2 * (cs >> 3)], mpv = segt[2 * (cs >> 3) + 1];
    const float Mend = fmaxf(mpv, gme - bo);
    const float w0 = __expf(ga0 - bo - Mend), w1 = __expf(ga1 - bo - Mend);
    { float f[8]; unpack8(v0, f);
#pragma unroll
      for (int i = 0; i < 8; ++i) f[i] *= w0;
      *(LAS u32x4*)(VWs + srow * VLD + scc * 8) = packf8(f);
      unpack8(v1, f);
#pragma unroll
      for (int i = 0; i < 8; ++i) f[i] *= w1;
      *(LAS u32x4*)(VWs + (srow + 32) * VLD + scc * 8) = packf8(f); }
    if (scc == 0) { VWs[srow * VLD + 128] = (bf16_t)f2bf(w0); VWs[(srow + 32) * VLD + 128] = (bf16_t)f2bf(w1); }
    if (tid < 64) {
      LAS float* ga = gab + (cs & 1) * 336;
      const float gav = (gs < 32) ? ga0 : ga1;
      (void)gav;
      const float a = GLa[cs * 64 + gs] - bo, Bs = bo + gb, Mt = fmaxf(mpv, gm - bo);
      float Mp = -1e30f;
      if (cs > 0) { const int sp = (cs * 64 - 1) >> 9; Mp = fmaxf(segt[2 * sp + 1], gmp - segt[2 * sp]); }
      ga[gs] = a; ga[64 + gs] = Mt; ga[128 + gs] = __expf(Mp - Mt); ga[192 + gs] = __expf(-(Bs + Mt));
      if (gs == 0) ga[320] = __expf(Mp - Mend);
    }
  };
  __syncthreads();
  gload(0); sstore(0);
  __syncthreads();
  const int tt = w >> 1, st0 = (w & 1) * 2;
  const int trq = fr >> 2, trp = fr & 3;
#pragma unroll 1
  for (int c = 0; c < 64; ++c) {
    if (c < 63) gload(c + 1);
    LAS const float* ga = gab + (c & 1) * 336;
    {
      f32x4 S[2];
#pragma unroll
      for (int i = 0; i < 2; ++i) S[i] = (f32x4){0.f, 0.f, 0.f, 0.f};
#pragma unroll
      for (int kk = 0; kk < 4; ++kk) {
        const bf16x8 bq = *(LAS bf16x8*)(Qs + (tt * 16 + fr) * QLD + kk * 32 + fq * 8);
#pragma unroll
        for (int i = 0; i < 2; ++i) if (st0 + i <= tt) {
          const bf16x8 ak = *(LAS bf16x8*)(Ks + ((st0 + i) * 16 + fr) * QLD + kk * 32 + fq * 8);
          S[i] = __builtin_amdgcn_mfma_f32_16x16x32_bf16(ak, bq, S[i], 0, 0, 0);
        }
      }
      const int t = tt * 16 + fr; const float Mt = ga[64 + t];
#pragma unroll
      for (int i = 0; i < 2; ++i) {
        const int s0 = (st0 + i) * 16 + fq * 4;
        const f32x4 as = *(LAS const f32x4*)(ga + s0);
        float pv[4];
#pragma unroll
        for (int j = 0; j < 4; ++j) pv[j] = (s0 + j <= t) ? S[i][j] * __expf(as[j] - Mt) : 0.f;
        u32x2 pw; pw.x = pk2(pv[0], pv[1]); pw.y = pk2(pv[2], pv[3]);
        *(LAS u32x2*)(Ps + t * TLD + s0) = pw;
      }
    }
    __syncthreads();
    if (w < 4) {
      f32x4 N1[9];
#pragma unroll
      for (int j = 0; j < 9; ++j) N1[j] = (f32x4){0.f, 0.f, 0.f, 0.f};
#pragma unroll
      for (int kk = 0; kk < 4; ++kk) {
        const bf16x8 bq = *(LAS bf16x8*)(Qs + (w * 16 + fr) * QLD + kk * 32 + fq * 8);
#pragma unroll
        for (int j = 0; j < 9; ++j) { const bf16x8 ac = *(LAS bf16x8*)(Cb + (j * 16 + fr) * QLD + kk * 32 + fq * 8); N1[j] = __builtin_amdgcn_mfma_f32_16x16x32_bf16(ac, bq, N1[j], 0, 0, 0); }
      }
      const int t = w * 16 + fr; const float inter = ga[128 + t], low = ga[192 + t];
#pragma unroll
      for (int j = 0; j < 9; ++j) N1[j] = N1[j] * inter;
#pragma unroll
      for (int kk = 0; kk < 2; ++kk) {
        const bf16x8 bp = *(LAS bf16x8*)(Ps + (w * 16 + fr) * TLD + kk * 32 + fq * 8);
        LAS const bf16_t* vb = Vs + (kk * 32 + fq * 8 + trq) * VLD + trp * 4;
#pragma unroll
        for (int j = 0; j < 9; ++j) { const bf16x8 av = ml_tr(vb + j * 16, VLD); N1[j] = __builtin_amdgcn_mfma_f32_16x16x32_bf16(av, bp, N1[j], 0, 0, 0); }
      }
      const float dsrc = N1[8][0];
      const float dn = fmaxf(fabsf(__shfl(dsrc, fr)), low);
      const float inv = __builtin_amdgcn_rcpf(dn);
      float ss = 0.f;
#pragma unroll
      for (int j = 0; j < 8; ++j)
#pragma unroll
        for (int r = 0; r < 4; ++r) { const float hv = N1[j][r] * inv; N1[j][r] = hv; ss += hv * hv; }
      ss += __shfl_xor(ss, 16); ss += __shfl_xor(ss, 32);
      const float rs = rsqrtf(ss * (1.f / 128.f) + EPS);
      bf16_t* op = A2 + (tok0 + (size_t)c * 64 + t) * 1024 + fq * 4;
#pragma unroll
      for (int j = 0; j < 8; ++j) {
        const float4 gh = *(const float4*)(p.g_mlstm_head + h * 128 + j * 16 + fq * 4);
        const u32x2 mo = *(const u32x2*)(MO + (tok0 + (size_t)c * 64 + t) * PLD + j * 16 + fq * 4);
        const float o0 = N1[j][0] * rs * gh.x * sigmoidf_(bflo(mo.x)), o1 = N1[j][1] * rs * gh.y * sigmoidf_(bfhi(mo.x));
        const float o2 = N1[j][2] * rs * gh.z * sigmoidf_(bflo(mo.y)), o3 = N1[j][3] * rs * gh.w * sigmoidf_(bfhi(mo.y));
        u32x2 hw; hw.x = pk2(o0, o1); hw.y = pk2(o2, o3);
        *(u32x2*)(op + j * 16) = hw;
      }
    } else {
      const float dcy = ga[320];
#pragma unroll
      for (int i = 0; i < 2; ++i)
#pragma unroll
        for (int j = 0; j < 9; ++j) Cacc[i][j] = Cacc[i][j] * dcy;
#pragma unroll
      for (int kk = 0; kk < 2; ++kk) {
        LAS const bf16_t* kb0 = Ks + (kk * 32 + fq * 8 + trq) * QLD + trp * 4;
        LAS const bf16_t* vwb = VWs + (kk * 32 + fq * 8 + trq) * VLD + trp * 4;
        bf16x8 akt[2];
#pragma unroll
        for (int i = 0; i < 2; ++i) akt[i] = ml_tr(kb0 + ((w - 4) * 2 + i) * 16, QLD);
#pragma unroll
        for (int j = 0; j < 9; ++j) {
          const bf16x8 bv = ml_tr(vwb + j * 16, VLD);
#pragma unroll
          for (int i = 0; i < 2; ++i) Cacc[i][j] = __builtin_amdgcn_mfma_f32_16x16x32_bf16(akt[i], bv, Cacc[i][j], 0, 0, 0);
        }
      }
    }
    __syncthreads();
    if (w >= 4) {
#pragma unroll
      for (int i = 0; i < 2; ++i)
#pragma unroll
        for (int j = 0; j < 9; ++j) { u32x2 cw; cw.x = pk2(Cacc[i][j][0], Cacc[i][j][1]); cw.y = pk2(Cacc[i][j][2], Cacc[i][j][3]);
          *(LAS u32x2*)(Cb + (j * 16 + fr) * QLD + ((w - 4) * 2 + i) * 16 + fq * 4) = cw; }
    }
    if (c < 63) sstore(c + 1);
    __syncthreads();
  }
}
namespace ds {
constexpr int KEYS = 0, HIST = 131840;
constexpr int KROW = 4112, HROW = 260;
constexpr int KT = 0, VT = 34816, PW = 71680, MSK = 108544;
constexpr int KLD = 136, VLD = 72;
}
__device__ __forceinline__ unsigned score_key16(float s4096) {
  const float t = __builtin_amdgcn_fmed3f(s4096, -32767.0f, 32767.0f);
  return (unsigned)(32768 + (int)floorf(t));
}
__device__ __forceinline__ void hist_find(LAS const unsigned* hist, int lane, unsigned target, unsigned& bin, unsigned& above) {
  const u32x4 h4 = *(LAS const u32x4*)(hist + 4 * lane);
  const unsigned lsum = h4.x + h4.y + h4.z + h4.w;
  const unsigned inc_ = wave_incl_scan(lsum);
  const unsigned suf = (unsigned)__builtin_amdgcn_readlane((int)inc_, 63) - inc_ + lsum;
  unsigned cum = suf - lsum; bool found = false; unsigned fb = 0, fa = 0;
  { const unsigned hv = h4.w; if (!found && cum < target && cum + hv >= target) { found = true; fb = 4 * lane + 3; fa = cum; } cum += hv; }
  { const unsigned hv = h4.z; if (!found && cum < target && cum + hv >= target) { found = true; fb = 4 * lane + 2; fa = cum; } cum += hv; }
  { const unsigned hv = h4.y; if (!found && cum < target && cum + hv >= target) { found = true; fb = 4 * lane + 1; fa = cum; } cum += hv; }
  { const unsigned hv = h4.x; if (!found && cum < target && cum + hv >= target) { found = true; fb = 4 * lane + 0; fa = cum; } cum += hv; }
  const unsigned long long m = __ballot(found);
  const int src = m ? (__ffsll((long long)m) - 1) : 0;
  bin = (unsigned)__builtin_amdgcn_readlane((int)fb, src); above = (unsigned)__builtin_amdgcn_readlane((int)fa, src);
}
typedef long long i64; typedef long long i64x2 __attribute__((ext_vector_type(2)));
__device__ __forceinline__ bf16x8 tr_pair(LAS const bf16_t* p0, LAS const bf16_t* p1) {
  const v4i16_t a = __builtin_amdgcn_ds_read_tr16_b64_v4i16((LAS v4i16_t*)p0), b = __builtin_amdgcn_ds_read_tr16_b64_v4i16((LAS v4i16_t*)p1);
  bf16x8 r; r[0] = a[0]; r[1] = a[1]; r[2] = a[2]; r[3] = a[3]; r[4] = b[0]; r[5] = b[1]; r[6] = b[2]; r[7] = b[3]; return r;
}
__device__ __forceinline__ void dsa_item(const Params& p, int b, int qc) {
  using namespace ds;
  const int tid = opaque_tid(), lane = tid & 63, w = tid >> 6, fr = lane & 15, fq = lane >> 4;
  LAS unsigned char* L = SMEM + LDS_MAIN;
  const size_t kb = (size_t)b * 4096;
  const size_t q0 = kb + (size_t)qc * 64;
  const int n = (qc + 1) * 64, ntile = qc + 1;
  unsigned long long* BITM = (unsigned long long*)(p.ws + OFF_BITM);
  unsigned char* BITB = (unsigned char*)(p.ws + OFF_BITM);
  const bf16_t* IQ = (const bf16_t*)(p.ws + OFF_PROJ) + 2816; const float* R128 = (const float*)(p.ws + OFF_ROPE); const float* R64 = R128 + 4096 * 32;
  const bf16_t* IK = (const bf16_t*)(p.ws + OFF_IK); const float* IW = (const float*)(p.ws + OFF_IW);
  for (int rep_s = 0; rep_s < ((PROBE_DBL == 33) ? 2 : 1); ++rep_s)
  if (n <= 256) {
    for (int i = tid; i < 64 * ntile; i += NTHR) { const int q = i / ntile, kt = i - q * ntile; BITM[(q0 + q) * 64 + kt] = ~0ull; }
  } else {
    LAS unsigned short* keys = (LAS unsigned short*)(L + KEYS);
    LAS unsigned* histq = (LAS unsigned*)(L + HIST);
    const int nk16 = n >> 4, nblk = (n + 511) >> 9;
    for (int i = tid; i < 16 * HROW / 4; i += NTHR) ((LAS u32x4*)(L + HIST))[i] = (u32x4){0u, 0u, 0u, 0u};
    __syncthreads();
#pragma unroll 1
    for (int g = 0; g < 4; ++g) {
      const size_t qg = q0 + g * 16;
      bf16x8 af[4][2]; f32x4 iw[4];
#pragma unroll
      for (int hh = 0; hh < 4; ++hh)
        {
          const bf16_t* src = IQ + (qg + fr) * PLD + hh * 64 + fq * 16;
          u32x4 raw0 = *(const u32x4*)src, raw1 = *(const u32x4*)(src + 8);
          if (fq == 0) {
            float x0[8], x1[8], y0[8], y1[8]; unpack8(raw0, x0); unpack8(raw1, x1);
            const float* cs = R64 + (size_t)((qg + fr) & 4095) * 16;
#pragma unroll
            for (int i = 0; i < 8; ++i) { const float c = cs[2 * i], sn = cs[2 * i + 1]; y0[i] = x0[i] * c - x1[i] * sn; y1[i] = x1[i] * c + x0[i] * sn; }
            raw0 = packf8(y0); raw1 = packf8(y1);
          }
          af[hh][0] = __builtin_bit_cast(bf16x8, raw0); af[hh][1] = __builtin_bit_cast(bf16x8, raw1);
        }
      iw[0] = *(const f32x4*)(IW + (qg + fr) * 4) * 4096.0f;

      {
        const int nbat = n >> 6;
        bf16x8 bc[4][2], bn[4][2];
        {
          const int bt = (w < nbat) ? w : 0;
#pragma unroll
          for (int u = 0; u < 4; ++u) { const bf16_t* kp = IK + (kb + (size_t)(bt * 4 + u) * 16 + fr) * 64 + fq * 16; bc[u][0] = *(const bf16x8*)kp; bc[u][1] = *(const bf16x8*)(kp + 8); }
        }
#define DS_LOADB(R, bt_) do { const int b_ = ((bt_) < nbat) ? (bt_) : ((w < nbat) ? w : 0); _Pragma("unroll") for (int u = 0; u < 4; ++u) { \
          const bf16_t* kp = IK + (kb + (size_t)(b_ * 4 + u) * 16 + fr) * 64 + fq * 16; R[u][0] = *(const bf16x8*)kp; R[u][1] = *(const bf16x8*)(kp + 8); } } while (0)
#define DS_SCORE(R, bt_) do { _Pragma("unroll") for (int u = 0; u < 4; ++u) { \
            float sc[4] = {32768.0f, 32768.0f, 32768.0f, 32768.0f};        \
            _Pragma("unroll") for (int hh = 0; hh < 4; ++hh) { \
              f32x4 a = (f32x4){0.f, 0.f, 0.f, 0.f}; \
              a = __builtin_amdgcn_mfma_f32_16x16x32_bf16(R[u][0], af[hh][0], a, 0, 0, 0);        \
              a = __builtin_amdgcn_mfma_f32_16x16x32_bf16(R[u][1], af[hh][1], a, 0, 0, 0); \
              _Pragma("unroll") for (int j = 0; j < 4; ++j) sc[j] = __builtin_fmaf(iw[0][hh], __builtin_amdgcn_fmed3f(a[j], 0.f, 3.0e38f), sc[j]);        \
            } \
            unsigned k16[4]; \
            _Pragma("unroll") for (int j = 0; j < 4; ++j) { k16[j] = (unsigned)(int)__builtin_amdgcn_fmed3f(sc[j], 1.0f, 65535.0f); \
              __hip_atomic_fetch_add(histq + fr * HROW + __builtin_amdgcn_ubfe(k16[j], 8, 8), 1u, __ATOMIC_RELAXED, __HIP_MEMORY_SCOPE_WORKGROUP); }        \
            { u32x2 kw; kw.x = k16[0] | (k16[1] << 16); kw.y = k16[2] | (k16[3] << 16); \
              *(LAS u32x2*)(keys + fr * KROW + ((bt_) * 4 + u) * 16 + fq * 4) = kw; }                        \
          } } while (0)
        for (int bt = w; bt < nbat; bt += 16) {
          DS_LOADB(bn, bt + 8); DS_SCORE(bc, bt);
          if (bt + 8 >= nbat) break;
          DS_LOADB(bc, bt + 16); DS_SCORE(bn, bt + 8);
        }
#undef DS_LOADB
#undef DS_SCORE
      }
      __syncthreads();
      {
        LAS const unsigned short* kq0 = keys + (w * 2) * KROW; LAS const unsigned short* kq1 = kq0 + KROW;
        LAS unsigned* h0 = histq + (w * 2) * HROW; LAS unsigned* h1 = h0 + HROW;
        LAS unsigned* dmy = (LAS unsigned*)(L + HIST) + 16 * HROW + w * 64 + lane;
        unsigned b1a, ab1a, b1b, ab1b;
        hist_find(h0, lane, 256u, b1a, ab1a); hist_find(h1, lane, 256u, b1b, ab1b);
        *(LAS u32x4*)(h0 + 4 * lane) = (u32x4){0u, 0u, 0u, 0u}; *(LAS u32x4*)(h1 + 4 * lane) = (u32x4){0u, 0u, 0u, 0u};
        for (int blk = 0; blk < nblk; ++blk) {
          const int k0i = blk * 512 + lane * 8;
          if (k0i < n) {
            const u32x4 ka = *(LAS const u32x4*)(kq0 + k0i), kb4 = *(LAS const u32x4*)(kq1 + k0i);
#define DS_P2(word, hh, bb) { const unsigned k_lo = (word) & 0xffffu, k_hi = (word) >> 16; \
              __hip_atomic_fetch_add(((k_lo >> 8) == (bb)) ? ((hh) + (k_lo & 255u)) : dmy, 1u, __ATOMIC_RELAXED, __HIP_MEMORY_SCOPE_WORKGROUP); \
              __hip_atomic_fetch_add(((k_hi >> 8) == (bb)) ? ((hh) + (k_hi & 255u)) : dmy, 1u, __ATOMIC_RELAXED, __HIP_MEMORY_SCOPE_WORKGROUP); }
            DS_P2(ka.x, h0, b1a) DS_P2(kb4.x, h1, b1b) DS_P2(ka.y, h0, b1a) DS_P2(kb4.y, h1, b1b) DS_P2(ka.z, h0, b1a) DS_P2(kb4.z, h1, b1b) DS_P2(ka.w, h0, b1a) DS_P2(kb4.w, h1, b1b)
#undef DS_P2
          }
        }
        asm volatile("s_waitcnt lgkmcnt(0)" ::: "memory");
        unsigned b2a, ab2a, b2b, ab2b;
        hist_find(h0, lane, 256u - ab1a, b2a, ab2a); hist_find(h1, lane, 256u - ab1b, b2b, ab2b);
        *(LAS u32x4*)(h0 + 4 * lane) = (u32x4){0u, 0u, 0u, 0u}; *(LAS u32x4*)(h1 + 4 * lane) = (u32x4){0u, 0u, 0u, 0u};
        {
          const unsigned tau0 = (b1a << 8) | b2a, rt0 = 256u - ab1a - ab2a, tau1 = (b1b << 8) | b2b, rt1 = 256u - ab1b - ab2b;
          unsigned tb0 = 0, tb1 = 0;
          for (int blk = 0; blk < nblk; ++blk) {
            const int k0i = blk * 512 + lane * 8;
            u32x4 kv0 = (u32x4){0u, 0u, 0u, 0u}, kv1 = (u32x4){0u, 0u, 0u, 0u};
            if (k0i < n) { kv0 = *(LAS const u32x4*)(kq0 + k0i); kv1 = *(LAS const u32x4*)(kq1 + k0i); }
#define DS_P3(kv, tau, rties, tbase, mbyte) { \
              unsigned kk[8] = {kv.x & 0xffffu, kv.x >> 16, kv.y & 0xffffu, kv.y >> 16, kv.z & 0xffffu, kv.z >> 16, kv.w & 0xffffu, kv.w >> 16}; \
              unsigned ne = 0; \
              _Pragma("unroll") for (int e = 0; e < 8; ++e) ne += (kk[e] == (tau)) ? 1u : 0u; \
              if (k0i >= n) ne = 0; \
              if (__ballot(ne != 0u) == 0ull) { \
                _Pragma("unroll") for (int e = 0; e < 8; ++e) mbyte |= (kk[e] > (tau)) ? (1u << e) : 0u; \
              } else { \
                const unsigned inc = wave_incl_scan(ne); \
                unsigned rank = (tbase) + inc - ne; \
                _Pragma("unroll") for (int e = 0; e < 8; ++e) { const bool eq = kk[e] == (tau); const bool sel = (kk[e] > (tau)) || (eq && rank < (rties)); mbyte |= sel ? (1u << e) : 0u; rank += eq ? 1u : 0u; } \
                (tbase) += (unsigned)__builtin_amdgcn_readlane((int)inc, 63); \
              } }
            unsigned mb0 = 0, mb1 = 0;
            DS_P3(kv0, tau0, rt0, tb0, mb0)
            DS_P3(kv1, tau1, rt1, tb1, mb1)
#undef DS_P3
            if (k0i < n) { BITB[(qg + w * 2) * 512 + blk * 64 + lane] = (unsigned char)mb0; BITB[(qg + w * 2 + 1) * 512 + blk * 64 + lane] = (unsigned char)mb1; }
          }
        }
      }
      __syncthreads();
    }
  }
  asm volatile("s_waitcnt vmcnt(0)" ::: "memory");
  __threadfence_block();
  __syncthreads();
  const bf16_t* AQ = (const bf16_t*)(p.ws + OFF_PROJ) + 2048; const bf16_t* AK = (const bf16_t*)(p.ws + OFF_AK); const bf16_t* AV = (const bf16_t*)(p.ws + OFF_PROJ) + 2688;
  bf16_t* A2 = (bf16_t*)(p.ws + OFF_ACTA);
  const float qscale = 0.08838834764831845f * 1.4426950408889634f;
  constexpr int RS = 36864;
  const int wv = __builtin_amdgcn_readfirstlane(w);
  const int prow0 = wv * 4 + (lane >> 4), prow1 = 32 + prow0;
  const int pch0 = (lane & 15) ^ (prow0 & 15), pch1 = (lane & 15) ^ (prow1 & 15);
  const unsigned koff0 = (unsigned)(prow0 * 128 + pch0 * 8) * 2u, koff1 = (unsigned)(prow1 * 128 + pch1 * 8) * 2u;
  const int vch0 = (lane & 15) ^ ((2 * prow0) & 15), vch1 = (lane & 15) ^ ((2 * prow1) & 15);
  const unsigned voff0 = (unsigned)(prow0 * PLD + vch0 * 8) * 2u, voff1 = (unsigned)(prow1 * PLD + vch1 * 8) * 2u;
  const unsigned moff = (unsigned)(((tid & 127) >> 1) * 512 + (tid & 1) * 4);
#define DS_GLDS(gp, ldsoff, sz) __builtin_amdgcn_global_load_lds((const unsigned*)(gp), (LAS unsigned*)(L + (ldsoff)), sz, 0, 0)
#define DS_ISSUE(kt_, stg_) do { const size_t t0_ = kb + (size_t)(kt_) * 64; const int so_ = (stg_) * RS; \
    DS_GLDS((const char*)(AK + t0_ * 128) + koff0, so_ + wv * 1024, 16); DS_GLDS((const char*)(AK + t0_ * 128) + koff1, so_ + 8192 + wv * 1024, 16); \
    DS_GLDS((const char*)(AV + t0_ * PLD) + voff0, so_ + 16384 + wv * 1024, 16); DS_GLDS((const char*)(AV + t0_ * PLD) + voff1, so_ + 16384 + 8192 + wv * 1024, 16); \
    DS_GLDS((const char*)(BITM + q0 * 64 + (kt_)) + moff, so_ + 32768 + wv * 256, 4); } while (0)
#pragma unroll 1
  for (int hp = 0; hp < ((PROBE_DBL == 34) ? 2 : 1); ++hp) {
    const int hd0 = (w >> 2) * 2, qh = (w & 3) * 16;
    bf16x8 qf[2][4];
#pragma unroll
    for (int hx = 0; hx < 2; ++hx)
#pragma unroll
      for (int kk = 0; kk < 4; ++kk) {
        const bf16_t* src = AQ + (q0 + qh + fr) * PLD + (hd0 + hx) * 128 + kk * 32 + fq * 8;
        float own[8]; unpack8(*(const u32x4*)src, own);
        if (kk == 0) { float oth[8]; unpack8(*(const u32x4*)(AQ + (q0 + qh + fr) * PLD + (hd0 + hx) * 128 + (fq ^ 2) * 8), oth);
          rope8(own, oth, fq < 2, R128 + (size_t)((q0 + qh + fr) & 4095) * 32 + (fq & 1) * 16); }
#pragma unroll
        for (int i = 0; i < 8; ++i) own[i] *= qscale;
        qf[hx][kk] = __builtin_bit_cast(bf16x8, packf8(own));
      }
    f32x4 O[2][8];
#pragma unroll
    for (int hx = 0; hx < 2; ++hx)
#pragma unroll
      for (int di = 0; di < 8; ++di) O[hx][di] = (f32x4){0.f, 0.f, 0.f, 0.f};
    float mrun[2] = {0.f, 0.f};
    f32x4 Lacc[2] = {(f32x4){0.f, 0.f, 0.f, 0.f}, (f32x4){0.f, 0.f, 0.f, 0.f}};
    const bf16x8 ones8 = __builtin_bit_cast(bf16x8, (u32x4){0x3F803F80u, 0x3F803F80u, 0x3F803F80u, 0x3F803F80u});
    const unsigned r15 = (unsigned)(fq * 4 + (fr >> 2));
    const unsigned vrb = r15 * 256u + (unsigned)(fr & 1) * 8u, vcx = (unsigned)((fr & 3) >> 1);
    const unsigned vky = (2u * r15) & 15u;
    const unsigned va0 = vrb + (((0u + vcx) ^ vky) << 4), va1 = vrb + (((2u + vcx) ^ vky) << 4), va2 = vrb + (((4u + vcx) ^ vky) << 4), va3 = vrb + (((6u + vcx) ^ vky) << 4);
    const unsigned va4 = vrb + (((8u + vcx) ^ vky) << 4), va5 = vrb + (((10u + vcx) ^ vky) << 4), va6 = vrb + (((12u + vcx) ^ vky) << 4), va7 = vrb + (((14u + vcx) ^ vky) << 4);
    const unsigned kc0 = (unsigned)(fr * 256 + (((0 * 4 + fq) ^ fr) << 4)), kc1 = (unsigned)(fr * 256 + (((1 * 4 + fq) ^ fr) << 4)), kc2 = (unsigned)(fr * 256 + (((2 * 4 + fq) ^ fr) << 4)), kc3 = (unsigned)(fr * 256 + (((3 * 4 + fq) ^ fr) << 4));
    asm volatile("s_waitcnt vmcnt(0)" ::: "memory");
    DS_ISSUE(0, 0);
    DS_ISSUE((ntile > 1) ? 1 : 0, 1);
    int stg = 0, stg2 = 2;
#pragma unroll 1
    for (int kt = 0; kt < ntile; ++kt) {
      asm volatile("s_waitcnt vmcnt(5)" ::: "memory");
      asm volatile("s_waitcnt lgkmcnt(0)" ::: "memory");
      __builtin_amdgcn_s_barrier();
      { const int ktn = (kt + 2 < ntile) ? kt + 2 : ntile - 1; DS_ISSUE(ktn, stg2); }
      LAS const unsigned char* Kt = L + stg * RS;
      f32x4 S[2][4];
#pragma unroll
      for (int hx = 0; hx < 2; ++hx)
#pragma unroll
        for (int ni = 0; ni < 4; ++ni) { const float nb = -mrun[hx]; S[hx][ni] = (f32x4){nb, nb, nb, nb}; }
      {
        const unsigned kst = (unsigned)(LDS_MAIN + stg * RS);
        u32x4 ka0, ka1, ka2, ka3, kb0, kb1, kb2, kb3;
#define DS_KRI(kc_, r0, r1, r2, r3) asm volatile("ds_read_b128 %0, %4\n\tds_read_b128 %1, %4 offset:4096\n\tds_read_b128 %2, %4 offset:8192\n\tds_read_b128 %3, %4 offset:12288" \
          : "=&v"(r0), "=&v"(r1), "=&v"(r2), "=&v"(r3) : "v"((kc_) + kst) : "memory")
#define DS_KRW(n_, r0, r1, r2, r3) asm volatile("s_waitcnt lgkmcnt(" #n_ ")" : "+v"(r0), "+v"(r1), "+v"(r2), "+v"(r3) :: "memory")
#define DS_QK(kk_, r0, r1, r2, r3) do { \
          S[0][0] = __builtin_amdgcn_mfma_f32_16x16x32_bf16(__builtin_bit_cast(bf16x8, r0), qf[0][kk_], S[0][0], 0, 0, 0); S[1][0] = __builtin_amdgcn_mfma_f32_16x16x32_bf16(__builtin_bit_cast(bf16x8, r0), qf[1][kk_], S[1][0], 0, 0, 0); \
          S[0][1] = __builtin_amdgcn_mfma_f32_16x16x32_bf16(__builtin_bit_cast(bf16x8, r1), qf[0][kk_], S[0][1], 0, 0, 0); S[1][1] = __builtin_amdgcn_mfma_f32_16x16x32_bf16(__builtin_bit_cast(bf16x8, r1), qf[1][kk_], S[1][1], 0, 0, 0); \
          S[0][2] = __builtin_amdgcn_mfma_f32_16x16x32_bf16(__builtin_bit_cast(bf16x8, r2), qf[0][kk_], S[0][2], 0, 0, 0); S[1][2] = __builtin_amdgcn_mfma_f32_16x16x32_bf16(__builtin_bit_cast(bf16x8, r2), qf[1][kk_], S[1][2], 0, 0, 0); \
          S[0][3] = __builtin_amdgcn_mfma_f32_16x16x32_bf16(__builtin_bit_cast(bf16x8, r3), qf[0][kk_], S[0][3], 0, 0, 0); S[1][3] = __builtin_amdgcn_mfma_f32_16x16x32_bf16(__builtin_bit_cast(bf16x8, r3), qf[1][kk_], S[1][3], 0, 0, 0); } while (0)
        __builtin_amdgcn_sched_barrier(0);
        DS_KRI(kc0, ka0, ka1, ka2, ka3); DS_KRI(kc1, kb0, kb1, kb2, kb3);
        DS_KRW(4, ka0, ka1, ka2, ka3); __builtin_amdgcn_sched_barrier(0);
        DS_QK(0, ka0, ka1, ka2, ka3); __builtin_amdgcn_sched_barrier(0);
        DS_KRI(kc2, ka0, ka1, ka2, ka3);
        DS_KRW(4, kb0, kb1, kb2, kb3); __builtin_amdgcn_sched_barrier(0);
        DS_QK(1, kb0, kb1, kb2, kb3); __builtin_amdgcn_sched_barrier(0);
        DS_KRI(kc3, kb0, kb1, kb2, kb3);
        DS_KRW(4, ka0, ka1, ka2, ka3); __builtin_amdgcn_sched_barrier(0);
        DS_QK(2, ka0, ka1, ka2, ka3); __builtin_amdgcn_sched_barrier(0);
        DS_KRW(0, kb0, kb1, kb2, kb3); __builtin_amdgcn_sched_barrier(0);
        DS_QK(3, kb0, kb1, kb2, kb3); __builtin_amdgcn_sched_barrier(0);
#undef DS_KRI
#undef DS_KRW
#undef DS_QK
      }
#define DS_TRI(o0, o1, aa, ab, ac, ad, r0, r1, r2, r3, r4, r5, r6, r7) asm volatile( \
        "ds_read_b64_tr_b16 %0, %8 offset:" #o0 "\n\tds_read_b64_tr_b16 %1, %8 offset:" #o1 "\n\tds_read_b64_tr_b16 %2, %9 offset:" #o0 "\n\tds_read_b64_tr_b16 %3, %9 offset:" #o1 "\n\t" \
        "ds_read_b64_tr_b16 %4, %10 offset:" #o0 "\n\tds_read_b64_tr_b16 %5, %10 offset:" #o1 "\n\tds_read_b64_tr_b16 %6, %11 offset:" #o0 "\n\tds_read_b64_tr_b16 %7, %11 offset:" #o1 \
        : "=&v"(r0), "=&v"(r1), "=&v"(r2), "=&v"(r3), "=&v"(r4), "=&v"(r5), "=&v"(r6), "=&v"(r7) : "v"((aa) + sb), "v"((ab) + sb), "v"((ac) + sb), "v"((ad) + sb) : "memory")
#define DS_TRW(r0, r1, r2, r3, r4, r5, r6, r7) asm volatile("s_waitcnt lgkmcnt(0)" : "+v"(r0), "+v"(r1), "+v"(r2), "+v"(r3), "+v"(r4), "+v"(r5), "+v"(r6), "+v"(r7) :: "memory")
      const unsigned sb = (unsigned)(LDS_MAIN + stg * RS + 16384);
      LAS const unsigned* wp = (LAS const unsigned*)(Kt + 32768 + (qh + fr) * 8);
      const unsigned mlo = wp[0] >> (fq * 4), mhi = wp[1] >> (fq * 4);
      unsigned pm[4][2];
#pragma unroll
      for (int ni = 0; ni < 4; ++ni)
#pragma unroll
        for (int jp = 0; jp < 2; ++jp) {
          const unsigned m = (ni < 2) ? mlo : mhi; const int sh = 16 * (ni & 1) + 2 * jp;
          const unsigned lo = (unsigned)__builtin_amdgcn_sbfe((int)m, sh, 1), hi = (unsigned)__builtin_amdgcn_sbfe((int)m, sh + 1, 1);
          pm[ni][jp] = __builtin_amdgcn_perm(hi, lo, 0x05040100u);
        }
      i64 t0, t1, t2, t3, t4, t5, t6, t7, u0, u1, u2, u3, u4, u5, u6, u7;
      __builtin_amdgcn_sched_barrier(0);
      DS_TRI(0, 4096, va0, va1, va2, va3, t0, t1, t2, t3, t4, t5, t6, t7);
      __builtin_amdgcn_sched_barrier(0);
      unsigned pk[2][4][2];
#pragma unroll
      for (int hx = 0; hx < 2; ++hx) {
        float mx = fmax_nc(fmax_nc(S[hx][0][0], S[hx][0][1]), fmax_nc(S[hx][0][2], S[hx][0][3]));
#pragma unroll
        for (int ni = 1; ni < 4; ++ni) mx = fmax_nc(mx, fmax_nc(fmax_nc(S[hx][ni][0], S[hx][ni][1]), fmax_nc(S[hx][ni][2], S[hx][ni][3])));
        mx = rowmax4(mx);
        const bool up = (kt == 0) || (mx > 8.0f);
        if (__ballot(up) != 0ull) {
          const float d = up ? mx : 0.f;
          const float alpha = __builtin_amdgcn_exp2f(-d);
          mrun[hx] += d;
#pragma unroll
          for (int ni = 0; ni < 4; ++ni)
#pragma unroll
            for (int j = 0; j < 4; ++j) S[hx][ni][j] -= d;
#pragma unroll
          for (int di = 0; di < 8; ++di) O[hx][di] = O[hx][di] * alpha;
          Lacc[hx] = Lacc[hx] * alpha;
        }
#pragma unroll
        for (int ni = 0; ni < 4; ++ni)
#pragma unroll
          for (int jp = 0; jp < 2; ++jp)
            pk[hx][ni][jp] = pk2(__builtin_amdgcn_exp2f(S[hx][ni][2 * jp]), __builtin_amdgcn_exp2f(S[hx][ni][2 * jp + 1])) & pm[ni][jp];
      }
#define DS_PV(di, ta, tb) { const bf16x8 av = __builtin_bit_cast(bf16x8, (i64x2){ta, tb}); \
        O[0][di] = __builtin_amdgcn_mfma_f32_16x16x32_bf16(av, pb0, O[0][di], 0, 0, 0); O[1][di] = __builtin_amdgcn_mfma_f32_16x16x32_bf16(av, pb1, O[1][di], 0, 0, 0); }
      DS_TRW(t0, t1, t2, t3, t4, t5, t6, t7);
      {
        u32x4 pw;
        pw.x = pk[0][0][0]; pw.y = pk[0][0][1]; pw.z = pk[0][1][0]; pw.w = pk[0][1][1];
        const bf16x8 pb0 = __builtin_bit_cast(bf16x8, pw);
        pw.x = pk[1][0][0]; pw.y = pk[1][0][1]; pw.z = pk[1][1][0]; pw.w = pk[1][1][1];
        const bf16x8 pb1 = __builtin_bit_cast(bf16x8, pw);
        DS_TRI(0, 4096, va4, va5, va6, va7, u0, u1, u2, u3, u4, u5, u6, u7);
        __builtin_amdgcn_sched_barrier(0);
        Lacc[0] = __builtin_amdgcn_mfma_f32_16x16x32_bf16(ones8, pb0, Lacc[0], 0, 0, 0);
        Lacc[1] = __builtin_amdgcn_mfma_f32_16x16x32_bf16(ones8, pb1, Lacc[1], 0, 0, 0);
        DS_PV(0, t0, t1) DS_PV(1, t2, t3) DS_PV(2, t4, t5) DS_PV(3, t6, t7)
        __builtin_amdgcn_sched_barrier(0);
        DS_TRW(u0, u1, u2, u3, u4, u5, u6, u7);
        DS_TRI(8192, 12288, va0, va1, va2, va3, t0, t1, t2, t3, t4, t5, t6, t7);
        __builtin_amdgcn_sched_barrier(0);
        DS_PV(4, u0, u1) DS_PV(5, u2, u3) DS_PV(6, u4, u5) DS_PV(7, u6, u7)
        __builtin_amdgcn_sched_barrier(0);
      }
      {
        u32x4 pw;
        pw.x = pk[0][2][0]; pw.y = pk[0][2][1]; pw.z = pk[0][3][0]; pw.w = pk[0][3][1];
        const bf16x8 pb0 = __builtin_bit_cast(bf16x8, pw);
        pw.x = pk[1][2][0]; pw.y = pk[1][2][1]; pw.z = pk[1][3][0]; pw.w = pk[1][3][1];
        const bf16x8 pb1 = __builtin_bit_cast(bf16x8, pw);
        DS_TRW(t0, t1, t2, t3, t4, t5, t6, t7);
        DS_TRI(8192, 12288, va4, va5, va6, va7, u0, u1, u2, u3, u4, u5, u6, u7);
        __builtin_amdgcn_sched_barrier(0);
        Lacc[0] = __builtin_amdgcn_mfma_f32_16x16x32_bf16(ones8, pb0, Lacc[0], 0, 0, 0);
        Lacc[1] = __builtin_amdgcn_mfma_f32_16x16x32_bf16(ones8, pb1, Lacc[1], 0, 0, 0);
        DS_PV(0, t0, t1) DS_PV(1, t2, t3) DS_PV(2, t4, t5) DS_PV(3, t6, t7)
        __builtin_amdgcn_sched_barrier(0);
        DS_TRW(u0, u1, u2, u3, u4, u5, u6, u7);
        DS_PV(4, u0, u1) DS_PV(5, u2, u3) DS_PV(6, u4, u5) DS_PV(7, u6, u7)
      }
#undef DS_PV
#undef DS_TRI
#undef DS_TRW
      stg = (stg == 2) ? 0 : stg + 1; stg2 = (stg2 == 2) ? 0 : stg2 + 1;
    }
    asm volatile("s_waitcnt vmcnt(0)" ::: "memory");
#pragma unroll
    for (int hx = 0; hx < 2; ++hx) {
      const float inv = 1.0f / Lacc[hx][0];
      bf16_t* op = A2 + (q0 + qh + fr) * 1024 + 512 + (hd0 + hx) * 128 + fq * 4;
#pragma unroll
      for (int di = 0; di < 8; ++di) { u32x2 wv2; wv2.x = pk2(O[hx][di][0] * inv, O[hx][di][1] * inv); wv2.y = pk2(O[hx][di][2] * inv, O[hx][di][3] * inv); *(u32x2*)(op + di * 16) = wv2; }
    }
    __syncthreads();
  }
#undef DS_ISSUE
#undef DS_GLDS
}
__device__ __forceinline__ void phase3(const Params& p) {
  for (int rep = 0; rep < ((PROBE_DBL == 31) ? 2 : 1); ++rep)
  for (int id = blockIdx.x; id < 64; id += gridDim.x) { mlstm_item(p, id); __syncthreads(); }
  unsigned* qctr = (unsigned*)(p.ws + OFF_CTL) + CW_Q;
  LAS unsigned* qk = (LAS unsigned*)(SMEM + LDS_MISC);
  for (;;) {
    __syncthreads();
    if (threadIdx.x == 0) qk[0] = __hip_atomic_fetch_add(qctr, 1u, __ATOMIC_RELAXED, __HIP_MEMORY_SCOPE_AGENT);
    __syncthreads();
    const unsigned k = qk[0];
    if (k >= 1024u) break;
    dsa_item(p, (int)(k & 15u), 63 - (int)(k >> 4));
  }
}
struct EpiY { bf16_t* Y; int m0, n0;
  __device__ __forceinline__ void operator()(LAS const float* tile, int r, int c0) const { *(u32x4*)(Y + (size_t)(m0 + r) * 1024 + n0 + c0) = pack8(tile + r * TILE_LD + c0); } };
__device__ __forceinline__ void rows6(const Params& p, int row0) {
  const int tid_ = opaque_tid(); const int lane = tid_ & 63, wv = tid_ >> 6;
  const float* mb = (const float*)(p.ws + OFF_MOD) + (row0 >> 12) * 6144;
  const bf16_t* Y = (const bf16_t*)(p.ws + OFF_Y);
  bf16_t* H2 = (bf16_t*)(p.ws + OFF_ACTA); bf16_t* H2L = (bf16_t*)(p.ws + OFF_H2LO);
  float4 gpo[4], gt1[4], gpr[4], sh2[4], sc2[4];
#pragma unroll
  for (int i = 0; i < 4; ++i) { const int c = (lane + 64 * i) * 4; gpo[i] = *(const float4*)(p.g_mix_post + c); gt1[i] = *(const float4*)(mb + 2048 + c);
    gpr[i] = *(const float4*)(p.g_ffn_pre + c); sh2[i] = *(const float4*)(mb + 3072 + c); sc2[i] = *(const float4*)(mb + 4096 + c); }
  u32x2 yn[4]; float4 xn[4];
  const int rfirst = row0 + wv * 32;
#pragma unroll
  for (int i = 0; i < 4; ++i) { const int c = (lane + 64 * i) * 4; yn[i] = *(const u32x2*)(Y + (size_t)rfirst * 1024 + c); xn[i] = *(const float4*)(p.x + (size_t)rfirst * 1024 + c); }
#pragma unroll 1
  for (int r = 0; r < 32; ++r) {
    const int row = rfirst + r;
    u32x2 yc[4]; float4 xc[4];
#pragma unroll
    for (int i = 0; i < 4; ++i) { yc[i] = yn[i]; xc[i] = xn[i]; }
    if (r + 1 < 32) {
#pragma unroll
      for (int i = 0; i < 4; ++i) { const int c = (lane + 64 * i) * 4; yn[i] = *(const u32x2*)(Y + (size_t)(row + 1) * 1024 + c); xn[i] = *(const float4*)(p.x + (size_t)(row + 1) * 1024 + c); }
    }
    float y[16], xv[16]; float ssy = 0.f;
#pragma unroll
    for (int i = 0; i < 4; ++i) {
      y[4 * i] = bflo(yc[i].x); y[4 * i + 1] = bfhi(yc[i].x); y[4 * i + 2] = bflo(yc[i].y); y[4 * i + 3] = bfhi(yc[i].y);
      xv[4 * i] = xc[i].x; xv[4 * i + 1] = xc[i].y; xv[4 * i + 2] = xc[i].z; xv[4 * i + 3] = xc[i].w;
#pragma unroll
      for (int k = 0; k < 4; ++k) ssy += y[4 * i + k] * y[4 * i + k];
    }
    ssy = wave_sum(ssy);
    const float rsy = rsqrtf(ssy * (1.f / 1024.f) + EPS);
    float ss1 = 0.f;
#pragma unroll
    for (int i = 0; i < 4; ++i) {
      const int c = (lane + 64 * i) * 4;
      xv[4 * i] += gt1[i].x * (y[4 * i] * rsy * gpo[i].x); xv[4 * i + 1] += gt1[i].y * (y[4 * i + 1] * rsy * gpo[i].y);
      xv[4 * i + 2] += gt1[i].z * (y[4 * i + 2] * rsy * gpo[i].z); xv[4 * i + 3] += gt1[i].w * (y[4 * i + 3] * rsy * gpo[i].w);
      { u32x2 xb; xb.x = pk2(xv[4 * i], xv[4 * i + 1]); xb.y = pk2(xv[4 * i + 2], xv[4 * i + 3]); *(u32x2*)((bf16_t*)(p.out + (size_t)row * 1024) + c) = xb; }
#pragma unroll
      for (int k = 0; k < 4; ++k) ss1 += xv[4 * i + k] * xv[4 * i + k];
    }
    ss1 = wave_sum(ss1);
    const float rs1 = rsqrtf(ss1 * (1.f / 1024.f) + EPS);
#pragma unroll
    for (int i = 0; i < 4; ++i) {
      const int c = (lane + 64 * i) * 4;
      const float h0 = xv[4 * i] * rs1 * gpr[i].x * (1.f + sc2[i].x) + sh2[i].x, h1 = xv[4 * i + 1] * rs1 * gpr[i].y * (1.f + sc2[i].y) + sh2[i].y;
      const float h2 = xv[4 * i + 2] * rs1 * gpr[i].z * (1.f + sc2[i].z) + sh2[i].z, h3 = xv[4 * i + 3] * rs1 * gpr[i].w * (1.f + sc2[i].w) + sh2[i].w;
      const unsigned hw0 = pk2(h0, h1), hw1 = pk2(h2, h3);
      u32x2 hi; hi.x = hw0; hi.y = hw1;
      u32x2 lo; lo.x = pk2(h0 - bflo(hw0), h1 - bfhi(hw0)); lo.y = pk2(h2 - bflo(hw1), h3 - bfhi(hw1));
      *(u32x2*)(H2 + (size_t)row * 1024 + c) = hi; *(u32x2*)(H2L + (size_t)row * 1024 + c) = lo;
      { const int q8 = cvt4_fp8(__builtin_amdgcn_fmed3f(h0, -448.f, 448.f), __builtin_amdgcn_fmed3f(h1, -448.f, 448.f), __builtin_amdgcn_fmed3f(h2, -448.f, 448.f), __builtin_amdgcn_fmed3f(h3, -448.f, 448.f)); *(int*)(p.ws + OFF_H2Q + (size_t)row * 1024 + c) = q8; }
    }
  }
}
constexpr int LDS_RT = LDS_MAIN + 4 * GT_STAGE;
constexpr int LDS_RTX = LDS_RT + 512 + 320 + 1024;
constexpr int RL_LD = 65, RG_STAGE = 49152;
__device__ __forceinline__ void route_logits(const Params& p, int pm) {
  const int tid = opaque_tid(), lane = tid & 63, wid = __builtin_amdgcn_readfirstlane(tid >> 6), wr = wid >> 1, wc = wid & 1, fr = lane & 15, fq = lane >> 4;
  const int r0 = tid >> 3, cs = ((tid & 7) ^ (r0 & 7)) * 8;
  const bf16_t* Hh = (const bf16_t*)(p.ws + OFF_ACTA) + ((size_t)pm * 256 + r0) * 1024 + cs; const bf16_t* Hl = (const bf16_t*)(p.ws + OFF_H2LO) + ((size_t)pm * 256 + r0) * 1024 + cs;
  const bf16_t* Wh = (const bf16_t*)(p.ws + OFF_WR) + (size_t)r0 * 1024 + cs; const bf16_t* Wl = Wh + 128 * 1024;
  f32x4 acc[4][2];
#pragma unroll
  for (int m = 0; m < 4; ++m)
#pragma unroll
    for (int n = 0; n < 2; ++n) acc[m][n] = (f32x4){0.f, 0.f, 0.f, 0.f};
  LAS unsigned char* ring = SMEM + LDS_MAIN;
  constexpr int nsteps = 32;
#define RG_ISSUE(s_) do { const int s1_ = (s_) < nsteps ? (s_) : nsteps - 1; const int seg_ = s1_ >> 4, k0_ = (s1_ & 15) * 64; \
    const bf16_t* Ap_ = seg_ ? Hl : Hh; \
    LAS unsigned char* st_ = ring + ((s_) % 3) * RG_STAGE + wid * 1024; \
    _Pragma("unroll") for (int i_ = 0; i_ < 4; ++i_) __builtin_amdgcn_global_load_lds((const unsigned*)(Ap_ + (size_t)i_ * 64 * 1024 + k0_), (LAS unsigned*)(st_ + i_ * 8192), 16, 0, 0); \
    __builtin_amdgcn_global_load_lds((const unsigned*)(Wh + k0_), (LAS unsigned*)(st_ + 32768), 16, 0, 0); \
    if (seg_ == 0) __builtin_amdgcn_global_load_lds((const unsigned*)(Wl + k0_), (LAS unsigned*)(st_ + 40960), 16, 0, 0); } while (0)
  asm volatile("s_waitcnt vmcnt(0)" ::: "memory");
  RG_ISSUE(0); RG_ISSUE(1);
#pragma unroll 1
  for (int s = 0; s < nsteps; ++s) {
    if (s + 1 < 16) asm volatile("s_waitcnt vmcnt(6)" ::: "memory"); else asm volatile("s_waitcnt vmcnt(5)" ::: "memory");
    asm volatile("s_waitcnt lgkmcnt(0)" ::: "memory");
    __builtin_amdgcn_s_barrier();
    RG_ISSUE(s + 2);
    LAS unsigned char* sa = ring + (s % 3) * RG_STAGE;
    LAS unsigned char* sb = sa + 32768;
#pragma unroll
    for (int kk = 0; kk < 2; ++kk) {
      bf16x8 af[4], bfr[2];
#pragma unroll
      for (int m = 0; m < 4; ++m) af[m] = *(LAS bf16x8*)(sa + swz_off(wr * 64 + m * 16 + fr, kk * 4 + fq));
#pragma unroll
      for (int n = 0; n < 2; ++n) bfr[n] = *(LAS bf16x8*)(sb + swz_off(wc * 32 + n * 16 + fr, kk * 4 + fq));
#pragma unroll
      for (int m = 0; m < 4; ++m)
#pragma unroll
        for (int n = 0; n < 2; ++n) acc[m][n] = __builtin_amdgcn_mfma_f32_16x16x32_bf16(af[m], bfr[n], acc[m][n], 0, 0, 0);
      if (s < 16) {
#pragma unroll
        for (int n = 0; n < 2; ++n) bfr[n] = *(LAS bf16x8*)(sb + 8192 + swz_off(wc * 32 + n * 16 + fr, kk * 4 + fq));
#pragma unroll
        for (int m = 0; m < 4; ++m)
#pragma unroll
          for (int n = 0; n < 2; ++n) acc[m][n] = __builtin_amdgcn_mfma_f32_16x16x32_bf16(af[m], bfr[n], acc[m][n], 0, 0, 0);
      }
    }
  }
#undef RG_ISSUE
  asm volatile("s_waitcnt vmcnt(0)" ::: "memory");
  asm volatile("s_waitcnt lgkmcnt(0)" ::: "memory");
  __builtin_amdgcn_s_barrier();
  LAS float* Lg = (LAS float*)(SMEM + LDS_MAIN);
#pragma unroll
  for (int m = 0; m < 4; ++m)
#pragma unroll
    for (int n = 0; n < 2; ++n)
#pragma unroll
      for (int j = 0; j < 4; ++j) Lg[(wr * 64 + m * 16 + fq * 4 + j) * RL_LD + wc * 32 + n * 16 + fr] = acc[m][n][j];
  __syncthreads();
}
constexpr int LDS_R2 = LDS_MAIN + 2 * 256 * RL_LD * 4;
__device__ __forceinline__ void route6h(const Params& p, int pm) {
  const int tid = opaque_tid();
  unsigned* cnt = (unsigned*)(p.ws + OFF_CTL) + CW_CNT;
  int* SORTED = (int*)(p.ws + OFF_SORTED);
  LAS unsigned* cntl = (LAS unsigned*)(SMEM + LDS_R2); LAS unsigned* basel = cntl + 64; LAS float* brl = (LAS float*)(basel + 64);
  const int r = tid >> 1, h = tid & 1;
  LAS int* rei = (LAS int*)(SMEM + LDS_R2 + 1024) + r * 8; LAS float* rgw = (LAS float*)(SMEM + LDS_R2 + 1024 + 8192) + r * 8; LAS unsigned* rrk = (LAS unsigned*)(SMEM + LDS_R2 + 1024 + 16384) + r * 8;
  if (tid < 64) { cntl[tid] = 0u; brl[tid] = p.b_router[tid]; }
  __syncthreads();
  const int tok = pm * 256 + r;
#define R6_SWAPF(x_) __builtin_bit_cast(float, __builtin_amdgcn_update_dpp(0, __builtin_bit_cast(int, x_), 0xB1, 0xf, 0xf, false))
#define R6_SWAPI(x_) __builtin_amdgcn_update_dpp(0, (x_), 0xB1, 0xf, 0xf, false)
  {
    LAS float* tr = (LAS float*)(SMEM + LDS_MAIN) + r * RL_LD; LAS float* sg = tr + 256 * RL_LD;
    const int eb = h * 32;
#pragma unroll 1
    for (int e0 = 0; e0 < 32; e0 += 8) {
      float v[8], bb[8];
#pragma unroll
      for (int k = 0; k < 8; ++k) { v[k] = tr[eb + e0 + k]; bb[k] = brl[eb + e0 + k]; }
#pragma unroll
      for (int k = 0; k < 8; ++k) { const float s_ = sigmoidf_(v[k]); v[k] = s_; bb[k] += s_; }
#pragma unroll
      for (int k = 0; k < 8; ++k) { sg[eb + e0 + k] = v[k]; tr[eb + e0 + k] = bb[k]; }
    }
    float gm[4], go[4];
#pragma unroll
    for (int g = 0; g < 4; ++g) {
      float gv[8];
#pragma unroll
      for (int k = 0; k < 8; ++k) gv[k] = tr[eb + g * 8 + k];
      float m1 = -INFINITY, m2 = -INFINITY;
#pragma unroll
      for (int k = 0; k < 8; ++k) { const float v = gv[k]; if (v > m1) { m2 = m1; m1 = v; } else if (v > m2) m2 = v; }
      gm[g] = m1 + m2;
    }
#pragma unroll
    for (int g = 0; g < 4; ++g) go[g] = R6_SWAPF(gm[g]);
    float gs[8];
#pragma unroll
    for (int g = 0; g < 4; ++g) { gs[g] = h ? go[g] : gm[g]; gs[4 + g] = h ? gm[g] : go[g]; }
#pragma unroll
    for (int g = 0; g < 4; ++g) {
      const float mine = gm[g]; const int G = h * 4 + g;
      int rank = 0;
#pragma unroll
      for (int gj = 0; gj < 8; ++gj) rank += (gs[gj] > mine || (gs[gj] == mine && gj < G)) ? 1 : 0;
      if (rank >= 4) {
#pragma unroll
        for (int k = 0; k < 8; ++k) tr[eb + g * 8 + k] = -INFINITY; }
    }
    float gsum = 0.f;
#pragma unroll 1
    for (int it = 0; it < 8; ++it) {
      float best = -INFINITY; int bi = eb;
#pragma unroll 1
      for (int e0 = 0; e0 < 32; e0 += 16) {
        float cv[16];
#pragma unroll
        for (int k = 0; k < 16; ++k) cv[k] = tr[eb + e0 + k];
#pragma unroll
        for (int k = 0; k < 16; ++k) { if (cv[k] > best) { best = cv[k]; bi = eb + e0 + k; } }
      }
      const float bo = R6_SWAPF(best); const int io = R6_SWAPI(bi);
      const bool mine = (best > bo) || (best == bo && h == 0);
      const int wbi = mine ? bi : io;
      if (mine) tr[wbi] = -INFINITY;
      const float sv = sg[wbi];
      if (h == 0) { rei[it] = wbi; rgw[it] = sv; }
      gsum += sv;
    }
    const float gn = 2.5f / gsum;
#pragma unroll 1
    for (int i4 = 0; i4 < 4; ++i4) { const int it = h * 4 + i4; rgw[it] *= gn; rrk[it] = __hip_atomic_fetch_add(cntl + rei[it], 1u, __ATOMIC_RELAXED, __HIP_MEMORY_SCOPE_WORKGROUP); }
  }
#undef R6_SWAPF
#undef R6_SWAPI
  __syncthreads();
  if (tid < 64) { const unsigned c = cntl[tid]; basel[tid] = c ? __hip_atomic_fetch_add(cnt + tid, c, __ATOMIC_RELAXED, __HIP_MEMORY_SCOPE_AGENT) : 0u; }
  __syncthreads();
  {
#pragma unroll 1
    for (int i4 = 0; i4 < 4; ++i4) {
      const int it = h * 4 + i4;
      const int e = rei[it];
      const unsigned pos = basel[e] + rrk[it];
      u32x2 rec; rec.x = (unsigned)(tok * 8 + it); rec.y = __builtin_bit_cast(unsigned, rgw[it]);
      *(u32x2*)(SORTED + ((size_t)e * 65536 + pos) * 2) = rec;
    }
  }
  __syncthreads();
}

struct PanelOrder {
  static constexpr bool REC = false, BSTAT = false; static constexpr int SCALE_A = 0, SCALE_B = 0;
  int pm; const char* Bt;
  __device__ __forceinline__ bool next(int i, pg8::Unit& u) const { if (i >= 4) return false; u.pm = pm; u.pn = i; u.e = 0; u.lt = 0; return true; }
  __device__ __forceinline__ const char* b_base(const pg8::Unit& u) const { return Bt + (size_t)u.pn * 256 * 1024 * 2; }
  __device__ __forceinline__ unsigned a_off(const pg8::Unit& u, int row) const { return (unsigned)(u.pm * 256 + row) * 2048u; }
  __device__ __forceinline__ const char* rec_ptr(const pg8::Unit&) const { return nullptr; }
  __device__ __forceinline__ bool has_rec(const pg8::Unit&) const { return false; }
  __device__ __forceinline__ bool row_valid(const pg8::Unit&, int) const { return true; }
  __device__ __forceinline__ int nvalid(const pg8::Unit&) const { return 256; }
  __device__ __forceinline__ unsigned a_off_idx(const pg8::Unit&, int, int) const { return 0u; }
};
__device__ __forceinline__ void phase56(const Params& p) {
#pragma unroll 1
  for (int pm = blockIdx.x; pm < 256; pm += gridDim.x) {
    PanelOrder S{pm, (const char*)(p.ws + OFF_WOUT)};
    pg8::EpiStoreBf16 E{(bf16_t*)(p.ws + OFF_Y), 1024};
    pg8::gemm_phase(SMEM + LDS_PG8, (const bf16_t*)(p.ws + OFF_ACTA), 1024, S, E);
    rows6(p, pm * 256);
    asm volatile("s_waitcnt vmcnt(0)" ::: "memory");
    __syncthreads();
    route_logits(p, pm);
    route6h(p, pm);
  }
}
constexpr int LDS_PRE = LDS_PG8 + 131072 + 8192 + 256;
constexpr int LDS_TAB = LDS_PRE + 1024;
typedef float f32x2 __attribute__((ext_vector_type(2)));
__device__ __forceinline__ void moe_prefix(const Params& p) {
  LAS int* pre = (LAS int*)(SMEM + LDS_PRE); LAS unsigned char* tab = SMEM + LDS_TAB;
  const unsigned* cnt = (const unsigned*)(p.ws + OFF_CTL) + CW_CNT;
  __syncthreads();
  if (threadIdx.x < 64) {
    const int e = threadIdx.x; const int c = (int)cnt[e]; const int nt_ = (c + 255) >> 8; int inc = nt_;
#pragma unroll
    for (int d = 1; d < 64; d <<= 1) { const int o = __shfl_up(inc, d, 64); if (e >= d) inc += o; }
    const int beg = inc - nt_;
    pre[e] = beg; if (e == 63) pre[64] = inc; pre[128 + e] = c;
    for (int t = beg; t < inc; ++t) tab[t] = (unsigned char)e;
  }
  __syncthreads();
}
template <int SA, int SB, int NT, bool BS = false>
struct MoeOrder {
  static constexpr bool REC = true, BSTAT = BS;
  static constexpr int SCALE_A = SA * 0x01010101, SCALE_B = SB * 0x01010101;
  int R, nwg, G, c, hf, mode, rowbytes, routed; const unsigned* cnt; const int* list; const char* W; size_t estride, tstride;
  __device__ __forceinline__ bool next(int i, pg8::Unit& u) const {
    const int cc = (c & 7) * (G >> 3) + (c >> 3);
    if (BS) {
      const int nch = G / NT, j = cc / NT, q = R / nch, r = R - q * nch;
      const int start = j * q + (j < r ? j : r), len = q + (j < r ? 1 : 0);
      if (j >= nch || i >= len) return false;
      u.pm = start + i; u.pn = cc - j * NT;
    } else {
    const int L = i * G + cc; if (L >= nwg) return false;
    u.pm = L / NT; u.pn = L - u.pm * NT; }
    if (u.pm >= routed) { u.e = 64; u.lt = u.pm - routed; }
    else { u.e = (int)(SMEM + LDS_TAB)[u.pm]; u.lt = u.pm - ((LAS const int*)(SMEM + LDS_PRE))[u.e]; }
    return true;
  }
  __device__ __forceinline__ const char* b_base(const pg8::Unit& u) const { return W + (size_t)u.e * estride + (size_t)u.pn * tstride; }
  __device__ __forceinline__ const char* rec_ptr(const pg8::Unit& u) const { return (const char*)(list + ((size_t)(u.e < 64 ? u.e : 0) * 65536 + (u.e < 64 ? u.lt * 256 : 0)) * 2); }
  __device__ __forceinline__ bool has_rec(const pg8::Unit& u) const { return u.e < 64; }
  __device__ __forceinline__ bool row_valid(const pg8::Unit& u, int row) const { return (u.lt * 256 + row) < ((LAS const int*)(SMEM + LDS_PRE))[128 + (u.e < 64 ? u.e : 0)]; }
  __device__ __forceinline__ int nvalid(const pg8::Unit& u) const { return ((LAS const int*)(SMEM + LDS_PRE))[128 + (u.e < 64 ? u.e : 0)] - u.lt * 256; }
  __device__ __forceinline__ unsigned a_off_idx(const pg8::Unit& u, int row, int idx) const { const int arow = (mode == 0) ? (idx >> 3) : idx; return (unsigned)arow * (unsigned)rowbytes; }
  __device__ __forceinline__ unsigned a_off(const pg8::Unit& u, int row) const {
    const int tl = u.lt * 256 + row; const int arow = (mode == 0) ? tl : (524288 + tl);
    return (unsigned)arow * (unsigned)rowbytes;
  }
};
constexpr int LDS_EPI = LDS_TAB + 2560;
#define EPI_BAR() do { asm volatile("s_waitcnt lgkmcnt(0)" ::: "memory"); __builtin_amdgcn_s_barrier(); } while (0)
struct EpiU { unsigned char* U; const unsigned* cnt; const int* list; int hf;
  __device__ __forceinline__ void operator()(const f32x4 (&acc)[2][2][4][2], const pg8::Unit& u, int wr, int wc, int fr, int fq, LAS const unsigned char* rec) const {
    const bool rt = u.e < 64;
    const int nrow = rt ? ((LAS const int*)(SMEM + LDS_PRE))[128 + u.e] : 0x7fffffff;
    LAS unsigned char* st = SMEM + LDS_EPI;
    int tid = (wr * 4 + wc) * 64 + fq * 16 + fr; asm volatile("" : "+v"(tid));
    const int c16 = tid & 7;
    int rb_ = (wr * 64 + fr) * 8; asm volatile("" : "+v"(rb_));
    int wb_ = (wr * 64 + fr) * 144 + wc * 16 + 4 * fq; asm volatile("" : "+v"(wb_));
    int ridx[2][2];
#pragma unroll
    for (int ai = 0; ai < 2; ++ai)
#pragma unroll
      for (int i = 0; i < 2; ++i) ridx[ai][i] = *(LAS const int*)(rec + (ai * 128 + ((tid + 512 * i) >> 3)) * 8);
#pragma unroll
    for (int ai = 0; ai < 2; ++ai) {
      int gwu[4];
#pragma unroll
      for (int m = 0; m < 4; ++m) gwu[m] = ((LAS const int*)(rec + (ai * 128 + m * 16) * 8 + rb_))[1];
#pragma unroll
      for (int m = 0; m < 4; ++m) {
        const int gb = gwu[m]; const float us = rt ? U_SCALE * __builtin_bit_cast(float, gb) : U_SCALE;
#pragma unroll
        for (int bj = 0; bj < 2; ++bj) {
          const f32x4 g = acc[ai][bj][m][0], up = acc[ai][bj][m][1];
          float uu[4];
#pragma unroll
          for (int i = 0; i < 4; ++i) uu[i] = __builtin_amdgcn_fmed3f(siluf_(g[i]) * up[i] * us, -448.f, 448.f);
          const int w8 = cvt4_fp8(uu[0], uu[1], uu[2], uu[3]);
          *(LAS int*)(st + wb_ + m * 16 * 144 + bj * 64) = w8;
        }
      }
      EPI_BAR();
#pragma unroll
      for (int i = 0; i < 2; ++i) {
        const int row = (tid + 512 * i) >> 3;
        const int li = u.lt * 256 + ai * 128 + row;
        const int ur = rt ? ridx[ai][i] : (524288 + li);
        const unsigned dpo = (unsigned)ur * 256u + (unsigned)(u.pn * 128 + c16 * 16);
        if (li < nrow) { const u32x4 v = *(LAS const u32x4*)(st + row * 144 + c16 * 16); *(u32x4*)(U + dpo) = v; }
      }
      EPI_BAR();
    }
  } };
__device__ __forceinline__ void phase7(const Params& p) {
  const int hf = 0; moe_prefix(p);
  const int routed = ((LAS const int*)(SMEM + LDS_PRE))[64];
  MoeOrder<127, 122, 2> S; S.R = routed + 256; S.nwg = S.R * 2; S.G = gridDim.x; S.c = blockIdx.x; S.hf = hf; S.mode = 0; S.rowbytes = 1024; S.routed = routed;
  S.cnt = (const unsigned*)(p.ws + OFF_CTL) + CW_CNT; S.list = (const int*)(p.ws + OFF_SORTED);
  S.W = (const char*)(p.ws + OFF_WGU); S.estride = (size_t)512 * 1024; S.tstride = (size_t)256 * 1024;
  EpiU E{p.ws + OFF_U, S.cnt, S.list, hf};
  pg8::gemm_phase<EpiU, MoeOrder<127, 122, 2>, true>(SMEM + LDS_PG8, (const bf16_t*)(p.ws + OFF_H2Q), 512, S, E);
}
#ifdef PROBE_WI
#define PWI PROBE_WI
#else
#define PWI 0
#endif
struct EpiYE { unsigned char* YE; const float* GW; const unsigned* cnt; const int* list; int hf; int pmode;
  __device__ __forceinline__ void operator()(const f32x4 (&acc)[2][2][4][2], const pg8::Unit& u, int wr, int wc, int fr, int fq, LAS const unsigned char* rec) const {
    const bool rt = u.e < 64;
    const int nrow = rt ? ((LAS const int*)(SMEM + LDS_PRE))[128 + u.e] : 0x7fffffff;
    LAS unsigned char* st = SMEM + LDS_EPI;
    int tid = (wr * 4 + wc) * 64 + fq * 16 + fr; asm volatile("" : "+v"(tid));
    const int c16 = tid & 7;
    int wb_ = (wr * 64 + fr) * 144 + wc * 32 + 8 * fq; asm volatile("" : "+v"(wb_));
    int ridx[2][2];
#pragma unroll
    for (int ai = 0; ai < 2; ++ai) {
#pragma unroll
      for (int i = 0; i < 2; ++i) ridx[ai][i] = *(LAS const int*)(rec + (ai * 128 + ((tid + 512 * i) >> 3)) * 8);
    }
    unsigned dp[2][2]; bool ok[2][2];
#pragma unroll
    for (int ai = 0; ai < 2; ++ai)
#pragma unroll
      for (int i = 0; i < 2; ++i) {
        const int li = u.lt * 256 + ai * 128 + ((tid + 512 * i) >> 3);
        ok[ai][i] = li < nrow;
        const int idx = ridx[ai][i];
        const int dst = rt ? ((idx >> 3) * 9 + (idx & 7)) : (li * 9 + 8);
        dp[ai][i] = (unsigned)dst * 1024u + (unsigned)(u.pn * 256 + c16 * 16);
      }
#pragma unroll
    for (int ai = 0; ai < 2; ++ai) {
#pragma unroll
      for (int bj = 0; bj < 2; ++bj) {
#pragma unroll
        for (int m = 0; m < 4; ++m) {
          const f32x4 v0 = acc[ai][bj][m][0], v1 = acc[ai][bj][m][1];
          float o[8];
#pragma unroll
          for (int i = 0; i < 4; ++i) { o[i] = v0[i]; o[4 + i] = v1[i]; }
          int w0 = 0, w1 = 0;
          if ((PWI & 64) && pmode) { w0 = __builtin_bit_cast(int, v0[0]); w1 = __builtin_bit_cast(int, v1[1]); } else {
#pragma unroll
          for (int i = 0; i < 8; ++i) o[i] = __builtin_amdgcn_fmed3f(o[i], -448.f, 448.f);
          if ((PWI & 512) && pmode) { v2i16_t q0 = {0, 0}, q1 = {0, 0};
            q0 = __builtin_amdgcn_cvt_scalef32_pk_fp8_f32(q0, o[0], o[1], 1.0f, false); q0 = __builtin_amdgcn_cvt_scalef32_pk_fp8_f32(q0, o[2], o[3], 1.0f, true);
            q1 = __builtin_amdgcn_cvt_scalef32_pk_fp8_f32(q1, o[4], o[5], 1.0f, false); q1 = __builtin_amdgcn_cvt_scalef32_pk_fp8_f32(q1, o[6], o[7], 1.0f, true);
            w0 = __builtin_bit_cast(int, q0); w1 = __builtin_bit_cast(int, q1); }
          else if ((PWI & 1024) && pmode) { v2i16_t q0 = {0, 0}, q1 = {0, 0};
            const unsigned b0 = pk2(o[0], o[1]), b1 = pk2(o[2], o[3]), b2 = pk2(o[4], o[5]), b3 = pk2(o[6], o[7]);
            q0 = __builtin_amdgcn_cvt_scalef32_pk_fp8_bf16(q0, __builtin_bit_cast(bf16x2_t, b0), 1.0f, false); q0 = __builtin_amdgcn_cvt_scalef32_pk_fp8_bf16(q0, __builtin_bit_cast(bf16x2_t, b1), 1.0f, true);
            q1 = __builtin_amdgcn_cvt_scalef32_pk_fp8_bf16(q1, __builtin_bit_cast(bf16x2_t, b2), 1.0f, false); q1 = __builtin_amdgcn_cvt_scalef32_pk_fp8_bf16(q1, __builtin_bit_cast(bf16x2_t, b3), 1.0f, true);
            w0 = __builtin_bit_cast(int, q0); w1 = __builtin_bit_cast(int, q1); }
          else           if ((PWI & 256) && pmode) { w0 = (int)(pk2(o[0], o[1]) ^ pk2(o[2], o[3])); w1 = (int)(pk2(o[4], o[5]) ^ pk2(o[6], o[7])); } else {
          w0 = cvt4_fp8(o[0], o[1], o[2], o[3]); w1 = cvt4_fp8(o[4], o[5], o[6], o[7]); } }
          u32x2 w; w.x = (unsigned)w0; w.y = (unsigned)w1;
          *(LAS u32x2*)(st + wb_ + m * 16 * 144) = w;
        }
        if (!(PWI & 128) || pmode == 0) EPI_BAR();
#pragma unroll
        for (int i = 0; i < 2; ++i) {
          const int row = (tid + 512 * i) >> 3;
          if (ok[ai][i]) {
            const u32x4 v = *(LAS const u32x4*)(st + row * 144 + c16 * 16);
            if (PROBE_DBL != 83 || pmode == 0 || v.x == 0x7fc12345u) *(u32x4*)(YE + (dp[ai][i] + (unsigned)(bj * 128))) = v;
          }
        }
        if (!(PWI & 128) || pmode == 0) EPI_BAR();
      }
    }
  } };
__device__ __forceinline__ void phase8(const Params& p, const int pmode = 0) {
  const int hf = 0;
  const int routed = ((LAS const int*)(SMEM + LDS_PRE))[64];
  MoeOrder<125, 125, 4, true> S; S.R = routed + 256; S.nwg = S.R * 4; S.G = gridDim.x; S.c = blockIdx.x; S.hf = hf; S.mode = 1; S.rowbytes = 256; S.routed = routed;
  S.cnt = (const unsigned*)(p.ws + OFF_CTL) + CW_CNT; S.list = (const int*)(p.ws + OFF_SORTED);
  S.W = (const char*)(p.ws + OFF_WDN); S.estride = (size_t)1024 * 256; S.tstride = (size_t)256 * 256;
  EpiYE E{p.ws + OFF_YE, (const float*)(p.ws + OFF_GW), S.cnt, S.list, hf, pmode};
#ifdef PROBE_WI
  if (pmode) pg8::gemm_phase<EpiYE, MoeOrder<125, 125, 4, true>, true, PROBE_WI>(SMEM + LDS_PG8, (const bf16_t*)(p.ws + OFF_U), 128, S, E); else
#endif
  pg8::gemm_phase<EpiYE, MoeOrder<125, 125, 4, true>, true>(SMEM + LDS_PG8, (const bf16_t*)(p.ws + OFF_U), 128, S, E);
}
__device__ __forceinline__ void phase9(const Params& p) {
  const int tid_ = opaque_tid(); const int lane = tid_ & 63, gw = blockIdx.x * 8 + (tid_ >> 6), nw = gridDim.x * 8;
  const float* mod = (const float*)(p.ws + OFF_MOD);
  const unsigned char* YE = p.ws + OFF_YE;
  const int c = lane * 16;
  float4 gp[4];
#pragma unroll
  for (int i = 0; i < 4; ++i) gp[i] = *(const float4*)(p.g_ffn_post + c + 4 * i);
  u32x4 vn[9]; u32x4 xn[2];
  if (gw < T_TOK) {
#pragma unroll
    for (int s = 0; s < 9; ++s) vn[s] = *(const u32x4*)(YE + ((size_t)gw * 9 + s) * 1024 + c);
    xn[0] = *(const u32x4*)((const bf16_t*)(p.out + (size_t)gw * 1024) + c); xn[1] = *(const u32x4*)((const bf16_t*)(p.out + (size_t)gw * 1024) + c + 8);
  }
  for (int rep9 = ((PROBE_DBL == 9) ? 0 : 1); rep9 < 2; ++rep9)
#pragma unroll 1
  for (int row = gw; row < T_TOK; row += nw) {
    const int b = row >> 12;
    u32x4 vc[9]; u32x4 xc[2];
#pragma unroll
    for (int s = 0; s < 9; ++s) vc[s] = vn[s];
    xc[0] = xn[0]; xc[1] = xn[1];
    { const int rn = (row + nw < T_TOK) ? row + nw : row;
#pragma unroll
      for (int s = 0; s < 9; ++s) vn[s] = *(const u32x4*)(YE + ((size_t)rn * 9 + s) * 1024 + c);
      xn[0] = *(const u32x4*)((const bf16_t*)(p.out + (size_t)rn * 1024) + c); xn[1] = *(const u32x4*)((const bf16_t*)(p.out + (size_t)rn * 1024) + c + 8); }
    float acc[16];
#pragma unroll
    for (int i = 0; i < 16; ++i) acc[i] = 0.f;
#pragma unroll
    for (int s = 0; s < 9; ++s) {
      const unsigned vw[4] = {vc[s].x, vc[s].y, vc[s].z, vc[s].w};
#pragma unroll
      for (int k = 0; k < 4; ++k) {
        const f32x2 lo = __builtin_amdgcn_cvt_scalef32_pk_f32_fp8(vw[k], 1.0f, false), hi = __builtin_amdgcn_cvt_scalef32_pk_f32_fp8(vw[k], 1.0f, true);
        acc[4 * k] = add_s(acc[4 * k], lo[0]); acc[4 * k + 1] = add_s(acc[4 * k + 1], lo[1]); acc[4 * k + 2] = add_s(acc[4 * k + 2], hi[0]); acc[4 * k + 3] = add_s(acc[4 * k + 3], hi[1]);
      }
    }
    float ss = 0.f;
#pragma unroll
    for (int i = 0; i < 16; ++i) { acc[i] = mul_s(acc[i], 1.0f / YE_SCALE); ss = __builtin_fmaf(acc[i], acc[i], ss); }
    ss = wave_sum(ss);
    const float rs = rsqrtf(ss * (1.f / 1024.f) + EPS);
    float* op = p.out + (size_t)row * 1024 + c;
#pragma unroll
    for (int i = 0; i < 4; ++i) {
      const unsigned xw0 = (i == 0) ? xc[0].x : (i == 1) ? xc[0].z : (i == 2) ? xc[1].x : xc[1].z, xw1 = (i == 0) ? xc[0].y : (i == 1) ? xc[0].w : (i == 2) ? xc[1].y : xc[1].w;
      float4 x1 = make_float4(bflo(xw0), bfhi(xw0), bflo(xw1), bfhi(xw1));
      const float4 gt = *(const float4*)(mod + b * 6144 + 5120 + c + 4 * i);
      x1.x += gt.x * (acc[4 * i] * rs * gp[i].x); x1.y += gt.y * (acc[4 * i + 1] * rs * gp[i].y); x1.z += gt.z * (acc[4 * i + 2] * rs * gp[i].z); x1.w += gt.w * (acc[4 * i + 3] * rs * gp[i].w);
      if (rep9 == 1) *(float4*)(op + 4 * i) = x1; else if (x1.x == 123456.789f) *(float4*)(op + 4 * i) = x1;
    }
  }
}

#define DBL(n, call) do { call; if (PROBE_DBL == (n)) { xcd_barrier(bar); call; } } while (0)
#ifndef STOP_AFTER
#define STOP_AFTER 99
#endif
__global__ void __launch_bounds__(NTHR) fwd_kernel(Params p) {
  volatile LAS unsigned* st = (volatile LAS unsigned*)(SMEM + LDS_ST);
  if (threadIdx.x < 4) st[threadIdx.x] = 0u;
  __syncthreads();
  XcdBarrier bar = xcd_barrier_post((unsigned*)(p.ws + OFF_CTL) + CW_BAR, st);
  __syncthreads();
#ifdef PROBE_CLK
  long long pc0 = 0, pw0 = 0, pc1 = 0, pw1 = 0;
#define TWIN(n, stmt) do { if (PROBE_CLK == (n)) { pc0 = clock64(); pw0 = wall_clock64(); } stmt; if (PROBE_CLK == (n)) { pc1 = clock64(); pw1 = wall_clock64(); } } while (0)
#else
#define TWIN(n, stmt) do { stmt; } while (0)
#endif
  TWIN(0, phase01<0>(p); xcd_barrier(bar));
  TWIN(1, phase01<1>(p); xcd_barrier(bar));
  TWIN(2, DBL(2, phase2(p));  xcd_barrier(bar));
  TWIN(20, DBL(20, phase2b(p)); xcd_barrier(bar));
  TWIN(3, DBL(3, phase3(p));  xcd_barrier(bar));
  TWIN(56, phase56(p); xcd_barrier(bar));
  TWIN(7, DBL(7, phase7(p)); xcd_barrier(bar));
  TWIN(8, DBL(8, phase8(p)); if (PROBE_DBL == 83) { xcd_barrier(bar); phase8(p, 1); } xcd_barrier(bar));
#ifdef PROBE_CLK
  TWIN(9, phase9(p); xcd_barrier(bar));
#else
  phase9(p);
#endif
#ifdef PROBE_SAT
  {
    float a = 1000.f, b = 3.0e38f, c = 500.f, d = 448.f; asm volatile("" : "+v"(a), "+v"(b), "+v"(c), "+v"(d));
    const int r1 = cvt4_fp8(a, -a, c, d), r2 = cvt4_fp8(b, -b, 449.f + (a - 1000.f), -c);
    xcd_barrier(bar);
    if (blockIdx.x == 0 && threadIdx.x == 0 && (r1 != 0x7E7EFE7E || r2 != (int)0xFE7EFE7Eu)) p.out[0] = __builtin_nanf("");
  }
#endif
#ifdef PROBE_CLK
  if (blockIdx.x == 0 && threadIdx.x == 0) {
#ifndef PROBE_CLKMODE
#define PROBE_CLKMODE 0
#endif
    const long long mhz = (pc1 - pc0) * 100 / (pw1 - pw0 + 1);
#ifndef PROBE_SUB
#define PROBE_SUB 0
#endif
    const long long ticks = (PROBE_SUB == 1) ? sub.a : (PROBE_SUB == 2) ? sub.b : (PROBE_SUB == 3) ? sub.c : (PROBE_SUB == 4) ? sub.d : ((PROBE_CLKMODE == 0) ? mhz * 25 : (pw1 - pw0));
    const long long ts = wall_clock64();
    while (wall_clock64() - ts < ticks) __builtin_amdgcn_s_sleep(20);
  }
#endif
}

extern "C" void kernel_launch(void* const* d_in, const int* in_sizes, int n_in, void* d_out, int out_size, void* d_ws, size_t ws_size, hipStream_t stream) {
  static int grid_blocks = 0;
  if (!grid_blocks) {
    int dev = 0, cus = 0, per_cu = 0;
    (void)hipGetDevice(&dev);
    (void)hipDeviceGetAttribute(&cus, hipDeviceAttributeMultiprocessorCount, dev);
    (void)hipFuncSetAttribute((const void*)fwd_kernel, hipFuncAttributeMaxDynamicSharedMemorySize, LDS_BYTES);
    (void)hipOccupancyMaxActiveBlocksPerMultiprocessor(&per_cu, (const void*)fwd_kernel, NTHR, LDS_BYTES);
    grid_blocks = cus;
    if (per_cu < 1 || ws_size < WS_NEED || n_in != 25) fprintf(stderr, "kernel_launch: per_cu=%d ws=%zu need=%zu n_in=%d\n", per_cu, ws_size, (size_t)WS_NEED, n_in);
  }
  (void)hipMemsetAsync((char*)d_ws + OFF_CTL, 0, CTL_ZERO_BYTES, stream);
  Params p{};
  const float** f = (const float**)&p;
  for (int i = 0; i < 25; ++i) f[i] = (const float*)d_in[i];
  p.out = (float*)d_out; p.ws = (unsigned char*)d_ws;
  void* args[] = {&p};
  hipError_t e = hipLaunchCooperativeKernel((void*)fwd_kernel, dim3(grid_blocks), dim3(NTHR), args, LDS_BYTES, stream);
  if (e != hipSuccess) fprintf(stderr, "cooperative launch failed: %s (grid %d)\n", hipGetErrorString(e), grid_blocks);
}
```
